# Optimizing an MI355X kernel written in HIP

```python
import jax, jax.numpy as jnp
from jax import lax
import numpy as np

D_MODEL = 1024
BATCH = 16
SEQ = 4096
DEPTH = 2
DEC_BATCH = 16
DEC_SEQ = 32
PAST_LEN = 2048

CHUNK = 64
N_AB_LAYERS = (DEPTH + 1) // 2
N_C_LAYERS = DEPTH // 2
A_WIDTH = D_MODEL // 2
A_HEAD = 128
A_HEADS = A_WIDTH // A_HEAD
B_WIDTH = D_MODEL // 2
B_HEADS = 4
B_KEY_WIDTH = B_WIDTH // 2
B_DK = B_KEY_WIDTH // B_HEADS
B_DV = B_WIDTH // B_HEADS
GLA_GATE_RANK = 16
GLA_GATE_NORMALIZER = 16.0
AB_SPLITS = (A_WIDTH, A_WIDTH, A_WIDTH, A_WIDTH, B_KEY_WIDTH, B_KEY_WIDTH, B_WIDTH, GLA_GATE_RANK, B_WIDTH)
AB_IN_WIDTH = 4 * A_WIDTH + 2 * B_KEY_WIDTH + 2 * B_WIDTH + GLA_GATE_RANK
AB_OUT_WIDTH = A_WIDTH + B_WIDTH
C_HEAD = 64
C_HEADS = D_MODEL // C_HEAD
C_DECAY_RANK = 64
C_AAA_RANK = 64
C_GATE_RANK = 128
C_GN_EPS = 64e-5
PEER_HEADS = 8
PEER_N_KEYS = 128
PEER_N_EXPERTS = PEER_N_KEYS * PEER_N_KEYS
PEER_TOPK = 16
PEER_QUERY = 256
PEER_SUBKEY = PEER_QUERY // 2
PEER_BLOCK = 256
NORM_EPS = 1e-6

kernel_name = 'hgrn2_gla_rwkv7_peer_stream_step'


def rms_norm(x, g):
    xf = x.astype(jnp.float32)
    y = xf * lax.rsqrt(jnp.mean(xf * xf, axis=-1, keepdims=True) + NORM_EPS)
    return (y * g.astype(jnp.float32)).astype(x.dtype)


def chunked_gated_recurrence(q, k, v, log_a, s0):
    bsz, T, H, _ = q.shape
    V = v.shape[-1]
    c = min(CHUNK, T)
    n = -(-T // c)
    pad = n * c - T

    def blocks(t):
        t = jnp.pad(t, ((0, 0), (0, pad), (0, 0), (0, 0)))
        return jnp.moveaxis(t.reshape(bsz, n, c, H, t.shape[-1]), 1, 0)

    qs, ks, vs, gs = blocks(q), blocks(k), blocks(v), blocks(log_a.astype(jnp.float32))
    causal = jnp.tril(jnp.ones((c, c), dtype=bool))[None, :, :, None, None]

    def step(S, inp):
        qc, kc, vc, gc = inp
        b = jnp.cumsum(gc, axis=1)
        diff = jnp.where(causal, b[:, :, None] - b[:, None, :], -jnp.inf)
        attn = jnp.einsum('bthk,bshk,btshk->bhts', qc, kc, jnp.exp(diff))
        o = (jnp.einsum('bhts,bshv->bthv', attn, vc)
             + jnp.einsum('bthk,bhkv->bthv', qc * jnp.exp(b), S))
        b_last = b[:, -1]
        S = (jnp.exp(b_last)[..., None] * S
             + jnp.einsum('bshk,bshv->bhkv', kc * jnp.exp(b_last[:, None] - b), vc))
        return S, o

    S, o = lax.scan(step, s0.astype(jnp.float32), (qs, ks, vs, gs))
    o = jnp.moveaxis(o, 0, 1).reshape(bsz, n * c, H, V)[:, :T]
    return o, S


def hgrn2_gla_mixer(h, s_hgrn, s_gla, w_in, lb, hgrn_norm_g, gla_gate_w2, gla_gate_b, gla_norm_g, w_out):
    bsz, T, _ = h.shape
    z = h @ w_in
    offs = [int(o) for o in np.cumsum(AB_SPLITS)[:-1]]
    a_q, a_f, a_i, a_gate, b_q, b_k, b_v, b_lr, b_gate = jnp.split(z, offs, axis=-1)

    def heads(t, H):
        return t.reshape(bsz, T, H, -1)

    f = lb + (1.0 - lb) * jax.nn.sigmoid(a_f.astype(jnp.float32))
    o_a, s_a = chunked_gated_recurrence(heads(jax.nn.silu(a_q), A_HEADS), heads(1.0 - f, A_HEADS),
                                        heads(a_i, A_HEADS), heads(jnp.log(f), A_HEADS), s_hgrn)
    o_a = rms_norm(o_a, hgrn_norm_g).reshape(bsz, T, A_WIDTH) * jax.nn.silu(a_gate)

    log_g = jax.nn.log_sigmoid((b_lr @ gla_gate_w2 + gla_gate_b).astype(jnp.float32)) / GLA_GATE_NORMALIZER
    o_b, s_b = chunked_gated_recurrence(heads(b_q * (B_DK ** -0.5), B_HEADS), heads(b_k, B_HEADS),
                                        heads(b_v, B_HEADS), heads(log_g, B_HEADS), s_gla)
    o_b = rms_norm(o_b, gla_norm_g).reshape(bsz, T, B_WIDTH) * jax.nn.silu(b_gate)

    y = jnp.concatenate([o_a, o_b], axis=-1).astype(h.dtype) @ w_out
    return y, s_a, s_b


def rwkv7_recurrence(r, w, k, v, kk, a, s0):
    def tm(t):
        return jnp.moveaxis(t.astype(jnp.float32), 1, 0)

    def step(S, inp):
        r_t, w_t, k_t, v_t, kk_t, a_t = inp
        sa = jnp.einsum('bhij,bhj->bhi', S, kk_t)
        S = (S * w_t[:, :, None, :] - sa[..., None] * (kk_t * a_t)[:, :, None, :]
             + v_t[..., None] * k_t[:, :, None, :])
        return S, jnp.einsum('bhij,bhj->bhi', S, r_t)

    S, o = lax.scan(step, s0.astype(jnp.float32), (tm(r), tm(w), tm(k), tm(v), tm(kk), tm(a)))
    return jnp.moveaxis(o, 0, 1), S


def rwkv7_mixer(h, s_wkv, x_last, mu, w_rkv, w_w1, w_w2, w0, a_w1, a_w2, a0, g_w1, g_w2,
                k_k, k_a, r_k, ln_g, ln_b, w_out):
    bsz, T, D = h.shape
    x_prev = jnp.concatenate([x_last[:, None].astype(h.dtype), h[:, :-1]], axis=1)
    dx = x_prev - h

    def mix(i):
        return h + dx * mu[i]

    r = mix(0) @ w_rkv[0]
    k = mix(1) @ w_rkv[1]
    v = mix(2) @ w_rkv[2]
    w = -jax.nn.softplus(-(w0 + jnp.tanh(mix(3) @ w_w1) @ w_w2).astype(jnp.float32)) - 0.5
    decay = jnp.exp(-jnp.exp(w))
    a = jax.nn.sigmoid((a0 + (mix(4) @ a_w1) @ a_w2).astype(jnp.float32))
    g = jax.nn.sigmoid(mix(5) @ g_w1) @ g_w2

    def hd(t):
        return t.reshape(bsz, T, C_HEADS, C_HEAD)

    kk = hd((k * k_k).astype(jnp.float32))
    kk = kk * lax.rsqrt(jnp.sum(kk * kk, axis=-1, keepdims=True) + 1e-12)
    k = k * (1.0 + (a - 1.0) * k_a)
    rh, kh, vh = hd(r), hd(k), hd(v)
    o, s_new = rwkv7_recurrence(rh, hd(decay), kh, vh, kk, hd(a), s_wkv)
    mean = jnp.mean(o, axis=-1, keepdims=True)
    var = jnp.mean(jnp.square(o - mean), axis=-1, keepdims=True)
    o = ((o - mean) * lax.rsqrt(var + C_GN_EPS)).reshape(bsz, T, D) * ln_g + ln_b
    bonus = jnp.sum(rh * kh * r_k, axis=-1, keepdims=True) * vh
    o = o + bonus.reshape(bsz, T, D)
    y = (o * g).astype(h.dtype) @ w_out
    return y, s_new, h[:, -1]


def peer_ffn(h, w_q, sub_keys, u_tab, v_tab):
    bsz, T, D = h.shape
    n = bsz * T
    blk = min(PEER_BLOCK, n)
    nb = -(-n // blk)
    xt = jnp.pad(h.reshape(n, D), ((0, nb * blk - n), (0, 0))).reshape(nb, blk, D)

    def block(xb):
        q = (xb @ w_q).reshape(blk, PEER_HEADS, 2, PEER_SUBKEY)
        s = jnp.einsum('thpd,hpnd->thpn', q, sub_keys).astype(jnp.float32)
        sv, si = lax.top_k(s, PEER_TOPK)
        cand = (sv[:, :, 0, :, None] + sv[:, :, 1, None, :]).reshape(blk, PEER_HEADS, PEER_TOPK * PEER_TOPK)
        cidx = (si[:, :, 0, :, None] * PEER_N_KEYS + si[:, :, 1, None, :]).reshape(blk, PEER_HEADS, PEER_TOPK * PEER_TOPK)
        cs, ci = lax.top_k(cand, PEER_TOPK)
        eidx = jnp.take_along_axis(cidx, ci, axis=-1)
        gate = jax.nn.softmax(cs, axis=-1)
        hid = jnp.einsum('td,thkd->thk', xb, u_tab[eidx]).astype(jnp.float32)
        act = (jax.nn.gelu(hid, approximate=False) * gate).astype(xb.dtype)
        return jnp.einsum('thk,thkd->td', act, v_tab[eidx])

    out = lax.map(block, xt).reshape(nb * blk, D)[:n]
    return out.reshape(bsz, T, D)


def setup_inputs(seed: int = 0) -> dict:
    key = jax.random.key(seed)
    ks = iter(jax.random.split(key, 48))

    def nrm(shape, scale):
        return jax.random.normal(next(ks), shape, jnp.float32) * scale

    def gain(shape):
        return 1.0 + nrm(shape, 0.02)

    D = D_MODEL
    return {
        'x_prompt': nrm((BATCH, SEQ, D), 1.0),
        'x_sample': nrm((DEC_BATCH, DEC_SEQ, D), 1.0),
        'state_hgrn': nrm((N_AB_LAYERS, DEC_BATCH, A_HEADS, A_HEAD, A_HEAD), 0.1),
        'state_gla': nrm((N_AB_LAYERS, DEC_BATCH, B_HEADS, B_DK, B_DV), 0.1),
        'state_rwkv': nrm((N_C_LAYERS, DEC_BATCH, C_HEADS, C_HEAD, C_HEAD), 0.1),
        'state_shift': nrm((N_C_LAYERS, DEC_BATCH, D), 1.0),
        'w_in_ab': nrm((N_AB_LAYERS, D, AB_IN_WIDTH), D ** -0.5),
        'hgrn_lower_bounds': nrm((DEPTH + 1, A_WIDTH), 0.1),
        'hgrn_norm_g': gain((N_AB_LAYERS, A_HEAD)),
        'gla_gate_w2': nrm((N_AB_LAYERS, GLA_GATE_RANK, B_KEY_WIDTH), GLA_GATE_RANK ** -0.5),
        'gla_gate_b': nrm((N_AB_LAYERS, B_KEY_WIDTH), 0.01),
        'gla_norm_g': gain((N_AB_LAYERS, B_DV)),
        'w_out_ab': nrm((N_AB_LAYERS, AB_OUT_WIDTH, D), AB_OUT_WIDTH ** -0.5),
        'rwkv_mu': jax.random.uniform(next(ks), (N_C_LAYERS, 6, D), jnp.float32),
        'rwkv_w_rkv': nrm((N_C_LAYERS, 3, D, D), D ** -0.5),
        'rwkv_w_w1': nrm((N_C_LAYERS, D, C_DECAY_RANK), D ** -0.5),
        'rwkv_w_w2': nrm((N_C_LAYERS, C_DECAY_RANK, D), 0.2),
        'rwkv_w0': -2.0 + nrm((N_C_LAYERS, D), 0.5),
        'rwkv_a_w1': nrm((N_C_LAYERS, D, C_AAA_RANK), D ** -0.5),
        'rwkv_a_w2': nrm((N_C_LAYERS, C_AAA_RANK, D), 0.2),
        'rwkv_a0': nrm((N_C_LAYERS, D), 0.1),
        'rwkv_g_w1': nrm((N_C_LAYERS, D, C_GATE_RANK), D ** -0.5),
        'rwkv_g_w2': nrm((N_C_LAYERS, C_GATE_RANK, D), C_GATE_RANK ** -0.5),
        'rwkv_k_k': 0.85 + nrm((N_C_LAYERS, D), 0.02),
        'rwkv_k_a': gain((N_C_LAYERS, D)),
        'rwkv_r_k': nrm((N_C_LAYERS, C_HEADS, C_HEAD), 0.1),
        'rwkv_ln_g': gain((N_C_LAYERS, D)),
        'rwkv_ln_b': nrm((N_C_LAYERS, D), 0.01),
        'w_out_c': nrm((N_C_LAYERS, D, D), D ** -0.5),
        'norm1_g': gain((DEPTH, D)),
        'norm2_g': gain((DEPTH, D)),
        'final_g': gain((D,)),
        'peer_w_q': nrm((DEPTH, D, PEER_HEADS * PEER_QUERY), D ** -0.5),
        'peer_sub_keys': nrm((DEPTH, PEER_HEADS, 2, PEER_N_KEYS, PEER_SUBKEY), PEER_SUBKEY ** -0.5),
        'peer_u': nrm((DEPTH, PEER_N_EXPERTS, D), D ** -0.5),
        'peer_v': nrm((DEPTH, PEER_N_EXPERTS, D), 0.1),
    }


def reference(x_prompt, x_sample, state_hgrn, state_gla, state_rwkv, state_shift,
              w_in_ab, hgrn_lower_bounds, hgrn_norm_g, gla_gate_w2, gla_gate_b, gla_norm_g, w_out_ab,
              rwkv_mu, rwkv_w_rkv, rwkv_w_w1, rwkv_w_w2, rwkv_w0, rwkv_a_w1, rwkv_a_w2, rwkv_a0,
              rwkv_g_w1, rwkv_g_w2, rwkv_k_k, rwkv_k_a, rwkv_r_k, rwkv_ln_g, rwkv_ln_b, w_out_c,
              norm1_g, norm2_g, final_g, peer_w_q, peer_sub_keys, peer_u, peer_v):
    lbs = jnp.cumsum(jax.nn.softmax(hgrn_lower_bounds.astype(jnp.float32), axis=0), axis=0)

    def trunk(x, st_h, st_g, st_r, st_s):
        out_h, out_g, out_r, out_s = [], [], [], []
        for l in range(DEPTH):
            j = l // 2
            hn = rms_norm(x, norm1_g[l])
            if l % 2 == 0:
                y, sh, sg = hgrn2_gla_mixer(hn, st_h[j], st_g[j], w_in_ab[j], lbs[l], hgrn_norm_g[j],
                                            gla_gate_w2[j], gla_gate_b[j], gla_norm_g[j], w_out_ab[j])
                out_h.append(sh)
                out_g.append(sg)
            else:
                y, sr, ss = rwkv7_mixer(hn, st_r[j], st_s[j], rwkv_mu[j], rwkv_w_rkv[j], rwkv_w_w1[j],
                                        rwkv_w_w2[j], rwkv_w0[j], rwkv_a_w1[j], rwkv_a_w2[j], rwkv_a0[j],
                                        rwkv_g_w1[j], rwkv_g_w2[j], rwkv_k_k[j], rwkv_k_a[j], rwkv_r_k[j],
                                        rwkv_ln_g[j], rwkv_ln_b[j], w_out_c[j])
                out_r.append(sr)
                out_s.append(ss)
            x = x + y.astype(x.dtype)
            x = x + peer_ffn(rms_norm(x, norm2_g[l]), peer_w_q[l], peer_sub_keys[l],
                             peer_u[l], peer_v[l]).astype(x.dtype)
        return rms_norm(x, final_g), jnp.stack(out_h), jnp.stack(out_g), jnp.stack(out_r), jnp.stack(out_s)

    bp = x_prompt.shape[0]
    z_h = jnp.zeros((N_AB_LAYERS, bp, A_HEADS, A_HEAD, A_HEAD), jnp.float32)
    z_g = jnp.zeros((N_AB_LAYERS, bp, B_HEADS, B_DK, B_DV), jnp.float32)
    z_r = jnp.zeros((N_C_LAYERS, bp, C_HEADS, C_HEAD, C_HEAD), jnp.float32)
    z_s = jnp.zeros((N_C_LAYERS, bp, D_MODEL), x_prompt.dtype)
    y_prompt, p_hgrn, p_gla, p_rwkv, p_shift = trunk(x_prompt, z_h, z_g, z_r, z_s)
    y_sample, s_hgrn, s_gla, s_rwkv, s_shift = trunk(x_sample, state_hgrn, state_gla, state_rwkv, state_shift)
    return (y_prompt, y_sample, p_hgrn, p_gla, p_rwkv, p_shift, s_hgrn, s_gla, s_rwkv, s_shift)
```

```cpp
#include <hip/hip_runtime.h>
#include <hip/hip_cooperative_groups.h>
#include <cstdio>
namespace cg = cooperative_groups;

#ifndef MEGA
#define MEGA 1
#endif

#define DI __device__ __forceinline__
typedef unsigned short bf16_t;
typedef short bf16x8 __attribute__((ext_vector_type(8)));
typedef float f32x16 __attribute__((ext_vector_type(16)));
typedef _Float16 half8 __attribute__((ext_vector_type(8)));
typedef unsigned u32x4 __attribute__((ext_vector_type(4)));
typedef unsigned u32x2 __attribute__((ext_vector_type(2)));
typedef float f32x2 __attribute__((ext_vector_type(2)));

constexpr int NT = 66048;
constexpr int NPR = 65536;
constexpr size_t U = (size_t)NT * 1024 * 2;
constexpr int LDS_BYTES = 77824;

constexpr size_t S0 = 0, S1 = U, S2 = 2 * U, S3 = 3 * U, S4 = 4 * U, S5 = 5 * U, S6 = 6 * U;
constexpr size_t OFF_HA = S0;
constexpr size_t OFF_QA = S1, OFF_F = S1 + U / 2, OFF_VA = S1 + U / 2 + U, OFF_GA = S1 + 2 * U, OFF_QB = S1 + 2 * U + U / 2,
                 OFF_KB = OFF_QB + U / 4, OFF_VB = S1 + 3 * U, OFF_GB = OFF_VB + U / 2, OFF_LR = S1 + 4 * U;
constexpr size_t OFF_ORAW = S6;
constexpr size_t OFF_EBL = S5 + (size_t)8 * 1024 * 1024, OFF_KTA = S5 + U / 4, OFF_KTB = OFF_KTA + U / 2;
constexpr size_t OFF_QP = S1;
constexpr size_t OFF_EIDX = S3, OFF_GATE = S3 + U / 4;
constexpr size_t OFF_HP = S1, OFF_SSP = S4;
constexpr size_t OFF_R = S1, OFF_K = S2, OFF_V = S3, OFF_DEC = S4, OFF_AA = S5, OFF_GG = S6, OFF_ORAW2 = S0, OFF_A5 = S4;
constexpr size_t OFF_TAB = 7 * U;
constexpr size_t TAB_BYTES = (size_t)16384 * 1024 * 2;
constexpr size_t OFF_U8 = OFF_TAB, OFF_V8 = OFF_TAB + (size_t)16384 * 1024, OFF_USC = OFF_V8 + (size_t)16384 * 1024, OFF_VSC = OFF_USC + 65536;
constexpr size_t OFF_W1 = OFF_TAB, OFF_A1 = OFF_W1 + (size_t)NT * 64 * 2, OFF_G1 = OFF_A1 + (size_t)NT * 64 * 2,
                 OFF_BON = OFF_G1 + (size_t)NT * 128 * 2;
constexpr size_t OFF_W = OFF_TAB + 2 * TAB_BYTES;
constexpr size_t OFF_WT_IN = OFF_W;
constexpr size_t OFF_WT_OUTAB = OFF_WT_IN + (size_t)3712 * 1024 * 2;
constexpr size_t OFF_WT_RK = OFF_WT_OUTAB + (size_t)1024 * 1024 * 2;
constexpr size_t OFF_WT_W2 = OFF_WT_RK + (size_t)3456 * 1024 * 2;
constexpr size_t OFF_WT_A2 = OFF_WT_W2 + (size_t)1024 * 64 * 2;
constexpr size_t OFF_WT_G2 = OFF_WT_A2 + (size_t)1024 * 64 * 2;
constexpr size_t OFF_WT_OUTC = OFF_WT_G2 + (size_t)1024 * 128 * 2;
constexpr size_t OFF_WT_Q = OFF_WT_OUTC + (size_t)1024 * 1024 * 2;
constexpr size_t OFF_SK = OFF_WT_Q + (size_t)2 * 2048 * 1024 * 2;
constexpr size_t OFF_LBS = OFF_SK + (size_t)2 * 16 * 128 * 128 * 2;
constexpr size_t OFF_GBAR = OFF_LBS + 2048;
constexpr size_t WS_END = OFF_GBAR + 256;

constexpr size_t O_PH = 67633152, O_PG = 68681728, O_PR = 69206016, O_PS = 70254592,
                 O_SH = 70270976, O_SG = 71319552, O_SR = 71843840, O_SS = 72892416;

struct Params { const float* in[36]; float* out; unsigned char* ws; };

enum { I_XP = 0, I_XS, I_SH, I_SG, I_SR, I_SS, I_WIN, I_LB, I_HNG, I_GW2, I_GB, I_GNG, I_WOUTAB, I_MU, I_WRKV, I_WW1, I_WW2, I_W0,
       I_AW1, I_AW2, I_A0, I_GW1, I_GWW2, I_KK, I_KA, I_RK, I_LNG, I_LNB, I_WOUTC, I_N1, I_N2, I_FG, I_PWQ, I_PSK, I_PU, I_PV };

DI float bf2f(bf16_t u) { return __uint_as_float(((unsigned)u) << 16); }
DI unsigned pack2(float lo, float hi) { unsigned r; asm("v_cvt_pk_bf16_f32 %0, %1, %2" : "=v"(r) : "v"(lo), "v"(hi)); return r; }
DI bf16_t f2bf(float x) { return (bf16_t)(pack2(x, 0.f) & 0xffffu); }
DI float lo2f(unsigned p) { return __uint_as_float(p << 16); }
DI float hi2f(unsigned p) { return __uint_as_float(p & 0xffff0000u); }
DI void unpack8(const u32x4& q, float* f) { f[0] = lo2f(q.x); f[1] = hi2f(q.x); f[2] = lo2f(q.y); f[3] = hi2f(q.y); f[4] = lo2f(q.z); f[5] = hi2f(q.z); f[6] = lo2f(q.w); f[7] = hi2f(q.w); }
DI u32x4 pack8(const float* f) { u32x4 q; q.x = pack2(f[0], f[1]); q.y = pack2(f[2], f[3]); q.z = pack2(f[4], f[5]); q.w = pack2(f[6], f[7]); return q; }
DI float sigmoidf_(float x) { return 1.f / (1.f + __expf(-x)); }
DI float siluf_(float x) { return x / (1.f + __expf(-x)); }
DI float wave_sum(float v) {
  v += __uint_as_float(__builtin_amdgcn_update_dpp(0, __float_as_uint(v), 0xB1, 0xF, 0xF, true));
  v += __uint_as_float(__builtin_amdgcn_update_dpp(0, __float_as_uint(v), 0x4E, 0xF, 0xF, true));
  v += __uint_as_float(__builtin_amdgcn_update_dpp(0, __float_as_uint(v), 0x141, 0xF, 0xF, true));
  v += __uint_as_float(__builtin_amdgcn_update_dpp(0, __float_as_uint(v), 0x140, 0xF, 0xF, true));
  v += __uint_as_float(__builtin_amdgcn_update_dpp(0, __float_as_uint(v), 0x142, 0xA, 0xF, false));
  v += __uint_as_float(__builtin_amdgcn_update_dpp(0, __float_as_uint(v), 0x143, 0xC, 0xF, false));
  return __uint_as_float(__builtin_amdgcn_readlane(__float_as_uint(v), 63));
}
DI int crow(int reg, int h) { return (reg & 3) + 8 * (reg >> 2) + 4 * h; }
#define MFMA(a, b, c) __builtin_amdgcn_mfma_f32_32x32x16_bf16((a), (b), (c), 0, 0, 0)

DI int seq_row0(int s) { return s < 16 ? s * 4096 : NPR + (s - 16) * 32; }
DI int seq_len(int s) { return s < 16 ? 4096 : 32; }

struct LoadBf16 {
  const bf16_t* A; int lda;
  DI void stage(int row, int k, u32x4& a, u32x4& b) const { a = *(const u32x4*)(A + (size_t)row * lda + k); b = a; }
  DI u32x4 finish(const u32x4& a, const u32x4& b, int k) const { return a; }
};
struct LoadShiftMix {
  const bf16_t* H; const float* mu; const float* xlast;
  DI void stage(int row, int k, u32x4& a, u32x4& b) const {
    a = *(const u32x4*)(H + (size_t)row * 1024 + k);
    const bool first = row < NPR ? ((row & 4095) == 0) : (((row - NPR) & 31) == 0);
    if (!first) b = *(const u32x4*)(H + (size_t)(row - 1) * 1024 + k);
    else if (row >= NPR) {
      const float* xl = xlast + (size_t)((row - NPR) >> 5) * 1024 + k;
      const float4 x0 = *(const float4*)xl, x1 = *(const float4*)(xl + 4);
      const float pv[8] = {x0.x, x0.y, x0.z, x0.w, x1.x, x1.y, x1.z, x1.w};
      b = pack8(pv);
    } else b = (u32x4){0u, 0u, 0u, 0u};
  }
  DI u32x4 finish(const u32x4& a, const u32x4& b, int k) const {
    float hv[8], pv[8], o[8];
    unpack8(a, hv); unpack8(b, pv);
    const float4 m0 = *(const float4*)(mu + k), m1 = *(const float4*)(mu + k + 4);
    const float mv[8] = {m0.x, m0.y, m0.z, m0.w, m1.x, m1.y, m1.z, m1.w};
#pragma unroll
    for (int i = 0; i < 8; ++i) o[i] = hv[i] + (pv[i] - hv[i]) * mv[i];
    return pack8(o);
  }
};

template <int BK, class AL>
DI void gemm_tile(const AL& al, const bf16_t* __restrict__ Bt, int ldb, int K, int m0, int n0, f32x16 (&acc)[2][2], bf16_t* As) {
  constexpr int LDK = BK + 8, CPR = BK / 8, NL = BK / 16, RSTEP = 256 / CPR;
  bf16_t* Bs = As + 128 * LDK;
  const int tid = threadIdx.x, lane = tid & 63, w = tid >> 6, wm = w >> 1, wn = w & 1;
#pragma unroll
  for (int mi = 0; mi < 2; ++mi)
#pragma unroll
    for (int ni = 0; ni < 2; ++ni)
#pragma unroll
      for (int r = 0; r < 16; ++r) acc[mi][ni][r] = 0.f;
  u32x4 ra[NL], ra2[NL], rb[NL];
  const int lr = tid / CPR, lk = (tid % CPR) * 8;
#pragma unroll
  for (int j = 0; j < NL; ++j) { al.stage(m0 + lr + RSTEP * j, lk, ra[j], ra2[j]); rb[j] = *(const u32x4*)(Bt + (size_t)(n0 + lr + RSTEP * j) * ldb + lk); }
  const int nk = K / BK;
  const int frow = lane & 31, fk = (lane >> 5) * 8;
  for (int kt = 0; kt < nk; ++kt) {
    __syncthreads();
#pragma unroll
    for (int j = 0; j < NL; ++j) { *(u32x4*)(As + (lr + RSTEP * j) * LDK + lk) = al.finish(ra[j], ra2[j], kt * BK + lk); *(u32x4*)(Bs + (lr + RSTEP * j) * LDK + lk) = rb[j]; }
    __syncthreads();
    if (kt + 1 < nk) {
      const int k0 = (kt + 1) * BK;
#pragma unroll
      for (int j = 0; j < NL; ++j) { al.stage(m0 + lr + RSTEP * j, k0 + lk, ra[j], ra2[j]); rb[j] = *(const u32x4*)(Bt + (size_t)(n0 + lr + RSTEP * j) * ldb + k0 + lk); }
    }
    __builtin_amdgcn_sched_barrier(0);
#pragma unroll
    for (int kk = 0; kk < BK / 16; ++kk) {
      bf16x8 af[2], bfr[2];
#pragma unroll
      for (int mi = 0; mi < 2; ++mi) af[mi] = *(const bf16x8*)(As + (wm * 64 + mi * 32 + frow) * LDK + kk * 16 + fk);
#pragma unroll
      for (int ni = 0; ni < 2; ++ni) bfr[ni] = *(const bf16x8*)(Bs + (wn * 64 + ni * 32 + frow) * LDK + kk * 16 + fk);
#pragma unroll
      for (int mi = 0; mi < 2; ++mi)
#pragma unroll
        for (int ni = 0; ni < 2; ++ni) acc[mi][ni] = MFMA(bfr[ni], af[mi], acc[mi][ni]);
    }
  }
}

template <class AL>
DI void gemm_tile_db(const AL& al, const bf16_t* __restrict__ Bt, int ldb, int K, int m0, int n0, f32x16 (&acc)[2][2], bf16_t* smem) {
  constexpr int LDK = 72, TB = 128 * LDK;
  const int tid = threadIdx.x, lane = tid & 63, w = tid >> 6, wm = w >> 1, wn = w & 1;
#pragma unroll
  for (int mi = 0; mi < 2; ++mi)
#pragma unroll
    for (int ni = 0; ni < 2; ++ni)
#pragma unroll
      for (int r = 0; r < 16; ++r) acc[mi][ni][r] = 0.f;
  u32x4 ra0[4], rc0[4], rb0[4], ra1[4], rc1[4], rb1[4];
  const int lr = tid >> 3, lk = (tid & 7) * 8;
  const int nk = K >> 6;
  const int frow = lane & 31, fk = (lane >> 5) * 8;
  const bf16_t* Bp = Bt + (size_t)(n0 + lr) * ldb + lk;
#define GDB_STAGE(RA, RC, RB, kt_)                                                                                     \
  {                                                                                                                    \
    _Pragma("unroll") for (int j = 0; j < 4; ++j) {                                                                    \
      al.stage(m0 + lr + 32 * j, (kt_) * 64 + lk, RA[j], RC[j]);                                                       \
      RB[j] = *(const u32x4*)(Bp + (size_t)(32 * j) * ldb + (kt_) * 64);                                               \
    }                                                                                                                  \
  }
#define GDB_WRITE(RA, RC, RB, kt_, buf_)                                                                               \
  {                                                                                                                    \
    bf16_t* Aw = smem + (buf_) * 2 * TB; bf16_t* Bw = Aw + TB;                                                         \
    _Pragma("unroll") for (int j = 0; j < 4; ++j) {                                                                    \
      *(u32x4*)(Aw + (lr + 32 * j) * LDK + lk) = al.finish(RA[j], RC[j], (kt_) * 64 + lk);                            \
      *(u32x4*)(Bw + (lr + 32 * j) * LDK + lk) = RB[j];                                                                \
    }                                                                                                                  \
  }
#define GDB_KK(buf_, kk_)                                                                                              \
  {                                                                                                                    \
    const bf16_t* Ar = smem + (buf_) * 2 * TB; const bf16_t* Br = Ar + TB;                                             \
    bf16x8 af[2], bfr[2];                                                                                              \
    _Pragma("unroll") for (int mi = 0; mi < 2; ++mi) af[mi] = *(const bf16x8*)(Ar + (wm * 64 + mi * 32 + frow) * LDK + (kk_) * 16 + fk);  \
    _Pragma("unroll") for (int ni = 0; ni < 2; ++ni) bfr[ni] = *(const bf16x8*)(Br + (wn * 64 + ni * 32 + frow) * LDK + (kk_) * 16 + fk); \
    _Pragma("unroll") for (int mi = 0; mi < 2; ++mi)                                                                   \
      _Pragma("unroll") for (int ni = 0; ni < 2; ++ni) acc[mi][ni] = MFMA(bfr[ni], af[mi], acc[mi][ni]);               \
  }
#define GDB_ITER(kt_, cur_, RAn, RCn, RBn)                                                                             \
  {                                                                                                                    \
    GDB_KK(cur_, 0)                                                                                                    \
    if ((kt_) + 1 < nk) GDB_WRITE(RAn, RCn, RBn, (kt_) + 1, (cur_) ^ 1)                                                \
    if ((kt_) + 3 < nk) GDB_STAGE(RAn, RCn, RBn, (kt_) + 3)                                                            \
    GDB_KK(cur_, 1) GDB_KK(cur_, 2) GDB_KK(cur_, 3)                                                                    \
    __syncthreads();                                                                                                   \
  }
  GDB_STAGE(ra0, rc0, rb0, 0)
  if (nk > 1) GDB_STAGE(ra1, rc1, rb1, 1)
  __syncthreads();
  GDB_WRITE(ra0, rc0, rb0, 0, 0)
  if (nk > 2) GDB_STAGE(ra0, rc0, rb0, 2)
  __syncthreads();
  for (int kt = 0; kt < nk; kt += 2) {
    GDB_ITER(kt, 0, ra1, rc1, rb1)
    if (kt + 1 < nk) GDB_ITER(kt + 1, 1, ra0, rc0, rb0)
  }
#undef GDB_STAGE
#undef GDB_WRITE
#undef GDB_KK
#undef GDB_ITER
}

template <class E>
DI void epilogue(const f32x16 (&acc)[2][2], int m0, int n0, E&& e, float* Cs) {
  const int tid = threadIdx.x, lane = tid & 63, w = tid >> 6, wm = w >> 1, wn = w & 1;
  __syncthreads();
#pragma unroll
  for (int mi = 0; mi < 2; ++mi)
#pragma unroll
    for (int ni = 0; ni < 2; ++ni)
#pragma unroll
      for (int g = 0; g < 4; ++g) {
        const int row = wm * 64 + mi * 32 + (lane & 31);
        const int col = wn * 64 + ni * 32 + 8 * g + 4 * (lane >> 5);
        *(float4*)(Cs + row * 132 + col) = make_float4(acc[mi][ni][4 * g], acc[mi][ni][4 * g + 1], acc[mi][ni][4 * g + 2], acc[mi][ni][4 * g + 3]);
      }
  __syncthreads();
#pragma unroll 4
  for (int it = 0; it < 16; ++it) {
    const int idx = tid + 256 * it, row = idx >> 5, col = (idx & 31) * 4;
    const float4 v = *(const float4*)(Cs + row * 132 + col);
    e(m0 + row, n0 + col, v.x, v.y, v.z, v.w);
  }
}

template <class F>
DI void for_tiles(int nM, int nN, F&& f) {
  const int x = blockIdx.x & 7, s = blockIdx.x >> 3, slots = gridDim.x >> 3;
  const int nFull = nN >> 3, wd = nN & 7, nRG8 = (nM + 7) >> 3, hr = wd ? 64 / wd : 1, cntP = wd ? (nM + hr - 1) / hr : 0;
  const int nSTf = nFull * nRG8, nST = nSTf + cntP;
  for (int e = s;; e += slots) {
    const int st = (e >> 6) * 8 + x;
    if (st >= nST) break;
    const int wi = e & 63;
    int tm, tn; bool ok;
    if (st < nSTf) { const int rg = st / nFull, cgi = st - rg * nFull; tm = rg * 8 + (wi & 7); tn = cgi * 8 + (wi >> 3); ok = tm < nM; }
    else { const int idx = st - nSTf, q = wi / hr; tm = idx * hr + (wi - q * hr); tn = nFull * 8 + q; ok = (q < wd) && (tm < nM); }
    if (ok) f(tm, tn);
  }
}

DI void st_bf4(bf16_t* p, float a, float b, float c, float d) { u32x2 q; q.x = pack2(a, b); q.y = pack2(c, d); *(u32x2*)p = q; }

DI void transpose_cvt(const float* __restrict__ W, int K, int N, bf16_t* __restrict__ Wt, int Npad, float* tile) {
  const int tK = K >> 5, tN = Npad >> 5;
  const int tx = threadIdx.x & 31, ty = threadIdx.x >> 5;
  for (int t = blockIdx.x; t < tK * tN; t += gridDim.x) {
    const int tk = t % tK, tn = t / tK;
    __syncthreads();
#pragma unroll
    for (int i = 0; i < 4; ++i) { const int k = tk * 32 + ty + 8 * i, n = tn * 32 + tx; tile[(ty + 8 * i) * 33 + tx] = (n < N) ? W[(size_t)k * N + n] : 0.f; }
    __syncthreads();
#pragma unroll
    for (int i = 0; i < 4; ++i) { const int n = tn * 32 + ty + 8 * i, k = tk * 32 + tx; Wt[(size_t)n * K + k] = f2bf(tile[tx * 33 + ty + 8 * i]); }
  }
}
DI void cvt_bf16(const float* __restrict__ src, bf16_t* __restrict__ dst, size_t n) {
  const size_t stride = (size_t)gridDim.x * 256 * 8;
  for (size_t i = ((size_t)blockIdx.x * 256 + threadIdx.x) * 8; i < n; i += stride) {
    float4 a = *(const float4*)(src + i), b = *(const float4*)(src + i + 4);
    float f[8] = {a.x, a.y, a.z, a.w, b.x, b.y, b.z, b.w};
    *(u32x4*)(dst + i) = pack8(f);
  }
}

DI void cvt_fp8_rows(const float* __restrict__ src, unsigned char* __restrict__ dst, float* __restrict__ scale) {
  const int lane = threadIdx.x & 63, gw = blockIdx.x * 4 + (threadIdx.x >> 6), nw = gridDim.x * 4;
  for (int row = gw; row < 16384; row += nw) {
    float4 v[4]; float m = 0.f;
#pragma unroll
    for (int j = 0; j < 4; ++j) { v[j] = *(const float4*)(src + (size_t)row * 1024 + lane * 4 + 256 * j); m = fmaxf(m, fmaxf(fmaxf(fabsf(v[j].x), fabsf(v[j].y)), fmaxf(fabsf(v[j].z), fabsf(v[j].w)))); }
    for (int o = 32; o > 0; o >>= 1) m = fmaxf(m, __shfl_xor(m, o));
    const float sc = m > 0.f ? m * (1.f / 224.f) : 1.f, inv = 1.f / sc;
#pragma unroll
    for (int j = 0; j < 4; ++j) {
      int q = 0;
      q = __builtin_amdgcn_cvt_pk_fp8_f32(v[j].x * inv, v[j].y * inv, q, false);
      q = __builtin_amdgcn_cvt_pk_fp8_f32(v[j].z * inv, v[j].w * inv, q, true);
      *(int*)(dst + ((size_t)(2 * j + (lane >> 5)) * 16384 + row) * 128 + ((lane * 4) & 127)) = q;
    }
    if (lane == 0) scale[row] = sc;
  }
}
DI void rmsnorm_rows(const Params& p, const float* __restrict__ X, bool from_input, const float* __restrict__ g, bf16_t* __restrict__ out) {
  const int lane = threadIdx.x & 63, gw = blockIdx.x * 4 + (threadIdx.x >> 6), nw = gridDim.x * 4;
  float4 gv[4];
#pragma unroll
  for (int j = 0; j < 4; ++j) gv[j] = *(const float4*)(g + lane * 4 + 256 * j);
  for (int row = gw; row < NT; row += nw) {
    const float* xr;
    if (from_input) xr = row < NPR ? p.in[I_XP] + (size_t)row * 1024 : p.in[I_XS] + (size_t)(row - NPR) * 1024;
    else xr = X + (size_t)row * 1024;
    float4 v[4]; float ss = 0.f;
#pragma unroll
    for (int j = 0; j < 4; ++j) { v[j] = *(const float4*)(xr + lane * 4 + 256 * j); ss += v[j].x * v[j].x + v[j].y * v[j].y + v[j].z * v[j].z + v[j].w * v[j].w; }
    ss = wave_sum(ss);
    const float rs = rsqrtf(ss * (1.f / 1024.f) + 1e-6f);
#pragma unroll
    for (int j = 0; j < 4; ++j) st_bf4(out + (size_t)row * 1024 + lane * 4 + 256 * j, v[j].x * rs * gv[j].x, v[j].y * rs * gv[j].y, v[j].z * rs * gv[j].z, v[j].w * rs * gv[j].w);
  }
}

DI void phase0(const Params& p, unsigned char* smem) {
  float* tile = (float*)smem;
  unsigned char* ws = p.ws;
  transpose_cvt(p.in[I_WIN], 1024, 3600, (bf16_t*)(ws + OFF_WT_IN), 3712, tile);
  transpose_cvt(p.in[I_WOUTAB], 1024, 1024, (bf16_t*)(ws + OFF_WT_OUTAB), 1024, tile);
  bf16_t* wrk = (bf16_t*)(ws + OFF_WT_RK);
  for (int i = 0; i < 3; ++i) transpose_cvt(p.in[I_WRKV] + (size_t)i * 1024 * 1024, 1024, 1024, wrk + (size_t)i * 1024 * 1024, 1024, tile);
  transpose_cvt(p.in[I_WW1], 1024, 64, wrk + (size_t)3072 * 1024, 128, tile);
  transpose_cvt(p.in[I_AW1], 1024, 64, wrk + (size_t)3200 * 1024, 128, tile);
  transpose_cvt(p.in[I_GW1], 1024, 128, wrk + (size_t)3328 * 1024, 128, tile);
  transpose_cvt(p.in[I_WW2], 64, 1024, (bf16_t*)(ws + OFF_WT_W2), 1024, tile);
  transpose_cvt(p.in[I_AW2], 64, 1024, (bf16_t*)(ws + OFF_WT_A2), 1024, tile);
  transpose_cvt(p.in[I_GWW2], 128, 1024, (bf16_t*)(ws + OFF_WT_G2), 1024, tile);
  transpose_cvt(p.in[I_WOUTC], 1024, 1024, (bf16_t*)(ws + OFF_WT_OUTC), 1024, tile);
  for (int l = 0; l < 2; ++l) transpose_cvt(p.in[I_PWQ] + (size_t)l * 1024 * 2048, 1024, 2048, (bf16_t*)(ws + OFF_WT_Q) + (size_t)l * 2048 * 1024, 2048, tile);
  cvt_bf16(p.in[I_PSK], (bf16_t*)(ws + OFF_SK), (size_t)2 * 16 * 128 * 128);
  cvt_fp8_rows(p.in[I_PU], ws + OFF_U8, (float*)(ws + OFF_USC));
  cvt_fp8_rows(p.in[I_PV], ws + OFF_V8, (float*)(ws + OFF_VSC));
  if (blockIdx.x == 0) {
    float* lbs = (float*)(ws + OFF_LBS);
    for (int c = threadIdx.x; c < 512; c += 256) {
      const float a0 = p.in[I_LB][c], a1 = p.in[I_LB][512 + c], a2 = p.in[I_LB][1024 + c];
      const float m = fmaxf(a0, fmaxf(a1, a2));
      const float e0 = expf(a0 - m), e1 = expf(a1 - m), e2 = expf(a2 - m);
      lbs[c] = e0 / (e0 + e1 + e2);
    }
  }
  rmsnorm_rows(p, nullptr, true, p.in[I_N1], (bf16_t*)(ws + OFF_HA));
}

DI void phase1(const Params& p, unsigned char* smem) {
  unsigned char* ws = p.ws;
  bf16_t* As = (bf16_t*)smem;
  const float* lbs = (const float*)(ws + OFF_LBS);
  bf16_t* QA = (bf16_t*)(ws + OFF_QA); float* F = (float*)(ws + OFF_F); bf16_t* VA = (bf16_t*)(ws + OFF_VA); bf16_t* GA = (bf16_t*)(ws + OFF_GA);
  bf16_t* QB = (bf16_t*)(ws + OFF_QB); bf16_t* KB = (bf16_t*)(ws + OFF_KB); bf16_t* VB = (bf16_t*)(ws + OFF_VB); bf16_t* GB = (bf16_t*)(ws + OFF_GB);
  float* LR = (float*)(ws + OFF_LR);
  for_tiles(NT / 128, 29, [&](int tm, int tn) {
    f32x16 acc[2][2];
    gemm_tile_db(LoadBf16{(const bf16_t*)(ws + OFF_HA), 1024}, (const bf16_t*)(ws + OFF_WT_IN), 1024, 1024, tm * 128, tn * 128, acc, As);
    epilogue(acc, tm * 128, tn * 128, [&](int row, int col, float a, float b, float c, float d) {
      if (col < 512) st_bf4(QA + (size_t)row * 512 + col, siluf_(a), siluf_(b), siluf_(c), siluf_(d));
      else if (col < 1024) {
        const int cc = col - 512; const float4 lb = *(const float4*)(lbs + cc);
        float4 o; o.x = lb.x + (1.f - lb.x) * sigmoidf_(a); o.y = lb.y + (1.f - lb.y) * sigmoidf_(b); o.z = lb.z + (1.f - lb.z) * sigmoidf_(c); o.w = lb.w + (1.f - lb.w) * sigmoidf_(d);
        *(float4*)(F + (size_t)row * 512 + cc) = o;
      } else if (col < 1536) st_bf4(VA + (size_t)row * 512 + col - 1024, a, b, c, d);
      else if (col < 2048) st_bf4(GA + (size_t)row * 512 + col - 1536, siluf_(a), siluf_(b), siluf_(c), siluf_(d));
      else if (col < 2304) st_bf4(QB + (size_t)row * 256 + col - 2048, a * 0.125f, b * 0.125f, c * 0.125f, d * 0.125f);
      else if (col < 2560) st_bf4(KB + (size_t)row * 256 + col - 2304, a, b, c, d);
      else if (col < 3072) st_bf4(VB + (size_t)row * 512 + col - 2560, a, b, c, d);
      else if (col < 3088) { float4 o = {a, b, c, d}; *(float4*)(LR + (size_t)row * 16 + col - 3072) = o; }
      else if (col < 3600) st_bf4(GB + (size_t)row * 512 + col - 3088, siluf_(a), siluf_(b), siluf_(c), siluf_(d));
    }, (float*)smem);
  });
}

DI int chunk_index(int seq, int c) { return seq < 16 ? seq * 64 + c : 1024 + (seq - 16); }
template <int K, bool GLA>
DI void pre_unit(const Params& p, int seq, int c, int head, unsigned char* smem) {
  constexpr int NPART = 256 / K, TPER = 64 / NPART;
  unsigned char* ws = p.ws;
  float* part = (float*)smem;
  const int tid = threadIdx.x, k = tid % K, tp = tid / K;
  const int row0 = seq_row0(seq), T = seq_len(seq);
  bf16_t* qsrc; const float* fsrc = nullptr; const bf16_t* ksrc = nullptr; bf16_t* kdst; int ldq;
  float w2c[16]; float gbias = 0.f;
  if (!GLA) {
    qsrc = (bf16_t*)(ws + OFF_QA) + head * 128 + k; fsrc = (const float*)(ws + OFF_F) + head * 128 + k; ldq = 512;
    kdst = (bf16_t*)(ws + OFF_KTA) + head * 128 + k;
#pragma unroll
    for (int r = 0; r < 16; ++r) w2c[r] = 0.f;
  } else {
    qsrc = (bf16_t*)(ws + OFF_QB) + head * 64 + k; ksrc = (const bf16_t*)(ws + OFF_KB) + head * 64 + k; ldq = 256;
    kdst = (bf16_t*)(ws + OFF_KTB) + head * 64 + k;
#pragma unroll
    for (int r = 0; r < 16; ++r) w2c[r] = p.in[I_GW2][r * 256 + head * 64 + k];
    gbias = p.in[I_GB][head * 64 + k];
  }
  const float* LR = (const float*)(ws + OFF_LR);
  struct LD { float4 l0, l1, l2, l3; float f; unsigned short kraw, qraw; };
  auto ld_issue = [&](size_t row, LD& d, bool withq) {
    if (!GLA) d.f = fsrc[row * 512];
    else { const float4* lp = (const float4*)(LR + row * 16); d.l0 = lp[0]; d.l1 = lp[1]; d.l2 = lp[2]; d.l3 = lp[3]; d.kraw = ksrc[row * ldq]; }
    if (withq) d.qraw = qsrc[row * ldq];
  };
  auto ld_eval = [&](const LD& d, float& kval) -> float {
    if (!GLA) { kval = 1.f - d.f; return __logf(d.f); }
    const float x = gbias + d.l0.x * w2c[0] + d.l0.y * w2c[1] + d.l0.z * w2c[2] + d.l0.w * w2c[3] + d.l1.x * w2c[4] + d.l1.y * w2c[5] + d.l1.z * w2c[6] + d.l1.w * w2c[7]
                    + d.l2.x * w2c[8] + d.l2.y * w2c[9] + d.l2.z * w2c[10] + d.l2.w * w2c[11] + d.l3.x * w2c[12] + d.l3.y * w2c[13] + d.l3.z * w2c[14] + d.l3.w * w2c[15];
    kval = bf2f(d.kraw);
    return (fminf(x, 0.f) - log1pf(__expf(-fabsf(x)))) * (1.f / 16.f);
  };
  constexpr int BT = GLA ? 4 : 16;
  float run = 0.f;
#pragma unroll
  for (int t0 = 0; t0 < TPER; t0 += BT) {
    LD ld[BT];
#pragma unroll
    for (int u = 0; u < BT; ++u) { const int ta = c * 64 + tp * TPER + t0 + u; ld_issue((size_t)(row0 + (ta < T ? ta : 0)), ld[u], false); }
    __builtin_amdgcn_sched_barrier(0);
#pragma unroll
    for (int u = 0; u < BT; ++u) { const int ta = c * 64 + tp * TPER + t0 + u; float kd; const float g = ld_eval(ld[u], kd); run += (ta < T) ? g : 0.f; }
  }
  __syncthreads();
  part[tp * K + k] = run;
  __syncthreads();
  float off = 0.f, tot = 0.f;
#pragma unroll
  for (int pp = 0; pp < NPART; ++pp) { const float v = part[pp * K + k]; tot += v; if (pp < tp) off += v; }
  if (tp == 0) ((float*)(ws + OFF_EBL))[(size_t)chunk_index(seq, c) * 768 + (GLA ? 512 : 0) + head * K + k] = __expf(tot);
  run = off;
#pragma unroll
  for (int t0 = 0; t0 < TPER; t0 += BT) {
    LD ld[BT];
#pragma unroll
    for (int u = 0; u < BT; ++u) { const int ta = c * 64 + tp * TPER + t0 + u; ld_issue((size_t)(row0 + (ta < T ? ta : 0)), ld[u], true); }
    __builtin_amdgcn_sched_barrier(0);
#pragma unroll
    for (int u = 0; u < BT; ++u) {
      const int ta = c * 64 + tp * TPER + t0 + u; const bool valid = ta < T;
      const size_t row = (size_t)(row0 + (valid ? ta : 0));
      float kd; const float g = ld_eval(ld[u], kd);
      run += valid ? g : 0.f;
      if (valid) {
        qsrc[row * ldq] = f2bf(bf2f(ld[u].qraw) * __expf(run));
        kdst[row * ldq] = f2bf(kd * __expf(-run));
      }
    }
  }
}
DI void phase_pre(const Params& p, unsigned char* smem) {
  for (int it = blockIdx.x; it < 1040 * 8; it += gridDim.x) {
    const int kind = it & 1, head = (it >> 1) & 3, ci = it >> 3;
    const int seq = ci < 1024 ? (ci >> 6) : 16 + (ci - 1024), c = ci < 1024 ? (ci & 63) : 0;
    if (kind == 0) pre_unit<128, false>(p, seq, c, head, smem);
    else pre_unit<64, true>(p, seq, c, head, smem);
  }
}

template <int K, bool GLA>
DI void chunk_unit(const Params& p, int seq, int head, int vs, unsigned char* smem) {
  constexpr int KP = K + 8, KT = K / 32, NQ = K / 32, CPR = K / 8;
  unsigned char* ws = p.ws;
  bf16_t* Qs = (bf16_t*)smem;
  bf16_t* Ks = Qs + 64 * KP;
  bf16_t* KsT = Ks + 64 * KP;
  bf16_t* VT = KsT + K * 72;
  bf16_t* Am = VT + 32 * 72;
  bf16_t* ST = Am + 64 * 72;
  float* bl = (float*)(ST + 32 * KP);
  const int tid = threadIdx.x, lane = tid & 63, w = tid >> 6, hh = lane >> 5, l31 = lane & 31;
  const int row0 = seq_row0(seq), T = seq_len(seq), nch = (T + 63) >> 6;
  const bf16_t* qsrc = GLA ? (const bf16_t*)(ws + OFF_QB) + head * 64 : (const bf16_t*)(ws + OFF_QA) + head * 128;
  const bf16_t* ksrc = GLA ? (const bf16_t*)(ws + OFF_KTB) + head * 64 : (const bf16_t*)(ws + OFF_KTA) + head * 128;
  const int ldq = GLA ? 256 : 512;
  const bf16_t* vsrc = (const bf16_t*)(ws + (GLA ? OFF_VB : OFF_VA)) + head * 128 + vs * 32;
  const float* ebl = (const float*)(ws + OFF_EBL) + (GLA ? 512 : 0) + head * K;
  bf16_t* odst = (bf16_t*)(ws + OFF_ORAW) + (GLA ? 512 : 0) + head * 128 + vs * 32;
  f32x16 S;
#pragma unroll
  for (int r = 0; r < 16; ++r) S[r] = 0.f;
  float* sout; const float* sin = nullptr;
  {
    const int b = seq & 15;
    const size_t hoff = GLA ? ((size_t)(b * 4 + head) * 64) * 128 : ((size_t)(b * 4 + head) * 128) * 128;
    sout = p.out + (seq < 16 ? (GLA ? O_PG : O_PH) : (GLA ? O_SG : O_SH)) + hoff + vs * 32;
    if (seq >= 16) sin = p.in[GLA ? I_SG : I_SH] + hoff + vs * 32;
  }
  u32x4 rq[NQ], rk[NQ], rv; float rbl = 1.f;
  auto gload = [&](int c) {
#pragma unroll
    for (int j = 0; j < NQ; ++j) {
      const int cj = tid + 256 * j, t = cj / CPR, k8 = (cj % CPR) * 8, ta = c * 64 + t;
      if (ta < T) { rq[j] = *(const u32x4*)(qsrc + (size_t)(row0 + ta) * ldq + k8); rk[j] = *(const u32x4*)(ksrc + (size_t)(row0 + ta) * ldq + k8); }
      else { rq[j] = (u32x4){0u, 0u, 0u, 0u}; rk[j] = (u32x4){0u, 0u, 0u, 0u}; }
    }
    const int s = tid >> 2, vq = tid & 3, ta = c * 64 + s;
    rv = (u32x4){0u, 0u, 0u, 0u};
    if (ta < T) rv = *(const u32x4*)(vsrc + (size_t)(row0 + ta) * 512 + vq * 8);
    if (tid < K) rbl = ebl[(size_t)chunk_index(seq, c) * 768 + tid];
  };
  gload(0);
  __syncthreads();
  if (w < KT) {
    if (sin) {
#pragma unroll
      for (int r = 0; r < 16; ++r) S[r] = sin[(size_t)(w * 32 + crow(r, hh)) * 128 + l31];
    }
#pragma unroll
    for (int g = 0; g < 4; ++g) st_bf4(ST + l31 * KP + w * 32 + 8 * g + 4 * hh, S[4 * g], S[4 * g + 1], S[4 * g + 2], S[4 * g + 3]);
  }
  for (int c = 0; c < nch; ++c) {
#pragma unroll
    for (int j = 0; j < NQ; ++j) {
      const int cj = tid + 256 * j, t = cj / CPR, k8 = (cj % CPR) * 8;
      *(u32x4*)(Qs + t * KP + k8) = rq[j];
      *(u32x4*)(Ks + t * KP + k8) = rk[j];
      const unsigned kk4[4] = {rk[j].x, rk[j].y, rk[j].z, rk[j].w};
#pragma unroll
      for (int e = 0; e < 4; ++e) { KsT[(k8 + 2 * e) * 72 + t] = (bf16_t)(kk4[e] & 0xffffu); KsT[(k8 + 2 * e + 1) * 72 + t] = (bf16_t)(kk4[e] >> 16); }
    }
    {
      const int s = tid >> 2, vq = tid & 3;
      const unsigned qq[4] = {rv.x, rv.y, rv.z, rv.w};
#pragma unroll
      for (int j = 0; j < 4; ++j) { VT[(vq * 8 + 2 * j) * 72 + s] = (bf16_t)(qq[j] & 0xffffu); VT[(vq * 8 + 2 * j + 1) * 72 + s] = (bf16_t)(qq[j] >> 16); }
    }
    if (tid < K) bl[tid] = rbl;
    __syncthreads();
    if (c + 1 < nch) gload(c + 1);
    {
      const int tm = w >> 1, tn = w & 1;
      f32x16 a;
#pragma unroll
      for (int r = 0; r < 16; ++r) a[r] = 0.f;
      if (tn <= tm) {
#pragma unroll
        for (int ks = 0; ks < K / 16; ++ks) {
          const bf16x8 qf = *(const bf16x8*)(Qs + (tm * 32 + l31) * KP + ks * 16 + hh * 8);
          const bf16x8 kf = *(const bf16x8*)(Ks + (tn * 32 + l31) * KP + ks * 16 + hh * 8);
          a = MFMA(kf, qf, a);
        }
      }
      const int t = tm * 32 + l31;
#pragma unroll
      for (int g = 0; g < 4; ++g) {
        const int s0 = tn * 32 + 8 * g + 4 * hh;
        float v0 = (s0 <= t) ? a[4 * g] : 0.f, v1 = (s0 + 1 <= t) ? a[4 * g + 1] : 0.f, v2 = (s0 + 2 <= t) ? a[4 * g + 2] : 0.f, v3 = (s0 + 3 <= t) ? a[4 * g + 3] : 0.f;
        if (tn > tm) { v0 = v1 = v2 = v3 = 0.f; }
        st_bf4(Am + t * 72 + s0, v0, v1, v2, v3);
      }
    }
    if (w < KT) {
#pragma unroll
      for (int ks = 0; ks < 4; ++ks) {
        const bf16x8 af = *(const bf16x8*)(KsT + (w * 32 + l31) * 72 + ks * 16 + hh * 8);
        const bf16x8 bf = *(const bf16x8*)(VT + l31 * 72 + ks * 16 + hh * 8);
        S = MFMA(af, bf, S);
      }
    }
    __syncthreads();
    if (w < 2) {
      f32x16 o;
#pragma unroll
      for (int r = 0; r < 16; ++r) o[r] = 0.f;
#pragma unroll
      for (int ks = 0; ks < 4; ++ks) {
        const bf16x8 af = *(const bf16x8*)(Am + (w * 32 + l31) * 72 + ks * 16 + hh * 8);
        const bf16x8 bf = *(const bf16x8*)(VT + l31 * 72 + ks * 16 + hh * 8);
        o = MFMA(af, bf, o);
      }
#pragma unroll
      for (int ks = 0; ks < K / 16; ++ks) {
        const bf16x8 af = *(const bf16x8*)(Qs + (w * 32 + l31) * KP + ks * 16 + hh * 8);
        const bf16x8 bf = *(const bf16x8*)(ST + l31 * KP + ks * 16 + hh * 8);
        o = MFMA(af, bf, o);
      }
#pragma unroll
      for (int r = 0; r < 16; ++r) {
        const int ta = c * 64 + w * 32 + crow(r, hh);
        if (ta < T) odst[(size_t)(row0 + ta) * 1024 + l31] = f2bf(o[r]);
      }
    }
    __syncthreads();
    if (w < KT) {
#pragma unroll
      for (int r = 0; r < 16; ++r) S[r] *= bl[w * 32 + crow(r, hh)];
#pragma unroll
      for (int g = 0; g < 4; ++g) st_bf4(ST + l31 * KP + w * 32 + 8 * g + 4 * hh, S[4 * g], S[4 * g + 1], S[4 * g + 2], S[4 * g + 3]);
    }
    __syncthreads();
  }
  if (w < KT) {
#pragma unroll
    for (int r = 0; r < 16; ++r) sout[(size_t)(w * 32 + crow(r, hh)) * 128 + l31] = S[r];
  }
  __syncthreads();
}

DI void phase2(const Params& p, unsigned char* smem) {
  for (int u = blockIdx.x; u < 1024; u += gridDim.x) {
    const int kind = (u >> 8) & 1, idx = u & 255, seq = (idx >> 4) + (u >= 512 ? 16 : 0), head = (idx >> 2) & 3, vs = idx & 3;
    if (kind == 0) chunk_unit<128, false>(p, seq, head, vs, smem);
    else chunk_unit<64, true>(p, seq, head, vs, smem);
  }
}

DI void phase3(const Params& p, unsigned char*) {
  unsigned char* ws = p.ws;
  const int lane = threadIdx.x & 63, gw = blockIdx.x * 4 + (threadIdx.x >> 6), nw = gridDim.x * 4;
  const bf16_t* O = (const bf16_t*)(ws + OFF_ORAW);
  const bf16_t* G = (const bf16_t*)(ws + (lane < 32 ? OFF_GA : OFF_GB)) + (lane & 31) * 16;
  const float* ng = p.in[lane < 32 ? I_HNG : I_GNG] + (lane & 7) * 16;
  float gv[16];
#pragma unroll
  for (int i = 0; i < 16; ++i) gv[i] = ng[i];
  bf16_t* out = (bf16_t*)(ws + OFF_HA);
  for (int row = gw; row < NT; row += nw) {
    const u32x4 o0 = *(const u32x4*)(O + (size_t)row * 1024 + lane * 16), o1 = *(const u32x4*)(O + (size_t)row * 1024 + lane * 16 + 8);
    const u32x4 g0 = *(const u32x4*)(G + (size_t)row * 512), g1 = *(const u32x4*)(G + (size_t)row * 512 + 8);
    float ov[16], gt[16];
    unpack8(o0, ov); unpack8(o1, ov + 8); unpack8(g0, gt); unpack8(g1, gt + 8);
    float ss = 0.f;
#pragma unroll
    for (int i = 0; i < 16; ++i) ss += ov[i] * ov[i];
    ss += __shfl_xor(ss, 1); ss += __shfl_xor(ss, 2); ss += __shfl_xor(ss, 4);
    const float rs = rsqrtf(ss * (1.f / 128.f) + 1e-6f);
    float r[16];
#pragma unroll
    for (int i = 0; i < 16; ++i) r[i] = ov[i] * rs * gv[i] * gt[i];
    *(u32x4*)(out + (size_t)row * 1024 + lane * 16) = pack8(r);
    *(u32x4*)(out + (size_t)row * 1024 + lane * 16 + 8) = pack8(r + 8);
  }
}

DI void phase_outproj(const Params& p, unsigned char* smem, size_t offA, size_t offW, bool first) {
  unsigned char* ws = p.ws;
  bf16_t* As = (bf16_t*)smem;
  float* X = p.out;
  for_tiles(NT / 128, 8, [&](int tm, int tn) {
    f32x16 acc[2][2];
    gemm_tile_db(LoadBf16{(const bf16_t*)(ws + offA), 1024}, (const bf16_t*)(ws + offW), 1024, 1024, tm * 128, tn * 128, acc, As);
    epilogue(acc, tm * 128, tn * 128, [&](int row, int col, float a, float b, float c, float d) {
      const float* src = first ? (row < NPR ? p.in[I_XP] + (size_t)row * 1024 + col : p.in[I_XS] + (size_t)(row - NPR) * 1024 + col) : X + (size_t)row * 1024 + col;
      float4 x = *(const float4*)src;
      x.x += a; x.y += b; x.z += c; x.w += d;
      *(float4*)(X + (size_t)row * 1024 + col) = x;
    }, (float*)smem);
  });
}

DI void phase_norm2(const Params& p, int layer) { rmsnorm_rows(p, p.out, false, p.in[I_N2] + layer * 1024, (bf16_t*)(p.ws + OFF_HA)); }

DI void phase_qp(const Params& p, unsigned char* smem, int layer) {
  unsigned char* ws = p.ws;
  bf16_t* As = (bf16_t*)smem;
  bf16_t* QP = (bf16_t*)(ws + OFF_QP);
  for_tiles(NT / 128, 16, [&](int tm, int tn) {
    f32x16 acc[2][2];
    gemm_tile_db(LoadBf16{(const bf16_t*)(ws + OFF_HA), 1024}, (const bf16_t*)(ws + OFF_WT_Q) + (size_t)layer * 2048 * 1024, 1024, 1024, tm * 128, tn * 128, acc, As);
    epilogue(acc, tm * 128, tn * 128, [&](int row, int col, float a, float b, float c, float d) { st_bf4(QP + (size_t)row * 2048 + col, a, b, c, d); }, (float*)smem);
  });
}

DI unsigned f2key(float f, int idx) { unsigned u = __float_as_uint(f); u = (u & 0x80000000u) ? ~u : (u | 0x80000000u); return (u & ~127u) | (unsigned)(127 - idx); }
DI float key2f(unsigned k) { k &= ~127u; const unsigned u = (k & 0x80000000u) ? (k & 0x7fffffffu) : ~k; return __uint_as_float(u); }
DI void phase_route(const Params& p, unsigned char* smem, int layer) {
  unsigned char* ws = p.ws;
  bf16_t* As = (bf16_t*)smem;
  unsigned* sk = (unsigned*)smem;
  float* lv = (float*)smem;
  int* li = (int*)(smem + 16384);
  float* sv1 = (float*)(smem + 32768);
  unsigned char* si1 = smem + 32768 + 8192;
  float* sv0 = (float*)(smem + 65536);
  unsigned char* si0 = smem + 65536 + 8192;
  const bf16_t* QP = (const bf16_t*)(ws + OFF_QP);
  const bf16_t* SK = (const bf16_t*)(ws + OFF_SK);
  int* EIDX = (int*)(ws + OFF_EIDX); float* GATE = (float*)(ws + OFF_GATE);
  const int tid = threadIdx.x, lane = tid & 63, w = tid >> 6, wm = w >> 1, wn = w & 1;
  const int ntile = (NT / 128) * 8;
  for (int t = blockIdx.x; t < ntile; t += gridDim.x) {
    const int tm = t >> 3, h = t & 7;
    for (int p2 = 0; p2 < 2; ++p2) {
      f32x16 acc[2][2];
      gemm_tile<64>(LoadBf16{QP + (h * 2 + p2) * 128, 2048}, SK + (size_t)((layer * 8 + h) * 2 + p2) * 128 * 128, 128, 128, tm * 128, 0, acc, As);
      __syncthreads();
#pragma unroll
      for (int mi = 0; mi < 2; ++mi)
#pragma unroll
        for (int ni = 0; ni < 2; ++ni)
#pragma unroll
          for (int g4 = 0; g4 < 4; ++g4) {
            const int m = wm * 64 + mi * 32 + (lane & 31), n = wn * 64 + ni * 32 + 8 * g4 + 4 * (lane >> 5);
            *(u32x4*)(sk + m * 128 + 4 * ((n >> 2) ^ (m & 31))) = (u32x4){f2key(acc[mi][ni][4 * g4], n), f2key(acc[mi][ni][4 * g4 + 1], n + 1), f2key(acc[mi][ni][4 * g4 + 2], n + 2), f2key(acc[mi][ni][4 * g4 + 3], n + 3)};
          }
      __syncthreads();
      const int row = tid & 127, half = tid >> 7, sw = row & 31;
      unsigned keys[16];
#pragma unroll
      for (int r = 0; r < 16; ++r) {
        unsigned best = 0u;
#pragma unroll
        for (int q = 0; q < 16; ++q) {
          const u32x4 v = *(const u32x4*)(sk + row * 128 + 4 * ((half * 16 + q) ^ sw));
          best = max(max(best, v.x), v.y); best = max(max(best, v.z), v.w);
        }
        const int bidx = 127 - (int)(best & 127u);
        sk[row * 128 + 4 * ((bidx >> 2) ^ sw) + (bidx & 3)] = 0u;
        keys[r] = best;
      }
      __syncthreads();
#pragma unroll
      for (int r = 0; r < 16; ++r) { lv[r * 256 + tid] = key2f(keys[r]); li[r * 256 + tid] = 127 - (int)(keys[r] & 127u); }
      __syncthreads();
      if (tid < 128) {
        float* dv = p2 ? sv1 : sv0; unsigned char* di = p2 ? si1 : si0;
        int a = 0, b = 0;
#pragma unroll 1
        for (int r = 0; r < 16; ++r) {
          const float va = lv[a * 256 + row], vb = lv[b * 256 + 128 + row];
          const bool ta = va >= vb;
          dv[r * 128 + row] = ta ? va : vb;
          di[r * 128 + row] = (unsigned char)(ta ? li[a * 256 + row] : li[b * 256 + 128 + row]);
          a += ta ? 1 : 0; b += ta ? 0 : 1;
        }
      }
      __syncthreads();
    }
    if (tid < 128) {
      const int row = tid;
      unsigned long long jp = 0ull;
      float cs[16]; int ce[16];
#pragma unroll
      for (int r = 0; r < 16; ++r) {
        float best = -INFINITY; int bi_ = 0;
#pragma unroll 4
        for (int i = 0; i < 16; ++i) {
          const int j = (int)((jp >> (4 * i)) & 15ull);
          const float v = sv0[i * 128 + row] + sv1[j * 128 + row];
          if (v > best) { best = v; bi_ = i; }
        }
        const int j = (int)((jp >> (4 * bi_)) & 15ull);
        ce[r] = (int)si0[bi_ * 128 + row] * 128 + (int)si1[j * 128 + row];
        cs[r] = best;
        jp += 1ull << (4 * bi_);
      }
      float e[16], sum = 0.f;
#pragma unroll
      for (int r = 0; r < 16; ++r) { e[r] = __expf(cs[r] - cs[0]); sum += e[r]; }
      const float inv = 1.f / sum;
      const size_t base = ((size_t)(tm * 128 + row) * 8 + h) * 16;
#pragma unroll
      for (int r = 0; r < 16; ++r) { EIDX[base + r] = ce[r]; GATE[base + r] = e[r] * inv; }
    }
    __syncthreads();
  }
}

DI float dot2bf(unsigned a, unsigned b, float c) {
  typedef __bf16 bf2 __attribute__((ext_vector_type(2)));
  return __builtin_amdgcn_fdot2_f32_bf16(__builtin_bit_cast(bf2, a), __builtin_bit_cast(bf2, b), c, false);
}

#define CVT8(q, hi) __builtin_amdgcn_cvt_pk_f32_fp8((int)(q), hi)
DI float dpp_x1(float v) { return __uint_as_float(__builtin_amdgcn_update_dpp(0, __float_as_uint(v), 0xB1, 0xF, 0xF, true)); }
DI float dpp_x2(float v) { return __uint_as_float(__builtin_amdgcn_update_dpp(0, __float_as_uint(v), 0x4E, 0xF, 0xF, true)); }
DI float dpp_hm(float v) { return __uint_as_float(__builtin_amdgcn_update_dpp(0, __float_as_uint(v), 0x141, 0xF, 0xF, true)); }
DI f32x2 shx2(const f32x2& v, int m) { f32x2 r; r.x = __shfl_xor(v.x, m); r.y = __shfl_xor(v.y, m); return r; }

struct TokU { u32x4 xa, xb; int ev0, ev1; };
DI void phase_peer_u(const Params& p) {
  unsigned char* ws = p.ws;
  const int lane = threadIdx.x & 63, r = lane >> 3, s = lane & 7;
  const int x = blockIdx.x & 7, lw = (blockIdx.x >> 3) * 4 + (threadIdx.x >> 6), nlw = (gridDim.x >> 3) * 4;
  const unsigned char* U8s = ws + OFF_U8 + (size_t)x * 16384 * 128 + 16 * s;
  const int* EIDX = (const int*)(ws + OFF_EIDX);
  const bf16_t* HA = (const bf16_t*)(ws + OFF_HA);
  float* HP = (float*)(ws + OFF_HP) + (size_t)x * NT * 128;
  auto load_tok = [&](int t, TokU& k) {
    const bf16_t* hp = HA + (size_t)t * 1024 + 128 * x + 16 * s;
    k.xa = *(const u32x4*)hp; k.xb = *(const u32x4*)(hp + 8);
    k.ev0 = EIDX[(size_t)t * 128 + lane]; k.ev1 = EIDX[(size_t)t * 128 + 64 + lane];
  };
  auto gather = [&](const TokU& k, u32x4 (&g)[16]) {
#pragma unroll
    for (int i = 0; i < 16; ++i) { const int e = __shfl(i < 8 ? k.ev0 : k.ev1, (8 * i + r) & 63); g[i] = *(const u32x4*)(U8s + (size_t)e * 128); }
  };
  auto compute = [&](int t, const f32x2 (&xs)[8], const u32x4 (&g)[16]) {
    float keep0 = 0.f, keep1 = 0.f;
#pragma unroll
    for (int i = 0; i < 16; ++i) {
      const u32x4 u = g[i];
      f32x2 d = CVT8(u.x, false) * xs[0];
      d = CVT8(u.x, true) * xs[1] + d; d = CVT8(u.y, false) * xs[2] + d; d = CVT8(u.y, true) * xs[3] + d;
      d = CVT8(u.z, false) * xs[4] + d; d = CVT8(u.z, true) * xs[5] + d; d = CVT8(u.w, false) * xs[6] + d; d = CVT8(u.w, true) * xs[7] + d;
      float ds = d.x + d.y;
      ds += dpp_x1(ds); ds += dpp_x2(ds); ds += dpp_hm(ds);
      if (s == (i & 7)) { if (i < 8) keep0 = ds; else keep1 = ds; }
    }
    HP[(size_t)t * 128 + 8 * s + r] = keep0; HP[(size_t)t * 128 + 64 + 8 * s + r] = keep1;
  };
#define PU_STEP(kc, gc, kn, gn)                                                                                        \
  {                                                                                                                    \
    const int tn = t + nlw; const bool has_next = tn < NT;                                                             \
    if (has_next) gather(kn, gn);                                                                                      \
    const f32x2 xs[8] = {{lo2f(kc.xa.x), hi2f(kc.xa.x)}, {lo2f(kc.xa.y), hi2f(kc.xa.y)}, {lo2f(kc.xa.z), hi2f(kc.xa.z)}, {lo2f(kc.xa.w), hi2f(kc.xa.w)}, \
                         {lo2f(kc.xb.x), hi2f(kc.xb.x)}, {lo2f(kc.xb.y), hi2f(kc.xb.y)}, {lo2f(kc.xb.z), hi2f(kc.xb.z)}, {lo2f(kc.xb.w), hi2f(kc.xb.w)}}; \
    if (tn + nlw < NT) load_tok(tn + nlw, kc);                                                                         \
    __builtin_amdgcn_sched_barrier(0);                                                                                 \
    compute(t, xs, gc);                                                                                                \
    t = tn; if (!has_next) break;                                                                                      \
  }
  int t = lw;
  if (t < NT) {
    TokU ka, kb; u32x4 ga[16], gb[16];
    load_tok(t, ka); gather(ka, ga);
    if (t + nlw < NT) load_tok(t + nlw, kb);
    while (true) {
      PU_STEP(ka, ga, kb, gb)
      PU_STEP(kb, gb, ka, ga)
    }
  }
#undef PU_STEP
}

DI void phase_peer_act(const Params& p) {
  unsigned char* ws = p.ws;
  const float* HP = (const float*)(ws + OFF_HP);
  const float* USC = (const float*)(ws + OFF_USC); const float* VSC = (const float*)(ws + OFF_VSC);
  const int* EIDX = (const int*)(ws + OFF_EIDX); float* GATE = (float*)(ws + OFF_GATE);
  const size_t n = (size_t)NT * 128, stride = (size_t)gridDim.x * 256 * 4;
  for (size_t idx = ((size_t)blockIdx.x * 256 + threadIdx.x) * 4; idx < n; idx += stride) {
    float4 hp[8];
#pragma unroll
    for (int x = 0; x < 8; ++x) hp[x] = *(const float4*)(HP + (size_t)x * n + idx);
    const int4 e4 = *(const int4*)(EIDX + idx);
    const float4 g4 = *(const float4*)(GATE + idx);
    __builtin_amdgcn_sched_barrier(0);
    const float us[4] = {USC[e4.x], USC[e4.y], USC[e4.z], USC[e4.w]};
    const float vs[4] = {VSC[e4.x], VSC[e4.y], VSC[e4.z], VSC[e4.w]};
    float h[4] = {0.f, 0.f, 0.f, 0.f};
#pragma unroll
    for (int x = 0; x < 8; ++x) { h[0] += hp[x].x; h[1] += hp[x].y; h[2] += hp[x].z; h[3] += hp[x].w; }
    const float gg[4] = {g4.x, g4.y, g4.z, g4.w};
    float o[4];
#pragma unroll
    for (int j = 0; j < 4; ++j) { const float hh = h[j] * us[j]; o[j] = 0.5f * hh * (1.f + erff(hh * 0.70710678118f)) * gg[j] * vs[j]; }
    *(float4*)(GATE + idx) = make_float4(o[0], o[1], o[2], o[3]);
  }
}

struct TokV { int ev0, ev1; float ac0, ac1; float2 xv; };
DI void phase_peer_v(const Params& p) {
  unsigned char* ws = p.ws;
  const int lane = threadIdx.x & 63, r = lane >> 3, s = lane & 7;
  const int x = blockIdx.x & 7, lw = (blockIdx.x >> 3) * 4 + (threadIdx.x >> 6), nlw = (gridDim.x >> 3) * 4;
  const unsigned char* V8s = ws + OFF_V8 + (size_t)x * 16384 * 128 + 16 * s;
  const int* EIDX = (const int*)(ws + OFF_EIDX); const float* ACT = (const float*)(ws + OFF_GATE);
  float* X = p.out; float* SSP = (float*)(ws + OFF_SSP) + (size_t)x * NT;
  const int xoff = 128 * x + 16 * s + 2 * r;
  auto load_tok = [&](int t, TokV& k) {
    k.ev0 = EIDX[(size_t)t * 128 + lane]; k.ev1 = EIDX[(size_t)t * 128 + 64 + lane];
    k.ac0 = ACT[(size_t)t * 128 + lane]; k.ac1 = ACT[(size_t)t * 128 + 64 + lane];
    k.xv = *(const float2*)(X + (size_t)t * 1024 + xoff);
  };
  auto gather = [&](const TokV& k, u32x4 (&g)[16]) {
#pragma unroll
    for (int i = 0; i < 16; ++i) { const int e = __shfl(i < 8 ? k.ev0 : k.ev1, (8 * i + r) & 63); g[i] = *(const u32x4*)(V8s + (size_t)e * 128); }
  };
  auto compute = [&](int t, float ac0, float ac1, float2 xv, const u32x4 (&g)[16]) {
    f32x2 acc[8];
#pragma unroll
    for (int i = 0; i < 8; ++i) acc[i] = (f32x2){0.f, 0.f};
#pragma unroll
    for (int i = 0; i < 16; ++i) {
      const float a = __shfl(i < 8 ? ac0 : ac1, (8 * i + r) & 63);
      const u32x4 v = g[i];
      const f32x2 aa = {a, a};
      acc[0] = CVT8(v.x, false) * aa + acc[0]; acc[1] = CVT8(v.x, true) * aa + acc[1];
      acc[2] = CVT8(v.y, false) * aa + acc[2]; acc[3] = CVT8(v.y, true) * aa + acc[3];
      acc[4] = CVT8(v.z, false) * aa + acc[4]; acc[5] = CVT8(v.z, true) * aa + acc[5];
      acc[6] = CVT8(v.w, false) * aa + acc[6]; acc[7] = CVT8(v.w, true) * aa + acc[7];
    }
    f32x2 b4[4], b2[2];
#pragma unroll
    for (int m = 0; m < 4; ++m) { const f32x2 keep = (r & 4) ? acc[4 + m] : acc[m], send = (r & 4) ? acc[m] : acc[4 + m]; b4[m] = keep + shx2(send, 32); }
#pragma unroll
    for (int m = 0; m < 2; ++m) { const f32x2 keep = (r & 2) ? b4[2 + m] : b4[m], send = (r & 2) ? b4[m] : b4[2 + m]; b2[m] = keep + shx2(send, 16); }
    const f32x2 keep = (r & 1) ? b2[1] : b2[0], send = (r & 1) ? b2[0] : b2[1];
    const f32x2 o = keep + shx2(send, 8);
    xv.x += o.x; xv.y += o.y;
    *(float2*)(X + (size_t)t * 1024 + xoff) = xv;
    const float ss = wave_sum(xv.x * xv.x + xv.y * xv.y);
    if (lane == 0) SSP[t] = ss;
  };
#define PV_STEP(kc, gc, kn, gn)                                                                                        \
  {                                                                                                                    \
    const int tn = t + nlw; const bool has_next = tn < NT;                                                             \
    if (has_next) gather(kn, gn);                                                                                      \
    const float c0 = kc.ac0, c1 = kc.ac1; const float2 cx = kc.xv;                                                     \
    if (tn + nlw < NT) load_tok(tn + nlw, kc);                                                                         \
    __builtin_amdgcn_sched_barrier(0);                                                                                 \
    compute(t, c0, c1, cx, gc);                                                                                        \
    t = tn; if (!has_next) break;                                                                                      \
  }
  int t = lw;
  if (t < NT) {
    TokV ka, kb; u32x4 ga[16], gb[16];
    load_tok(t, ka); gather(ka, ga);
    if (t + nlw < NT) load_tok(t + nlw, kb);
    while (true) {
      PV_STEP(ka, ga, kb, gb)
      PV_STEP(kb, gb, ka, ga)
    }
  }
#undef PV_STEP
}

DI void phase_peer_norm(const Params& p, int layer) {
  unsigned char* ws = p.ws;
  const int lane = threadIdx.x & 63, gw = blockIdx.x * 4 + (threadIdx.x >> 6), nw = gridDim.x * 4;
  const float* SSP = (const float*)(ws + OFF_SSP);
  bf16_t* HA = (bf16_t*)(ws + OFF_HA);
  float* X = p.out;
  const float* gn = layer == 0 ? p.in[I_N1] + 1024 : p.in[I_FG];
  float4 gv[4];
#pragma unroll
  for (int j = 0; j < 4; ++j) gv[j] = *(const float4*)(gn + lane * 4 + 256 * j);
  for (int row = gw; row < NT; row += nw) {
    float sp[8];
#pragma unroll
    for (int x = 0; x < 8; ++x) sp[x] = SSP[(size_t)x * NT + row];
    float* xr = X + (size_t)row * 1024;
    float4 xin[4];
#pragma unroll
    for (int j = 0; j < 4; ++j) xin[j] = *(const float4*)(xr + lane * 4 + 256 * j);
    __builtin_amdgcn_sched_barrier(0);
    const float ss = ((sp[0] + sp[1]) + (sp[2] + sp[3])) + ((sp[4] + sp[5]) + (sp[6] + sp[7]));
    const float rs = rsqrtf(ss * (1.f / 1024.f) + 1e-6f);
    float* so = nullptr;
    if (layer == 0) {
      if (row < NPR) { if ((row & 4095) == 4095) so = p.out + O_PS + (size_t)(row >> 12) * 1024; }
      else { if (((row - NPR) & 31) == 31) so = p.out + O_SS + (size_t)((row - NPR) >> 5) * 1024; }
    }
#pragma unroll
    for (int j = 0; j < 4; ++j) {
      const float4 v = xin[j];
      const float4 y = make_float4(v.x * rs * gv[j].x, v.y * rs * gv[j].y, v.z * rs * gv[j].z, v.w * rs * gv[j].w);
      if (layer == 0) {
        st_bf4(HA + (size_t)row * 1024 + lane * 4 + 256 * j, y.x, y.y, y.z, y.w);
        if (so) *(float4*)(so + lane * 4 + 256 * j) = y;
      } else *(float4*)(xr + lane * 4 + 256 * j) = y;
    }
  }
}

DI void phase9(const Params& p, unsigned char* smem) {
  unsigned char* ws = p.ws;
  bf16_t* As = (bf16_t*)smem;
  bf16_t* R = (bf16_t*)(ws + OFF_R); bf16_t* Kb = (bf16_t*)(ws + OFF_K); bf16_t* V = (bf16_t*)(ws + OFF_V);
  bf16_t* W1 = (bf16_t*)(ws + OFF_W1); bf16_t* A1 = (bf16_t*)(ws + OFF_A1); bf16_t* G1 = (bf16_t*)(ws + OFF_G1);
  for_tiles(NT / 128, 27, [&](int tm, int tn) {
    const int mi_ = tn < 24 ? (tn >> 3) : tn - 21;
    f32x16 acc[2][2];
    gemm_tile<64>(LoadShiftMix{(const bf16_t*)(ws + OFF_HA), p.in[I_MU] + mi_ * 1024, p.in[I_SS]}, (const bf16_t*)(ws + OFF_WT_RK), 1024, 1024, tm * 128, tn * 128, acc, As);
    epilogue(acc, tm * 128, tn * 128, [&](int row, int col, float a, float b, float c, float d) {
      if (col < 1024) st_bf4(R + (size_t)row * 1024 + col, a, b, c, d);
      else if (col < 2048) st_bf4(Kb + (size_t)row * 1024 + col - 1024, a, b, c, d);
      else if (col < 3072) st_bf4(V + (size_t)row * 1024 + col - 2048, a, b, c, d);
      else if (col < 3136) st_bf4(W1 + (size_t)row * 64 + col - 3072, tanhf(a), tanhf(b), tanhf(c), tanhf(d));
      else if (col < 3200) {}
      else if (col < 3264) st_bf4(A1 + (size_t)row * 64 + col - 3200, a, b, c, d);
      else if (col < 3328) {}
      else st_bf4(G1 + (size_t)row * 128 + col - 3328, sigmoidf_(a), sigmoidf_(b), sigmoidf_(c), sigmoidf_(d));
    }, (float*)smem);
  });
}

DI float decay_of(float w) {
  const float nw = -w;
  const float sp = nw > 20.f ? nw : log1pf(__expf(nw));
  return __expf(-__expf(-sp - 0.5f));
}
DI unsigned short f2h(float x) { return __builtin_bit_cast(unsigned short, (_Float16)x); }

DI void phase10(const Params& p, unsigned char* smem) {
  unsigned char* ws = p.ws;
  bf16_t* As = (bf16_t*)smem;
  unsigned short* DEC = (unsigned short*)(ws + OFF_DEC); bf16_t* AA = (bf16_t*)(ws + OFF_AA); bf16_t* GG = (bf16_t*)(ws + OFF_GG);
  for_tiles(NT / 128, 24, [&](int tm, int tn) {
    const int grp = tn >> 3, n0 = (tn & 7) * 128;
    f32x16 acc[2][2];
    if (grp == 0) {
      gemm_tile<64>(LoadBf16{(const bf16_t*)(ws + OFF_W1), 64}, (const bf16_t*)(ws + OFF_WT_W2), 64, 64, tm * 128, n0, acc, As);
      epilogue(acc, tm * 128, n0, [&](int row, int col, float a, float b, float c, float d) {
        const float4 w0 = *(const float4*)(p.in[I_W0] + col);
        u32x2 q; q.x = (unsigned)f2h(decay_of(w0.x + a)) | ((unsigned)f2h(decay_of(w0.y + b)) << 16); q.y = (unsigned)f2h(decay_of(w0.z + c)) | ((unsigned)f2h(decay_of(w0.w + d)) << 16);
        *(u32x2*)(DEC + (size_t)row * 1024 + col) = q;
      }, (float*)smem);
    } else if (grp == 1) {
      gemm_tile<64>(LoadBf16{(const bf16_t*)(ws + OFF_A1), 64}, (const bf16_t*)(ws + OFF_WT_A2), 64, 64, tm * 128, n0, acc, As);
      epilogue(acc, tm * 128, n0, [&](int row, int col, float a, float b, float c, float d) {
        const float4 a0 = *(const float4*)(p.in[I_A0] + col);
        st_bf4(AA + (size_t)row * 1024 + col, sigmoidf_(a0.x + a), sigmoidf_(a0.y + b), sigmoidf_(a0.z + c), sigmoidf_(a0.w + d));
      }, (float*)smem);
    } else {
      gemm_tile<128>(LoadBf16{(const bf16_t*)(ws + OFF_G1), 128}, (const bf16_t*)(ws + OFF_WT_G2), 128, 128, tm * 128, n0, acc, As);
      epilogue(acc, tm * 128, n0, [&](int row, int col, float a, float b, float c, float d) { st_bf4(GG + (size_t)row * 1024 + col, a, b, c, d); }, (float*)smem);
    }
  });
}

DI float dpp_xor1(float v) { return __uint_as_float(__builtin_amdgcn_update_dpp(0, __float_as_uint(v), 0xB1, 0xF, 0xF, true)); }
DI float dpp_xor2(float v) { return __uint_as_float(__builtin_amdgcn_update_dpp(0, __float_as_uint(v), 0x4E, 0xF, 0xF, true)); }

DI void rwkv_unit(const Params& p, int seq, int head, int ih, unsigned char* smem) {
  unsigned char* ws = p.ws;
  float* buf = (float*)smem;
  float* obuf = buf + 32 * 384;
  const int tid = threadIdx.x, lane = tid & 63, w = tid >> 6, il = lane >> 3, jq = lane & 7, ii = w * 8 + il, i = ih * 32 + ii;
  const int row0 = seq_row0(seq), T = seq_len(seq), nch = T >> 5;
  const int b = seq & 15;
  f32x2 s2[4];
  const size_t soff = ((size_t)(b * 16 + head) * 64 + i) * 64 + jq * 8;
  if (seq >= 16) {
    const float* sp = p.in[I_SR] + soff;
#pragma unroll
    for (int j = 0; j < 4; ++j) s2[j] = (f32x2){sp[2 * j], sp[2 * j + 1]};
  } else {
#pragma unroll
    for (int j = 0; j < 4; ++j) s2[j] = (f32x2){0.f, 0.f};
  }
  const int pt = tid >> 3, jg = tid & 7, col = head * 64 + jg * 8;
  float ckk[8], cka[8], crk[8];
#pragma unroll
  for (int j = 0; j < 8; ++j) { ckk[j] = p.in[I_KK][col + j]; cka[j] = p.in[I_KA][col + j]; crk[j] = p.in[I_RK][col + j]; }
  const bf16_t* R = (const bf16_t*)(ws + OFF_R); const bf16_t* Kb = (const bf16_t*)(ws + OFF_K); const bf16_t* V = (const bf16_t*)(ws + OFF_V);
  const unsigned short* DEC = (const unsigned short*)(ws + OFF_DEC); const bf16_t* AA = (const bf16_t*)(ws + OFF_AA);
  float* BON = (float*)(ws + OFF_BON);
  bf16_t* O2 = (bf16_t*)(ws + OFF_ORAW2);
  u32x4 qr, qk, qv, qd, qa;
  {
    const size_t o = (size_t)(row0 + pt) * 1024 + col;
    qr = *(const u32x4*)(R + o); qk = *(const u32x4*)(Kb + o); qv = *(const u32x4*)(V + o); qd = *(const u32x4*)(DEC + o); qa = *(const u32x4*)(AA + o);
  }
  __syncthreads();
  for (int c = 0; c < nch; ++c) {
    {
      float r8[8], k8[8], v8[8], a8[8], d8[8];
      unpack8(qr, r8); unpack8(qk, k8); unpack8(qv, v8); unpack8(qa, a8);
      const half8 dh = __builtin_bit_cast(half8, qd);
#pragma unroll
      for (int j = 0; j < 8; ++j) d8[j] = (float)dh[j];
      float kkr[8], ss = 0.f, bon = 0.f, kp[8];
#pragma unroll
      for (int j = 0; j < 8; ++j) { kkr[j] = k8[j] * ckk[j]; ss += kkr[j] * kkr[j]; kp[j] = k8[j] * (1.f + (a8[j] - 1.f) * cka[j]); bon += r8[j] * kp[j] * crk[j]; }
      ss += dpp_x1(ss); ss += dpp_x2(ss); ss += dpp_hm(ss);
      bon += dpp_x1(bon); bon += dpp_x2(bon); bon += dpp_hm(bon);
      const float inv = rsqrtf(ss + 1e-12f);
      float* bb = buf + pt * 384 + jg * 8;
      float kkn[8], bbv[8];
#pragma unroll
      for (int j = 0; j < 8; ++j) { kkn[j] = kkr[j] * inv; bbv[j] = kkn[j] * a8[j]; }
      *(float4*)(bb) = make_float4(r8[0], r8[1], r8[2], r8[3]); *(float4*)(bb + 4) = make_float4(r8[4], r8[5], r8[6], r8[7]);
      *(float4*)(bb + 64) = make_float4(d8[0], d8[1], d8[2], d8[3]); *(float4*)(bb + 68) = make_float4(d8[4], d8[5], d8[6], d8[7]);
      *(float4*)(bb + 128) = make_float4(kp[0], kp[1], kp[2], kp[3]); *(float4*)(bb + 132) = make_float4(kp[4], kp[5], kp[6], kp[7]);
      *(float4*)(bb + 192) = make_float4(kkn[0], kkn[1], kkn[2], kkn[3]); *(float4*)(bb + 196) = make_float4(kkn[4], kkn[5], kkn[6], kkn[7]);
      *(float4*)(bb + 256) = make_float4(bbv[0], bbv[1], bbv[2], bbv[3]); *(float4*)(bb + 260) = make_float4(bbv[4], bbv[5], bbv[6], bbv[7]);
      *(float4*)(bb + 320) = make_float4(v8[0], v8[1], v8[2], v8[3]); *(float4*)(bb + 324) = make_float4(v8[4], v8[5], v8[6], v8[7]);
      if (jg == 0 && ih == 0) BON[(size_t)(row0 + c * 32 + pt) * 16 + head] = bon;
    }
    __syncthreads();
    if (c + 1 < nch) {
      const size_t o = (size_t)(row0 + (c + 1) * 32 + pt) * 1024 + col;
      qr = *(const u32x4*)(R + o); qk = *(const u32x4*)(Kb + o); qv = *(const u32x4*)(V + o); qd = *(const u32x4*)(DEC + o); qa = *(const u32x4*)(AA + o);
    }
    struct StepOps { float4 r0, r1, w0, w1, k0, k1, n0, n1, b0, b1; float vi; };
    auto ldops = [&](int t, StepOps& q) {
      const float* sb = buf + t * 384 + jq * 8;
      q.n0 = *(const float4*)(sb + 192); q.n1 = *(const float4*)(sb + 196);
      q.w0 = *(const float4*)(sb + 64); q.w1 = *(const float4*)(sb + 68);
      q.b0 = *(const float4*)(sb + 256); q.b1 = *(const float4*)(sb + 260);
      q.k0 = *(const float4*)(sb + 128); q.k1 = *(const float4*)(sb + 132);
      q.r0 = *(const float4*)(sb); q.r1 = *(const float4*)(sb + 4);
      q.vi = buf[t * 384 + 320 + i];
    };
    StepOps cu; ldops(0, cu);
#pragma unroll 4
    for (int t = 0; t < 32; ++t) {
      StepOps nx = cu;
      if (t + 1 < 32) ldops(t + 1, nx);
      __builtin_amdgcn_sched_barrier(0);
      const f32x2 rr2[4] = {{cu.r0.x, cu.r0.y}, {cu.r0.z, cu.r0.w}, {cu.r1.x, cu.r1.y}, {cu.r1.z, cu.r1.w}};
      const f32x2 ww2[4] = {{cu.w0.x, cu.w0.y}, {cu.w0.z, cu.w0.w}, {cu.w1.x, cu.w1.y}, {cu.w1.z, cu.w1.w}};
      const f32x2 kp2[4] = {{cu.k0.x, cu.k0.y}, {cu.k0.z, cu.k0.w}, {cu.k1.x, cu.k1.y}, {cu.k1.z, cu.k1.w}};
      const f32x2 kn2[4] = {{cu.n0.x, cu.n0.y}, {cu.n0.z, cu.n0.w}, {cu.n1.x, cu.n1.y}, {cu.n1.z, cu.n1.w}};
      const f32x2 bb2[4] = {{cu.b0.x, cu.b0.y}, {cu.b0.z, cu.b0.w}, {cu.b1.x, cu.b1.y}, {cu.b1.z, cu.b1.w}};
      const float vi = cu.vi;
      f32x2 sa2 = s2[0] * kn2[0];
      sa2 = s2[1] * kn2[1] + sa2; sa2 = s2[2] * kn2[2] + sa2; sa2 = s2[3] * kn2[3] + sa2;
      float sa = sa2.x + sa2.y;
      sa += dpp_x1(sa); sa += dpp_x2(sa); sa += dpp_hm(sa);
      const f32x2 nsa = {-sa, -sa}, vv = {vi, vi};
      f32x2 o2 = {0.f, 0.f};
#pragma unroll
      for (int j = 0; j < 4; ++j) {
        s2[j] = vv * kp2[j] + (nsa * bb2[j] + s2[j] * ww2[j]);
        o2 = s2[j] * rr2[j] + o2;
      }
      float o = o2.x + o2.y;
      o += dpp_x1(o); o += dpp_x2(o); o += dpp_hm(o);
      if (jq == 0) obuf[t * 32 + ii] = o;
      cu = nx;
    }
    __syncthreads();
    {
      const int ot = tid >> 3, oc = (tid & 7) * 4;
      const float4 ov = *(const float4*)(obuf + ot * 32 + oc);
      st_bf4(O2 + (size_t)(row0 + c * 32 + ot) * 1024 + head * 64 + ih * 32 + oc, ov.x, ov.y, ov.z, ov.w);
    }
  }
  {
    float* so = p.out + (seq < 16 ? O_PR : O_SR) + soff;
#pragma unroll
    for (int j = 0; j < 4; ++j) { so[2 * j] = s2[j].x; so[2 * j + 1] = s2[j].y; }
  }
  __syncthreads();
}
DI void phase11(const Params& p, unsigned char* smem) {
  for (int u = blockIdx.x; u < 1024; u += gridDim.x) {
    const int uu = u & 511;
    rwkv_unit(p, (uu & 15) + (u >= 512 ? 16 : 0), (uu >> 4) & 15, uu >> 8, smem);
  }
}

DI void phase12(const Params& p) {
  unsigned char* ws = p.ws;
  const int lane = threadIdx.x & 63, gw = blockIdx.x * 4 + (threadIdx.x >> 6), nw = gridDim.x * 4;
  const bf16_t* O2 = (const bf16_t*)(ws + OFF_ORAW2); const bf16_t* V = (const bf16_t*)(ws + OFF_V); const bf16_t* GG = (const bf16_t*)(ws + OFF_GG);
  const float* BON = (const float*)(ws + OFF_BON);
  bf16_t* A5 = (bf16_t*)(ws + OFF_A5);
  float lg[16], lb[16];
#pragma unroll
  for (int i = 0; i < 16; ++i) { lg[i] = p.in[I_LNG][lane * 16 + i]; lb[i] = p.in[I_LNB][lane * 16 + i]; }
  for (int row = gw; row < NT; row += nw) {
    const size_t o = (size_t)row * 1024 + lane * 16;
    float ov[16], vv[16], gg[16];
    unpack8(*(const u32x4*)(O2 + o), ov); unpack8(*(const u32x4*)(O2 + o + 8), ov + 8);
    unpack8(*(const u32x4*)(V + o), vv); unpack8(*(const u32x4*)(V + o + 8), vv + 8);
    unpack8(*(const u32x4*)(GG + o), gg); unpack8(*(const u32x4*)(GG + o + 8), gg + 8);
    const float bon = BON[(size_t)row * 16 + (lane >> 2)];
    float sm = 0.f;
#pragma unroll
    for (int i = 0; i < 16; ++i) sm += ov[i];
    sm += __shfl_xor(sm, 1); sm += __shfl_xor(sm, 2);
    const float mean = sm * (1.f / 64.f);
    float sq = 0.f;
#pragma unroll
    for (int i = 0; i < 16; ++i) { const float d = ov[i] - mean; sq += d * d; }
    sq += __shfl_xor(sq, 1); sq += __shfl_xor(sq, 2);
    const float rs = rsqrtf(sq * (1.f / 64.f) + 64e-5f);
    float r[16];
#pragma unroll
    for (int i = 0; i < 16; ++i) r[i] = ((ov[i] - mean) * rs * lg[i] + lb[i] + bon * vv[i]) * gg[i];
    *(u32x4*)(A5 + o) = pack8(r); *(u32x4*)(A5 + o + 8) = pack8(r + 8);
  }
}

DI void phase13(const Params& p, unsigned char* smem) {
  cvt_fp8_rows(p.in[I_PU] + (size_t)16384 * 1024, p.ws + OFF_U8, (float*)(p.ws + OFF_USC));
  cvt_fp8_rows(p.in[I_PV] + (size_t)16384 * 1024, p.ws + OFF_V8, (float*)(p.ws + OFF_VSC));
  phase_outproj(p, smem, OFF_A5, OFF_WT_OUTC, false);
}

template <int PH>
DI void run_phase(const Params& p, unsigned char* smem) {
  if (PH == 0) phase0(p, smem);
  else if (PH == 1) phase1(p, smem);
  else if (PH == 2) phase2(p, smem);
  else if (PH == 3) phase3(p, smem);
  else if (PH == 4) phase_outproj(p, smem, OFF_HA, OFF_WT_OUTAB, true);
  else if (PH == 5) phase_norm2(p, 0);
  else if (PH == 6) phase_qp(p, smem, 0);
  else if (PH == 7) phase_route(p, smem, 0);
  else if (PH == 8) phase_peer_u(p);
  else if (PH == 9) phase_peer_act(p);
  else if (PH == 10) phase_peer_v(p);
  else if (PH == 11) phase_peer_norm(p, 0);
  else if (PH == 12) phase9(p, smem);
  else if (PH == 13) phase10(p, smem);
  else if (PH == 14) phase11(p, smem);
  else if (PH == 15) phase12(p);
  else if (PH == 16) phase13(p, smem);
  else if (PH == 17) phase_norm2(p, 1);
  else if (PH == 18) phase_qp(p, smem, 1);
  else if (PH == 19) phase_route(p, smem, 1);
  else if (PH == 20) phase_peer_u(p);
  else if (PH == 21) phase_peer_act(p);
  else if (PH == 22) phase_peer_v(p);
  else if (PH == 23) phase_peer_norm(p, 1);
  else if (PH == 24) phase_pre(p, smem);
}

template <int PH>
__global__ void __launch_bounds__(256, 2) k_phase(Params p) {
  extern __shared__ __attribute__((aligned(16))) unsigned char smem[];
  run_phase<PH>(p, smem);
}

#ifndef PROBE_MASK
#define PROBE_MASK 0u
#endif
DI void grid_barrier(unsigned* cnt, unsigned target) {
  asm volatile("s_waitcnt vmcnt(0) lgkmcnt(0)" ::: "memory");
  __syncthreads();
  if (threadIdx.x == 0) {
    __builtin_amdgcn_fence(__ATOMIC_RELEASE, "agent");
    asm volatile("s_waitcnt vmcnt(0)" ::: "memory");
    __hip_atomic_fetch_add(cnt, 1u, __ATOMIC_RELAXED, __HIP_MEMORY_SCOPE_AGENT);
    while (__hip_atomic_load(cnt, __ATOMIC_RELAXED, __HIP_MEMORY_SCOPE_AGENT) < target) __builtin_amdgcn_s_sleep(1);
    __builtin_amdgcn_fence(__ATOMIC_ACQUIRE, "agent");
    asm volatile("s_waitcnt vmcnt(0)" ::: "memory");
  }
  __syncthreads();
}
template <int PH>
DI void mega_step(const Params& p, unsigned char* smem, cg::grid_group& grid, unsigned& nb, bool last) {
  run_phase<PH>(p, smem);
  if ((PROBE_MASK >> PH) & 1u) { grid.sync(); run_phase<PH>(p, smem); }
  if (!last) {
    if (PH == 0) grid.sync();
    else { ++nb; grid_barrier((unsigned*)(p.ws + OFF_GBAR), nb * gridDim.x); }
  }
}
__global__ void __launch_bounds__(256, 2) k_mega(Params p) {
  extern __shared__ __attribute__((aligned(16))) unsigned char smem[];
  cg::grid_group grid = cg::this_grid();
  unsigned nb = 0;
  mega_step<0>(p, smem, grid, nb, false); mega_step<1>(p, smem, grid, nb, false); mega_step<24>(p, smem, grid, nb, false); mega_step<2>(p, smem, grid, nb, false); mega_step<3>(p, smem, grid, nb, false);
  mega_step<4>(p, smem, grid, nb, false); mega_step<5>(p, smem, grid, nb, false); mega_step<6>(p, smem, grid, nb, false); mega_step<7>(p, smem, grid, nb, false);
  mega_step<8>(p, smem, grid, nb, false); mega_step<9>(p, smem, grid, nb, false); mega_step<10>(p, smem, grid, nb, false); mega_step<11>(p, smem, grid, nb, false);
  mega_step<12>(p, smem, grid, nb, false); mega_step<13>(p, smem, grid, nb, false); mega_step<14>(p, smem, grid, nb, false); mega_step<15>(p, smem, grid, nb, false);
  mega_step<16>(p, smem, grid, nb, false); mega_step<17>(p, smem, grid, nb, false); mega_step<18>(p, smem, grid, nb, false); mega_step<19>(p, smem, grid, nb, false);
  mega_step<20>(p, smem, grid, nb, false); mega_step<21>(p, smem, grid, nb, false); mega_step<22>(p, smem, grid, nb, false); mega_step<23>(p, smem, grid, nb, true);
}

template <int PH>
static void launch_phase(const Params& p, int grid, hipStream_t stream) {
  static bool attr = false;
  if (!attr) { hipFuncSetAttribute((const void*)k_phase<PH>, hipFuncAttributeMaxDynamicSharedMemorySize, LDS_BYTES); attr = true; }
  hipLaunchKernelGGL(k_phase<PH>, dim3(grid), dim3(256), LDS_BYTES, stream, p);
}

extern "C" void kernel_launch(void* const* d_in, const int* in_sizes, int n_in, void* d_out, int out_size, void* d_ws, size_t ws_size, hipStream_t stream) {
  Params p{};
  for (int i = 0; i < 36; ++i) p.in[i] = (const float*)d_in[i];
  p.out = (float*)d_out; p.ws = (unsigned char*)d_ws;
  if (ws_size < WS_END) { fprintf(stderr, "workspace too small: %zu < %zu\n", ws_size, (size_t)WS_END); return; }
#if MEGA
  static int grid_blocks = 0;
  if (!grid_blocks) {
    hipFuncSetAttribute((const void*)k_mega, hipFuncAttributeMaxDynamicSharedMemorySize, LDS_BYTES);
    int dev = 0, cus = 0, per_cu = 0;
    hipGetDevice(&dev);
    hipDeviceGetAttribute(&cus, hipDeviceAttributeMultiprocessorCount, dev);
    hipOccupancyMaxActiveBlocksPerMultiprocessor(&per_cu, k_mega, 256, LDS_BYTES);
    if (per_cu > 2) per_cu = 2;
    if (per_cu < 1) per_cu = 1;
    grid_blocks = cus * per_cu;
  }
  hipMemsetAsync((unsigned char*)d_ws + OFF_GBAR, 0, 256, stream);
  void* args[] = {&p};
  hipError_t e = hipLaunchCooperativeKernel((void*)k_mega, dim3(grid_blocks), dim3(256), args, LDS_BYTES, stream);
  if (e != hipSuccess) fprintf(stderr, "cooperative launch failed: %s (grid %d)\n", hipGetErrorString(e), grid_blocks);
#else
  const int grid = 512;
  launch_phase<0>(p, grid, stream); launch_phase<1>(p, grid, stream); launch_phase<24>(p, grid, stream); launch_phase<2>(p, grid, stream); launch_phase<3>(p, grid, stream);
  launch_phase<4>(p, grid, stream); launch_phase<5>(p, grid, stream); launch_phase<6>(p, grid, stream); launch_phase<7>(p, grid, stream);
  launch_phase<8>(p, grid, stream); launch_phase<9>(p, grid, stream); launch_phase<10>(p, grid, stream); launch_phase<11>(p, grid, stream);
  launch_phase<12>(p, grid, stream); launch_phase<13>(p, grid, stream); launch_phase<14>(p, grid, stream); launch_phase<15>(p, grid, stream);
  launch_phase<16>(p, grid, stream); launch_phase<17>(p, grid, stream); launch_phase<18>(p, grid, stream); launch_phase<19>(p, grid, stream);
  launch_phase<20>(p, grid, stream); launch_phase<21>(p, grid, stream); launch_phase<22>(p, grid, stream); launch_phase<23>(p, grid, stream);
#endif
}
```

```cpp
#include <hip/hip_runtime.h>
#include <hip/hip_cooperative_groups.h>
#include <cstdio>
namespace cg = cooperative_groups;

#ifndef MEGA
#define MEGA 1
#endif

#define DI __device__ __forceinline__
typedef unsigned short bf16_t;
typedef short bf16x8 __attribute__((ext_vector_type(8)));
typedef float f32x16 __attribute__((ext_vector_type(16)));
typedef _Float16 half8 __attribute__((ext_vector_type(8)));
typedef unsigned u32x4 __attribute__((ext_vector_type(4)));
typedef unsigned u32x2 __attribute__((ext_vector_type(2)));
typedef float f32x2 __attribute__((ext_vector_type(2)));

constexpr int NT = 66048;
constexpr int NPR = 65536;
constexpr size_t U = (size_t)NT * 1024 * 2;
constexpr int LDS_BYTES = 77824;

constexpr size_t S0 = 0, S1 = U, S2 = 2 * U, S3 = 3 * U, S4 = 4 * U, S5 = 5 * U, S6 = 6 * U;
constexpr size_t OFF_HA = S0;
constexpr size_t OFF_QA = S1, OFF_F = S1 + U / 2, OFF_VA = S1 + U / 2 + U, OFF_GA = S1 + 2 * U, OFF_QB = S1 + 2 * U + U / 2,
                 OFF_KB = OFF_QB + U / 4, OFF_VB = S1 + 3 * U, OFF_GB = OFF_VB + U / 2, OFF_LR = S1 + 4 * U;
constexpr size_t OFF_ORAW = S6;
constexpr size_t OFF_EBL = S5 + (size_t)8 * 1024 * 1024, OFF_KTA = S5 + U / 4, OFF_KTB = OFF_KTA + U / 2;
constexpr size_t OFF_QP = S1;
constexpr size_t OFF_EIDX = S3, OFF_GATE = S3 + U / 4;
constexpr size_t OFF_HP = S1, OFF_SSP = S4;
constexpr size_t OFF_R = S1, OFF_K = S2, OFF_V = S3, OFF_DEC = S4, OFF_AA = S5, OFF_GG = S6, OFF_ORAW2 = S0, OFF_A5 = S4;
constexpr size_t OFF_TAB = 7 * U;
constexpr size_t TAB_BYTES = (size_t)16384 * 1024 * 2;
constexpr size_t OFF_U8 = OFF_TAB, OFF_V8 = OFF_TAB + (size_t)16384 * 1024, OFF_USC = OFF_V8 + (size_t)16384 * 1024, OFF_VSC = OFF_USC + 65536;
constexpr size_t OFF_W1 = OFF_TAB, OFF_A1 = OFF_W1 + (size_t)NT * 64 * 2, OFF_G1 = OFF_A1 + (size_t)NT * 64 * 2,
                 OFF_BON = OFF_G1 + (size_t)NT * 128 * 2;
constexpr size_t OFF_W = OFF_TAB + 2 * TAB_BYTES;
constexpr size_t OFF_WT_IN = OFF_W;
constexpr size_t OFF_WT_OUTAB = OFF_WT_IN + (size_t)3712 * 1024 * 2;
constexpr size_t OFF_WT_RK = OFF_WT_OUTAB + (size_t)1024 * 1024 * 2;
constexpr size_t OFF_WT_W2 = OFF_WT_RK + (size_t)3456 * 1024 * 2;
constexpr size_t OFF_WT_A2 = OFF_WT_W2 + (size_t)1024 * 64 * 2;
constexpr size_t OFF_WT_G2 = OFF_WT_A2 + (size_t)1024 * 64 * 2;
constexpr size_t OFF_WT_OUTC = OFF_WT_G2 + (size_t)1024 * 128 * 2;
constexpr size_t OFF_WT_Q = OFF_WT_OUTC + (size_t)1024 * 1024 * 2;
constexpr size_t OFF_SK = OFF_WT_Q + (size_t)2 * 2048 * 1024 * 2;
constexpr size_t OFF_LBS = OFF_SK + (size_t)2 * 16 * 128 * 128 * 2;
constexpr size_t OFF_GBAR = OFF_LBS + 2048;
constexpr size_t WS_END = OFF_GBAR + 256;

constexpr size_t O_PH = 67633152, O_PG = 68681728, O_PR = 69206016, O_PS = 70254592,
                 O_SH = 70270976, O_SG = 71319552, O_SR = 71843840, O_SS = 72892416;

struct Params { const float* in[36]; float* out; unsigned char* ws; };

enum { I_XP = 0, I_XS, I_SH, I_SG, I_SR, I_SS, I_WIN, I_LB, I_HNG, I_GW2, I_GB, I_GNG, I_WOUTAB, I_MU, I_WRKV, I_WW1, I_WW2, I_W0,
       I_AW1, I_AW2, I_A0, I_GW1, I_GWW2, I_KK, I_KA, I_RK, I_LNG, I_LNB, I_WOUTC, I_N1, I_N2, I_FG, I_PWQ, I_PSK, I_PU, I_PV };

DI float bf2f(bf16_t u) { return __uint_as_float(((unsigned)u) << 16); }
DI unsigned pack2(float lo, float hi) { unsigned r; asm("v_cvt_pk_bf16_f32 %0, %1, %2" : "=v"(r) : "v"(lo), "v"(hi)); return r; }
DI bf16_t f2bf(float x) { return (bf16_t)(pack2(x, 0.f) & 0xffffu); }
DI float lo2f(unsigned p) { return __uint_as_float(p << 16); }
DI float hi2f(unsigned p) { return __uint_as_float(p & 0xffff0000u); }
DI void unpack8(const u32x4& q, float* f) { f[0] = lo2f(q.x); f[1] = hi2f(q.x); f[2] = lo2f(q.y); f[3] = hi2f(q.y); f[4] = lo2f(q.z); f[5] = hi2f(q.z); f[6] = lo2f(q.w); f[7] = hi2f(q.w); }
DI u32x4 pack8(const float* f) { u32x4 q; q.x = pack2(f[0], f[1]); q.y = pack2(f[2], f[3]); q.z = pack2(f[4], f[5]); q.w = pack2(f[6], f[7]); return q; }
DI float sigmoidf_(float x) { return 1.f / (1.f + __expf(-x)); }
DI float siluf_(float x) { return x / (1.f + __expf(-x)); }
DI float wave_sum(float v) {
  v += __uint_as_float(__builtin_amdgcn_update_dpp(0, __float_as_uint(v), 0xB1, 0xF, 0xF, true));
  v += __uint_as_float(__builtin_amdgcn_update_dpp(0, __float_as_uint(v), 0x4E, 0xF, 0xF, true));
  v += __uint_as_float(__builtin_amdgcn_update_dpp(0, __float_as_uint(v), 0x141, 0xF, 0xF, true));
  v += __uint_as_float(__builtin_amdgcn_update_dpp(0, __float_as_uint(v), 0x140, 0xF, 0xF, true));
  v += __uint_as_float(__builtin_amdgcn_update_dpp(0, __float_as_uint(v), 0x142, 0xA, 0xF, false));
  v += __uint_as_float(__builtin_amdgcn_update_dpp(0, __float_as_uint(v), 0x143, 0xC, 0xF, false));
  return __uint_as_float(__builtin_amdgcn_readlane(__float_as_uint(v), 63));
}
DI int crow(int reg, int h) { return (reg & 3) + 8 * (reg >> 2) + 4 * h; }
#define MFMA(a, b, c) __builtin_amdgcn_mfma_f32_32x32x16_bf16((a), (b), (c), 0, 0, 0)

DI int seq_row0(int s) { return s < 16 ? s * 4096 : NPR + (s - 16) * 32; }
DI int seq_len(int s) { return s < 16 ? 4096 : 32; }

struct LoadBf16 {
  const bf16_t* A; int lda;
  DI void stage(int row, int k, u32x4& a, u32x4& b) const { a = *(const u32x4*)(A + (size_t)row * lda + k); b = a; }
  DI u32x4 finish(const u32x4& a, const u32x4& b, int k) const { return a; }
};
struct LoadShiftMix {
  const bf16_t* H; const float* mu; const float* xlast;
  DI void stage(int row, int k, u32x4& a, u32x4& b) const {
    a = *(const u32x4*)(H + (size_t)row * 1024 + k);
    const bool first = row < NPR ? ((row & 4095) == 0) : (((row - NPR) & 31) == 0);
    if (!first) b = *(const u32x4*)(H + (size_t)(row - 1) * 1024 + k);
    else if (row >= NPR) {
      const float* xl = xlast + (size_t)((row - NPR) >> 5) * 1024 + k;
      const float4 x0 = *(const float4*)xl, x1 = *(const float4*)(xl + 4);
      const float pv[8] = {x0.x, x0.y, x0.z, x0.w, x1.x, x1.y, x1.z, x1.w};
      b = pack8(pv);
    } else b = (u32x4){0u, 0u, 0u, 0u};
  }
  DI u32x4 finish(const u32x4& a, const u32x4& b, int k) const {
    float hv[8], pv[8], o[8];
    unpack8(a, hv); unpack8(b, pv);
    const float4 m0 = *(const float4*)(mu + k), m1 = *(const float4*)(mu + k + 4);
    const float mv[8] = {m0.x, m0.y, m0.z, m0.w, m1.x, m1.y, m1.z, m1.w};
#pragma unroll
    for (int i = 0; i < 8; ++i) o[i] = hv[i] + (pv[i] - hv[i]) * mv[i];
    return pack8(o);
  }
};

template <int BK, class AL>
DI void gemm_tile(const AL& al, const bf16_t* __restrict__ Bt, int ldb, int K, int m0, int n0, f32x16 (&acc)[2][2], bf16_t* As) {
  constexpr int LDK = BK + 8, CPR = BK / 8, NL = BK / 16, RSTEP = 256 / CPR;
  bf16_t* Bs = As + 128 * LDK;
  const int tid = threadIdx.x, lane = tid & 63, w = tid >> 6, wm = w >> 1, wn = w & 1;
#pragma unroll
  for (int mi = 0; mi < 2; ++mi)
#pragma unroll
    for (int ni = 0; ni < 2; ++ni)
#pragma unroll
      for (int r = 0; r < 16; ++r) acc[mi][ni][r] = 0.f;
  u32x4 ra[NL], ra2[NL], rb[NL];
  const int lr = tid / CPR, lk = (tid % CPR) * 8;
#pragma unroll
  for (int j = 0; j < NL; ++j) { al.stage(m0 + lr + RSTEP * j, lk, ra[j], ra2[j]); rb[j] = *(const u32x4*)(Bt + (size_t)(n0 + lr + RSTEP * j) * ldb + lk); }
  const int nk = K / BK;
  const int frow = lane & 31, fk = (lane >> 5) * 8;
  for (int kt = 0; kt < nk; ++kt) {
    __syncthreads();
#pragma unroll
    for (int j = 0; j < NL; ++j) { *(u32x4*)(As + (lr + RSTEP * j) * LDK + lk) = al.finish(ra[j], ra2[j], kt * BK + lk); *(u32x4*)(Bs + (lr + RSTEP * j) * LDK + lk) = rb[j]; }
    __syncthreads();
    if (kt + 1 < nk) {
      const int k0 = (kt + 1) * BK;
#pragma unroll
      for (int j = 0; j < NL; ++j) { al.stage(m0 + lr + RSTEP * j, k0 + lk, ra[j], ra2[j]); rb[j] = *(const u32x4*)(Bt + (size_t)(n0 + lr + RSTEP * j) * ldb + k0 + lk); }
    }
    __builtin_amdgcn_sched_barrier(0);
#pragma unroll
    for (int kk = 0; kk < BK / 16; ++kk) {
      bf16x8 af[2], bfr[2];
#pragma unroll
      for (int mi = 0; mi < 2; ++mi) af[mi] = *(const bf16x8*)(As + (wm * 64 + mi * 32 + frow) * LDK + kk * 16 + fk);
#pragma unroll
      for (int ni = 0; ni < 2; ++ni) bfr[ni] = *(const bf16x8*)(Bs + (wn * 64 + ni * 32 + frow) * LDK + kk * 16 + fk);
#pragma unroll
      for (int mi = 0; mi < 2; ++mi)
#pragma unroll
        for (int ni = 0; ni < 2; ++ni) acc[mi][ni] = MFMA(bfr[ni], af[mi], acc[mi][ni]);
    }
  }
}

template <class AL>
DI void gemm_tile_db(const AL& al, const bf16_t* __restrict__ Bt, int ldb, int K, int m0, int n0, f32x16 (&acc)[2][2], bf16_t* smem) {
  constexpr int LDK = 72, TB = 128 * LDK;
  const int tid = threadIdx.x, lane = tid & 63, w = tid >> 6, wm = w >> 1, wn = w & 1;
#pragma unroll
  for (int mi = 0; mi < 2; ++mi)
#pragma unroll
    for (int ni = 0; ni < 2; ++ni)
#pragma unroll
      for (int r = 0; r < 16; ++r) acc[mi][ni][r] = 0.f;
  u32x4 ra0[4], rc0[4], rb0[4], ra1[4], rc1[4], rb1[4];
  const int lr = tid >> 3, lk = (tid & 7) * 8;
  const int nk = K >> 6;
  const int frow = lane & 31, fk = (lane >> 5) * 8;
  const bf16_t* Bp = Bt + (size_t)(n0 + lr) * ldb + lk;
#define GDB_STAGE(RA, RC, RB, kt_)                                                                                     \
  {                                                                                                                    \
    _Pragma("unroll") for (int j = 0; j < 4; ++j) {                                                                    \
      al.stage(m0 + lr + 32 * j, (kt_) * 64 + lk, RA[j], RC[j]);                                                       \
      RB[j] = *(const u32x4*)(Bp + (size_t)(32 * j) * ldb + (kt_) * 64);                                               \
    }                                                                                                                  \
  }
#define GDB_WRITE(RA, RC, RB, kt_, buf_)                                                                               \
  {                                                                                                                    \
    bf16_t* Aw = smem + (buf_) * 2 * TB; bf16_t* Bw = Aw + TB;                                                         \
    _Pragma("unroll") for (int j = 0; j < 4; ++j) {                                                                    \
      *(u32x4*)(Aw + (lr + 32 * j) * LDK + lk) = al.finish(RA[j], RC[j], (kt_) * 64 + lk);                            \
      *(u32x4*)(Bw + (lr + 32 * j) * LDK + lk) = RB[j];                                                                \
    }                                                                                                                  \
  }
#define GDB_KK(buf_, kk_)                                                                                              \
  {                                                                                                                    \
    const bf16_t* Ar = smem + (buf_) * 2 * TB; const bf16_t* Br = Ar + TB;                                             \
    bf16x8 af[2], bfr[2];                                                                                              \
    _Pragma("unroll") for (int mi = 0; mi < 2; ++mi) af[mi] = *(const bf16x8*)(Ar + (wm * 64 + mi * 32 + frow) * LDK + (kk_) * 16 + fk);  \
    _Pragma("unroll") for (int ni = 0; ni < 2; ++ni) bfr[ni] = *(const bf16x8*)(Br + (wn * 64 + ni * 32 + frow) * LDK + (kk_) * 16 + fk); \
    _Pragma("unroll") for (int mi = 0; mi < 2; ++mi)                                                                   \
      _Pragma("unroll") for (int ni = 0; ni < 2; ++ni) acc[mi][ni] = MFMA(bfr[ni], af[mi], acc[mi][ni]);               \
  }
#define GDB_ITER(kt_, cur_, RAn, RCn, RBn)                                                                             \
  {                                                                                                                    \
    GDB_KK(cur_, 0)                                                                                                    \
    if ((kt_) + 1 < nk) GDB_WRITE(RAn, RCn, RBn, (kt_) + 1, (cur_) ^ 1)                                                \
    if ((kt_) + 3 < nk) GDB_STAGE(RAn, RCn, RBn, (kt_) + 3)                                                            \
    GDB_KK(cur_, 1) GDB_KK(cur_, 2) GDB_KK(cur_, 3)                                                                    \
    __syncthreads();                                                                                                   \
  }
  GDB_STAGE(ra0, rc0, rb0, 0)
  if (nk > 1) GDB_STAGE(ra1, rc1, rb1, 1)
  __syncthreads();
  GDB_WRITE(ra0, rc0, rb0, 0, 0)
  if (nk > 2) GDB_STAGE(ra0, rc0, rb0, 2)
  __syncthreads();
  for (int kt = 0; kt < nk; kt += 2) {
    GDB_ITER(kt, 0, ra1, rc1, rb1)
    if (kt + 1 < nk) GDB_ITER(kt + 1, 1, ra0, rc0, rb0)
  }
#undef GDB_STAGE
#undef GDB_WRITE
#undef GDB_KK
#undef GDB_ITER
}

template <class E>
DI void epilogue(const f32x16 (&acc)[2][2], int m0, int n0, E&& e, float* Cs) {
  const int tid = threadIdx.x, lane = tid & 63, w = tid >> 6, wm = w >> 1, wn = w & 1;
  __syncthreads();
#pragma unroll
  for (int mi = 0; mi < 2; ++mi)
#pragma unroll
    for (int ni = 0; ni < 2; ++ni)
#pragma unroll
      for (int g = 0; g < 4; ++g) {
        const int row = wm * 64 + mi * 32 + (lane & 31);
        const int col = wn * 64 + ni * 32 + 8 * g + 4 * (lane >> 5);
        *(float4*)(Cs + row * 132 + col) = make_float4(acc[mi][ni][4 * g], acc[mi][ni][4 * g + 1], acc[mi][ni][4 * g + 2], acc[mi][ni][4 * g + 3]);
      }
  __syncthreads();
#pragma unroll 4
  for (int it = 0; it < 16; ++it) {
    const int idx = tid + 256 * it, row = idx >> 5, col = (idx & 31) * 4;
    const float4 v = *(const float4*)(Cs + row * 132 + col);
    e(m0 + row, n0 + col, v.x, v.y, v.z, v.w);
  }
}

template <class F>
DI void for_tiles(int nM, int nN, F&& f) {
  const int x = blockIdx.x & 7, s = blockIdx.x >> 3, slots = gridDim.x >> 3;
  const int nFull = nN >> 3, wd = nN & 7, nRG8 = (nM + 7) >> 3, hr = wd ? 64 / wd : 1, cntP = wd ? (nM + hr - 1) / hr : 0;
  const int nSTf = nFull * nRG8, nST = nSTf + cntP;
  for (int e = s;; e += slots) {
    const int st = (e >> 6) * 8 + x;
    if (st >= nST) break;
    const int wi = e & 63;
    int tm, tn; bool ok;
    if (st < nSTf) { const int rg = st / nFull, cgi = st - rg * nFull; tm = rg * 8 + (wi & 7); tn = cgi * 8 + (wi >> 3); ok = tm < nM; }
    else { const int idx = st - nSTf, q = wi / hr; tm = idx * hr + (wi - q * hr); tn = nFull * 8 + q; ok = (q < wd) && (tm < nM); }
    if (ok) f(tm, tn);
  }
}

DI void st_bf4(bf16_t* p, float a, float b, float c, float d) { u32x2 q; q.x = pack2(a, b); q.y = pack2(c, d); *(u32x2*)p = q; }

DI void transpose_cvt(const float* __restrict__ W, int K, int N, bf16_t* __restrict__ Wt, int Npad, float* tile) {
  const int tK = K >> 5, tN = Npad >> 5;
  const int tx = threadIdx.x & 31, ty = threadIdx.x >> 5;
  for (int t = blockIdx.x; t < tK * tN; t += gridDim.x) {
    const int tk = t % tK, tn = t / tK;
    __syncthreads();
#pragma unroll
    for (int i = 0; i < 4; ++i) { const int k = tk * 32 + ty + 8 * i, n = tn * 32 + tx; tile[(ty + 8 * i) * 33 + tx] = (n < N) ? W[(size_t)k * N + n] : 0.f; }
    __syncthreads();
#pragma unroll
    for (int i = 0; i < 4; ++i) { const int n = tn * 32 + ty + 8 * i, k = tk * 32 + tx; Wt[(size_t)n * K + k] = f2bf(tile[tx * 33 + ty + 8 * i]); }
  }
}
DI void cvt_bf16(const float* __restrict__ src, bf16_t* __restrict__ dst, size_t n) {
  const size_t stride = (size_t)gridDim.x * 256 * 8;
  for (size_t i = ((size_t)blockIdx.x * 256 + threadIdx.x) * 8; i < n; i += stride) {
    float4 a = *(const float4*)(src + i), b = *(const float4*)(src + i + 4);
    float f[8] = {a.x, a.y, a.z, a.w, b.x, b.y, b.z, b.w};
    *(u32x4*)(dst + i) = pack8(f);
  }
}

DI void cvt_fp8_rows(const float* __restrict__ src, unsigned char* __restrict__ dst, float* __restrict__ scale) {
  const int lane = threadIdx.x & 63, gw = blockIdx.x * 4 + (threadIdx.x >> 6), nw = gridDim.x * 4;
  for (int row = gw; row < 16384; row += nw) {
    float4 v[4]; float m = 0.f;
#pragma unroll
    for (int j = 0; j < 4; ++j) { v[j] = *(const float4*)(src + (size_t)row * 1024 + lane * 4 + 256 * j); m = fmaxf(m, fmaxf(fmaxf(fabsf(v[j].x), fabsf(v[j].y)), fmaxf(fabsf(v[j].z), fabsf(v[j].w)))); }
    for (int o = 32; o > 0; o >>= 1) m = fmaxf(m, __shfl_xor(m, o));
    const float sc = m > 0.f ? m * (1.f / 224.f) : 1.f, inv = 1.f / sc;
#pragma unroll
    for (int j = 0; j < 4; ++j) {
      int q = 0;
      q = __builtin_amdgcn_cvt_pk_fp8_f32(v[j].x * inv, v[j].y * inv, q, false);
      q = __builtin_amdgcn_cvt_pk_fp8_f32(v[j].z * inv, v[j].w * inv, q, true);
      *(int*)(dst + ((size_t)(2 * j + (lane >> 5)) * 16384 + row) * 128 + ((lane * 4) & 127)) = q;
    }
    if (lane == 0) scale[row] = sc;
  }
}
DI void rmsnorm_rows(const Params& p, const float* __restrict__ X, bool from_input, const float* __restrict__ g, bf16_t* __restrict__ out) {
  const int lane = threadIdx.x & 63, gw = blockIdx.x * 4 + (threadIdx.x >> 6), nw = gridDim.x * 4;
  float4 gv[4];
#pragma unroll
  for (int j = 0; j < 4; ++j) gv[j] = *(const float4*)(g + lane * 4 + 256 * j);
  for (int row = gw; row < NT; row += nw) {
    const float* xr;
    if (from_input) xr = row < NPR ? p.in[I_XP] + (size_t)row * 1024 : p.in[I_XS] + (size_t)(row - NPR) * 1024;
    else xr = X + (size_t)row * 1024;
    float4 v[4]; float ss = 0.f;
#pragma unroll
    for (int j = 0; j < 4; ++j) { v[j] = *(const float4*)(xr + lane * 4 + 256 * j); ss += v[j].x * v[j].x + v[j].y * v[j].y + v[j].z * v[j].z + v[j].w * v[j].w; }
    ss = wave_sum(ss);
    const float rs = rsqrtf(ss * (1.f / 1024.f) + 1e-6f);
#pragma unroll
    for (int j = 0; j < 4; ++j) st_bf4(out + (size_t)row * 1024 + lane * 4 + 256 * j, v[j].x * rs * gv[j].x, v[j].y * rs * gv[j].y, v[j].z * rs * gv[j].z, v[j].w * rs * gv[j].w);
  }
}

DI void phase0(const Params& p, unsigned char* smem) {
  float* tile = (float*)smem;
  unsigned char* ws = p.ws;
  transpose_cvt(p.in[I_WIN], 1024, 3600, (bf16_t*)(ws + OFF_WT_IN), 3712, tile);
  transpose_cvt(p.in[I_WOUTAB], 1024, 1024, (bf16_t*)(ws + OFF_WT_OUTAB), 1024, tile);
  bf16_t* wrk = (bf16_t*)(ws + OFF_WT_RK);
  for (int i = 0; i < 3; ++i) transpose_cvt(p.in[I_WRKV] + (size_t)i * 1024 * 1024, 1024, 1024, wrk + (size_t)i * 1024 * 1024, 1024, tile);
  transpose_cvt(p.in[I_WW1], 1024, 64, wrk + (size_t)3072 * 1024, 128, tile);
  transpose_cvt(p.in[I_AW1], 1024, 64, wrk + (size_t)3200 * 1024, 128, tile);
  transpose_cvt(p.in[I_GW1], 1024, 128, wrk + (size_t)3328 * 1024, 128, tile);
  transpose_cvt(p.in[I_WW2], 64, 1024, (bf16_t*)(ws + OFF_WT_W2), 1024, tile);
  transpose_cvt(p.in[I_AW2], 64, 1024, (bf16_t*)(ws + OFF_WT_A2), 1024, tile);
  transpose_cvt(p.in[I_GWW2], 128, 1024, (bf16_t*)(ws + OFF_WT_G2), 1024, tile);
  transpose_cvt(p.in[I_WOUTC], 1024, 1024, (bf16_t*)(ws + OFF_WT_OUTC), 1024, tile);
  for (int l = 0; l < 2; ++l) transpose_cvt(p.in[I_PWQ] + (size_t)l * 1024 * 2048, 1024, 2048, (bf16_t*)(ws + OFF_WT_Q) + (size_t)l * 2048 * 1024, 2048, tile);
  cvt_bf16(p.in[I_PSK], (bf16_t*)(ws + OFF_SK), (size_t)2 * 16 * 128 * 128);
  cvt_fp8_rows(p.in[I_PU], ws + OFF_U8, (float*)(ws + OFF_USC));
  cvt_fp8_rows(p.in[I_PV], ws + OFF_V8, (float*)(ws + OFF_VSC));
  if (blockIdx.x == 0) {
    float* lbs = (float*)(ws + OFF_LBS);
    for (int c = threadIdx.x; c < 512; c += 256) {
      const float a0 = p.in[I_LB][c], a1 = p.in[I_LB][512 + c], a2 = p.in[I_LB][1024 + c];
      const float m = fmaxf(a0, fmaxf(a1, a2));
      const float e0 = expf(a0 - m), e1 = expf(a1 - m), e2 = expf(a2 - m);
      lbs[c] = e0 / (e0 + e1 + e2);
    }
  }
  rmsnorm_rows(p, nullptr, true, p.in[I_N1], (bf16_t*)(ws + OFF_HA));
}

DI void phase1(const Params& p, unsigned char* smem) {
  unsigned char* ws = p.ws;
  bf16_t* As = (bf16_t*)smem;
  const float* lbs = (const float*)(ws + OFF_LBS);
  bf16_t* QA = (bf16_t*)(ws + OFF_QA); float* F = (float*)(ws + OFF_F); bf16_t* VA = (bf16_t*)(ws + OFF_VA); bf16_t* GA = (bf16_t*)(ws + OFF_GA);
  bf16_t* QB = (bf16_t*)(ws + OFF_QB); bf16_t* KB = (bf16_t*)(ws + OFF_KB); bf16_t* VB = (bf16_t*)(ws + OFF_VB); bf16_t* GB = (bf16_t*)(ws + OFF_GB);
  float* LR = (float*)(ws + OFF_LR);
  for_tiles(NT / 128, 29, [&](int tm, int tn) {
    f32x16 acc[2][2];
    gemm_tile_db(LoadBf16{(const bf16_t*)(ws + OFF_HA), 1024}, (const bf16_t*)(ws + OFF_WT_IN), 1024, 1024, tm * 128, tn * 128, acc, As);
    epilogue(acc, tm * 128, tn * 128, [&](int row, int col, float a, float b, float c, float d) {
      if (col < 512) st_bf4(QA + (size_t)row * 512 + col, siluf_(a), siluf_(b), siluf_(c), siluf_(d));
      else if (col < 1024) {
        const int cc = col - 512; const float4 lb = *(const float4*)(lbs + cc);
        float4 o; o.x = lb.x + (1.f - lb.x) * sigmoidf_(a); o.y = lb.y + (1.f - lb.y) * sigmoidf_(b); o.z = lb.z + (1.f - lb.z) * sigmoidf_(c); o.w = lb.w + (1.f - lb.w) * sigmoidf_(d);
        *(float4*)(F + (size_t)row * 512 + cc) = o;
      } else if (col < 1536) st_bf4(VA + (size_t)row * 512 + col - 1024, a, b, c, d);
      else if (col < 2048) st_bf4(GA + (size_t)row * 512 + col - 1536, siluf_(a), siluf_(b), siluf_(c), siluf_(d));
      else if (col < 2304) st_bf4(QB + (size_t)row * 256 + col - 2048, a * 0.125f, b * 0.125f, c * 0.125f, d * 0.125f);
      else if (col < 2560) st_bf4(KB + (size_t)row * 256 + col - 2304, a, b, c, d);
      else if (col < 3072) st_bf4(VB + (size_t)row * 512 + col - 2560, a, b, c, d);
      else if (col < 3088) { float4 o = {a, b, c, d}; *(float4*)(LR + (size_t)row * 16 + col - 3072) = o; }
      else if (col < 3600) st_bf4(GB + (size_t)row * 512 + col - 3088, siluf_(a), siluf_(b), siluf_(c), siluf_(d));
    }, (float*)smem);
  });
}

DI int chunk_index(int seq, int c) { return seq < 16 ? seq * 64 + c : 1024 + (seq - 16); }
template <int K, bool GLA>
DI void pre_unit(const Params& p, int seq, int c, int head, unsigned char* smem) {
  constexpr int NPART = 256 / K, TPER = 64 / NPART;
  unsigned char* ws = p.ws;
  float* part = (float*)smem;
  const int tid = threadIdx.x, k = tid % K, tp = tid / K;
  const int row0 = seq_row0(seq), T = seq_len(seq);
  bf16_t* qsrc; const float* fsrc = nullptr; const bf16_t* ksrc = nullptr; bf16_t* kdst; int ldq;
  float w2c[16]; float gbias = 0.f;
  if (!GLA) {
    qsrc = (bf16_t*)(ws + OFF_QA) + head * 128 + k; fsrc = (const float*)(ws + OFF_F) + head * 128 + k; ldq = 512;
    kdst = (bf16_t*)(ws + OFF_KTA) + head * 128 + k;
#pragma unroll
    for (int r = 0; r < 16; ++r) w2c[r] = 0.f;
  } else {
    qsrc = (bf16_t*)(ws + OFF_QB) + head * 64 + k; ksrc = (const bf16_t*)(ws + OFF_KB) + head * 64 + k; ldq = 256;
    kdst = (bf16_t*)(ws + OFF_KTB) + head * 64 + k;
#pragma unroll
    for (int r = 0; r < 16; ++r) w2c[r] = p.in[I_GW2][r * 256 + head * 64 + k];
    gbias = p.in[I_GB][head * 64 + k];
  }
  const float* LR = (const float*)(ws + OFF_LR);
  struct LD { float4 l0, l1, l2, l3; float f; unsigned short kraw, qraw; };
  auto ld_issue = [&](size_t row, LD& d, bool withq) {
    if (!GLA) d.f = fsrc[row * 512];
    else { const float4* lp = (const float4*)(LR + row * 16); d.l0 = lp[0]; d.l1 = lp[1]; d.l2 = lp[2]; d.l3 = lp[3]; d.kraw = ksrc[row * ldq]; }
    if (withq) d.qraw = qsrc[row * ldq];
  };
  auto ld_eval = [&](const LD& d, float& kval) -> float {
    if (!GLA) { kval = 1.f - d.f; return __logf(d.f); }
    const float x = gbias + d.l0.x * w2c[0] + d.l0.y * w2c[1] + d.l0.z * w2c[2] + d.l0.w * w2c[3] + d.l1.x * w2c[4] + d.l1.y * w2c[5] + d.l1.z * w2c[6] + d.l1.w * w2c[7]
                    + d.l2.x * w2c[8] + d.l2.y * w2c[9] + d.l2.z * w2c[10] + d.l2.w * w2c[11] + d.l3.x * w2c[12] + d.l3.y * w2c[13] + d.l3.z * w2c[14] + d.l3.w * w2c[15];
    kval = bf2f(d.kraw);
    return (fminf(x, 0.f) - log1pf(__expf(-fabsf(x)))) * (1.f / 16.f);
  };
  constexpr int BT = GLA ? 4 : 16;
  float run = 0.f;
#pragma unroll
  for (int t0 = 0; t0 < TPER; t0 += BT) {
    LD ld[BT];
#pragma unroll
    for (int u = 0; u < BT; ++u) { const int ta = c * 64 + tp * TPER + t0 + u; ld_issue((size_t)(row0 + (ta < T ? ta : 0)), ld[u], false); }
    __builtin_amdgcn_sched_barrier(0);
#pragma unroll
    for (int u = 0; u < BT; ++u) { const int ta = c * 64 + tp * TPER + t0 + u; float kd; const float g = ld_eval(ld[u], kd); run += (ta < T) ? g : 0.f; }
  }
  __syncthreads();
  part[tp * K + k] = run;
  __syncthreads();
  float off = 0.f, tot = 0.f;
#pragma unroll
  for (int pp = 0; pp < NPART; ++pp) { const float v = part[pp * K + k]; tot += v; if (pp < tp) off += v; }
  if (tp == 0) ((float*)(ws + OFF_EBL))[(size_t)chunk_index(seq, c) * 768 + (GLA ? 512 : 0) + head * K + k] = __expf(tot);
  run = off;
#pragma unroll
  for (int t0 = 0; t0 < TPER; t0 += BT) {
    LD ld[BT];
#pragma unroll
    for (int u = 0; u < BT; ++u) { const int ta = c * 64 + tp * TPER + t0 + u; ld_issue((size_t)(row0 + (ta < T ? ta : 0)), ld[u], true); }
    __builtin_amdgcn_sched_barrier(0);
#pragma unroll
    for (int u = 0; u < BT; ++u) {
      const int ta = c * 64 + tp * TPER + t0 + u; const bool valid = ta < T;
      const size_t row = (size_t)(row0 + (valid ? ta : 0));
      float kd; const float g = ld_eval(ld[u], kd);
      run += valid ? g : 0.f;
      if (valid) {
        qsrc[row * ldq] = f2bf(bf2f(ld[u].qraw) * __expf(run));
        kdst[row * ldq] = f2bf(kd * __expf(-run));
      }
    }
  }
}
DI void phase_pre(const Params& p, unsigned char* smem) {
  for (int it = blockIdx.x; it < 1040 * 8; it += gridDim.x) {
    const int kind = it & 1, head = (it >> 1) & 3, ci = it >> 3;
    const int seq = ci < 1024 ? (ci >> 6) : 16 + (ci - 1024), c = ci < 1024 ? (ci & 63) : 0;
    if (kind == 0) pre_unit<128, false>(p, seq, c, head, smem);
    else pre_unit<64, true>(p, seq, c, head, smem);
  }
}

template <int K, bool GLA>
DI void chunk_unit(const Params& p, int seq, int head, int vs, unsigned char* smem) {
  constexpr int KP = K + 8, KT = K / 32, NQ = K / 32, CPR = K / 8;
  unsigned char* ws = p.ws;
  bf16_t* Qs = (bf16_t*)smem;
  bf16_t* Ks = Qs + 64 * KP;
  bf16_t* KsT = Ks + 64 * KP;
  bf16_t* VT = KsT + K * 72;
  bf16_t* Am = VT + 32 * 72;
  bf16_t* ST = Am + 64 * 72;
  float* bl = (float*)(ST + 32 * KP);
  const int tid = threadIdx.x, lane = tid & 63, w = tid >> 6, hh = lane >> 5, l31 = lane & 31;
  const int row0 = seq_row0(seq), T = seq_len(seq), nch = (T + 63) >> 6;
  const bf16_t* qsrc = GLA ? (const bf16_t*)(ws + OFF_QB) + head * 64 : (const bf16_t*)(ws + OFF_QA) + head * 128;
  const bf16_t* ksrc = GLA ? (const bf16_t*)(ws + OFF_KTB) + head * 64 : (const bf16_t*)(ws + OFF_KTA) + head * 128;
  const int ldq = GLA ? 256 : 512;
  const bf16_t* vsrc = (const bf16_t*)(ws + (GLA ? OFF_VB : OFF_VA)) + head * 128 + vs * 32;
  const float* ebl = (const float*)(ws + OFF_EBL) + (GLA ? 512 : 0) + head * K;
  bf16_t* odst = (bf16_t*)(ws + OFF_ORAW) + (GLA ? 512 : 0) + head * 128 + vs * 32;
  f32x16 S;
#pragma unroll
  for (int r = 0; r < 16; ++r) S[r] = 0.f;
  float* sout; const float* sin = nullptr;
  {
    const int b = seq & 15;
    const size_t hoff = GLA ? ((size_t)(b * 4 + head) * 64) * 128 : ((size_t)(b * 4 + head) * 128) * 128;
    sout = p.out + (seq < 16 ? (GLA ? O_PG : O_PH) : (GLA ? O_SG : O_SH)) + hoff + vs * 32;
    if (seq >= 16) sin = p.in[GLA ? I_SG : I_SH] + hoff + vs * 32;
  }
  u32x4 rq[NQ], rk[NQ], rv; float rbl = 1.f;
  auto gload = [&](int c) {
#pragma unroll
    for (int j = 0; j < NQ; ++j) {
      const int cj = tid + 256 * j, t = cj / CPR, k8 = (cj % CPR) * 8, ta = c * 64 + t;
      if (ta < T) { rq[j] = *(const u32x4*)(qsrc + (size_t)(row0 + ta) * ldq + k8); rk[j] = *(const u32x4*)(ksrc + (size_t)(row0 + ta) * ldq + k8); }
      else { rq[j] = (u32x4){0u, 0u, 0u, 0u}; rk[j] = (u32x4){0u, 0u, 0u, 0u}; }
    }
    const int s = tid >> 2, vq = tid & 3, ta = c * 64 + s;
    rv = (u32x4){0u, 0u, 0u, 0u};
    if (ta < T) rv = *(const u32x4*)(vsrc + (size_t)(row0 + ta) * 512 + vq * 8);
    if (tid < K) rbl = ebl[(size_t)chunk_index(seq, c) * 768 + tid];
  };
  gload(0);
  __syncthreads();
  if (w < KT) {
    if (sin) {
#pragma unroll
      for (int r = 0; r < 16; ++r) S[r] = sin[(size_t)(w * 32 + crow(r, hh)) * 128 + l31];
    }
#pragma unroll
    for (int g = 0; g < 4; ++g) st_bf4(ST + l31 * KP + w * 32 + 8 * g + 4 * hh, S[4 * g], S[4 * g + 1], S[4 * g + 2], S[4 * g + 3]);
  }
  for (int c = 0; c < nch; ++c) {
#pragma unroll
    for (int j = 0; j < NQ; ++j) {
      const int cj = tid + 256 * j, t = cj / CPR, k8 = (cj % CPR) * 8;
      *(u32x4*)(Qs + t * KP + k8) = rq[j];
      *(u32x4*)(Ks + t * KP + k8) = rk[j];
      const unsigned kk4[4] = {rk[j].x, rk[j].y, rk[j].z, rk[j].w};
#pragma unroll
      for (int e = 0; e < 4; ++e) { KsT[(k8 + 2 * e) * 72 + t] = (bf16_t)(kk4[e] & 0xffffu); KsT[(k8 + 2 * e + 1) * 72 + t] = (bf16_t)(kk4[e] >> 16); }
    }
    {
      const int s = tid >> 2, vq = tid & 3;
      const unsigned qq[4] = {rv.x, rv.y, rv.z, rv.w};
#pragma unroll
      for (int j = 0; j < 4; ++j) { VT[(vq * 8 + 2 * j) * 72 + s] = (bf16_t)(qq[j] & 0xffffu); VT[(vq * 8 + 2 * j + 1) * 72 + s] = (bf16_t)(qq[j] >> 16); }
    }
    if (tid < K) bl[tid] = rbl;
    __syncthreads();
    if (c + 1 < nch) gload(c + 1);
    {
      const int tm = w >> 1, tn = w & 1;
      f32x16 a;
#pragma unroll
      for (int r = 0; r < 16; ++r) a[r] = 0.f;
      if (tn <= tm) {
#pragma unroll
        for (int ks = 0; ks < K / 16; ++ks) {
          const bf16x8 qf = *(const bf16x8*)(Qs + (tm * 32 + l31) * KP + ks * 16 + hh * 8);
          const bf16x8 kf = *(const bf16x8*)(Ks + (tn * 32 + l31) * KP + ks * 16 + hh * 8);
          a = MFMA(kf, qf, a);
        }
      }
      const int t = tm * 32 + l31;
#pragma unroll
      for (int g = 0; g < 4; ++g) {
        const int s0 = tn * 32 + 8 * g + 4 * hh;
        float v0 = (s0 <= t) ? a[4 * g] : 0.f, v1 = (s0 + 1 <= t) ? a[4 * g + 1] : 0.f, v2 = (s0 + 2 <= t) ? a[4 * g + 2] : 0.f, v3 = (s0 + 3 <= t) ? a[4 * g + 3] : 0.f;
        if (tn > tm) { v0 = v1 = v2 = v3 = 0.f; }
        st_bf4(Am + t * 72 + s0, v0, v1, v2, v3);
      }
    }
    if (w < KT) {
#pragma unroll
      for (int ks = 0; ks < 4; ++ks) {
        const bf16x8 af = *(const bf16x8*)(KsT + (w * 32 + l31) * 72 + ks * 16 + hh * 8);
        const bf16x8 bf = *(const bf16x8*)(VT + l31 * 72 + ks * 16 + hh * 8);
        S = MFMA(af, bf, S);
      }
    }
    __syncthreads();
    if (w < 2) {
      f32x16 o;
#pragma unroll
      for (int r = 0; r < 16; ++r) o[r] = 0.f;
#pragma unroll
      for (int ks = 0; ks < 4; ++ks) {
        const bf16x8 af = *(const bf16x8*)(Am + (w * 32 + l31) * 72 + ks * 16 + hh * 8);
        const bf16x8 bf = *(const bf16x8*)(VT + l31 * 72 + ks * 16 + hh * 8);
        o = MFMA(af, bf, o);
      }
#pragma unroll
      for (int ks = 0; ks < K / 16; ++ks) {
        const bf16x8 af = *(const bf16x8*)(Qs + (w * 32 + l31) * KP + ks * 16 + hh * 8);
        const bf16x8 bf = *(const bf16x8*)(ST + l31 * KP + ks * 16 + hh * 8);
        o = MFMA(af, bf, o);
      }
#pragma unroll
      for (int r = 0; r < 16; ++r) {
        const int ta = c * 64 + w * 32 + crow(r, hh);
        if (ta < T) odst[(size_t)(row0 + ta) * 1024 + l31] = f2bf(o[r]);
      }
    }
    __syncthreads();
    if (w < KT) {
#pragma unroll
      for (int r = 0; r < 16; ++r) S[r] *= bl[w * 32 + crow(r, hh)];
#pragma unroll
      for (int g = 0; g < 4; ++g) st_bf4(ST + l31 * KP + w * 32 + 8 * g + 4 * hh, S[4 * g], S[4 * g + 1], S[4 * g + 2], S[4 * g + 3]);
    }
    __syncthreads();
  }
  if (w < KT) {
#pragma unroll
    for (int r = 0; r < 16; ++r) sout[(size_t)(w * 32 + crow(r, hh)) * 128 + l31] = S[r];
  }
  __syncthreads();
}

DI void phase2(const Params& p, unsigned char* smem) {
  for (int u = blockIdx.x; u < 1024; u += gridDim.x) {
    const int kind = (u >> 8) & 1, idx = u & 255, seq = (idx >> 4) + (u >= 512 ? 16 : 0), head = (idx >> 2) & 3, vs = idx & 3;
    if (kind == 0) chunk_unit<128, false>(p, seq, head, vs, smem);
    else chunk_unit<64, true>(p, seq, head, vs, smem);
  }
}

DI void phase3(const Params& p, unsigned char*) {
  unsigned char* ws = p.ws;
  const int lane = threadIdx.x & 63, gw = blockIdx.x * 4 + (threadIdx.x >> 6), nw = gridDim.x * 4;
  const bf16_t* O = (const bf16_t*)(ws + OFF_ORAW);
  const bf16_t* G = (const bf16_t*)(ws + (lane < 32 ? OFF_GA : OFF_GB)) + (lane & 31) * 16;
  const float* ng = p.in[lane < 32 ? I_HNG : I_GNG] + (lane & 7) * 16;
  float gv[16];
#pragma unroll
  for (int i = 0; i < 16; ++i) gv[i] = ng[i];
  bf16_t* out = (bf16_t*)(ws + OFF_HA);
  for (int row = gw; row < NT; row += nw) {
    const u32x4 o0 = *(const u32x4*)(O + (size_t)row * 1024 + lane * 16), o1 = *(const u32x4*)(O + (size_t)row * 1024 + lane * 16 + 8);
    const u32x4 g0 = *(const u32x4*)(G + (size_t)row * 512), g1 = *(const u32x4*)(G + (size_t)row * 512 + 8);
    float ov[16], gt[16];
    unpack8(o0, ov); unpack8(o1, ov + 8); unpack8(g0, gt); unpack8(g1, gt + 8);
    float ss = 0.f;
#pragma unroll
    for (int i = 0; i < 16; ++i) ss += ov[i] * ov[i];
    ss += __shfl_xor(ss, 1); ss += __shfl_xor(ss, 2); ss += __shfl_xor(ss, 4);
    const float rs = rsqrtf(ss * (1.f / 128.f) + 1e-6f);
    float r[16];
#pragma unroll
    for (int i = 0; i < 16; ++i) r[i] = ov[i] * rs * gv[i] * gt[i];
    *(u32x4*)(out + (size_t)row * 1024 + lane * 16) = pack8(r);
    *(u32x4*)(out + (size_t)row * 1024 + lane * 16 + 8) = pack8(r + 8);
  }
}

DI void phase_outproj(const Params& p, unsigned char* smem, size_t offA, size_t offW, bool first) {
  unsigned char* ws = p.ws;
  bf16_t* As = (bf16_t*)smem;
  float* X = p.out;
  for_tiles(NT / 128, 8, [&](int tm, int tn) {
    f32x16 acc[2][2];
    gemm_tile_db(LoadBf16{(const bf16_t*)(ws + offA), 1024}, (const bf16_t*)(ws + offW), 1024, 1024, tm * 128, tn * 128, acc, As);
    epilogue(acc, tm * 128, tn * 128, [&](int row, int col, float a, float b, float c, float d) {
      const float* src = first ? (row < NPR ? p.in[I_XP] + (size_t)row * 1024 + col : p.in[I_XS] + (size_t)(row - NPR) * 1024 + col) : X + (size_t)row * 1024 + col;
      float4 x = *(const float4*)src;
      x.x += a; x.y += b; x.z += c; x.w += d;
      *(float4*)(X + (size_t)row * 1024 + col) = x;
    }, (float*)smem);
  });
}

DI void phase_norm2(const Params& p, int layer) { rmsnorm_rows(p, p.out, false, p.in[I_N2] + layer * 1024, (bf16_t*)(p.ws + OFF_HA)); }

DI void phase_qp(const Params& p, unsigned char* smem, int layer) {
  unsigned char* ws = p.ws;
  bf16_t* As = (bf16_t*)smem;
  bf16_t* QP = (bf16_t*)(ws + OFF_QP);
  for_tiles(NT / 128, 16, [&](int tm, int tn) {
    f32x16 acc[2][2];
    gemm_tile_db(LoadBf16{(const bf16_t*)(ws + OFF_HA), 1024}, (const bf16_t*)(ws + OFF_WT_Q) + (size_t)layer * 2048 * 1024, 1024, 1024, tm * 128, tn * 128, acc, As);
    epilogue(acc, tm * 128, tn * 128, [&](int row, int col, float a, float b, float c, float d) { st_bf4(QP + (size_t)row * 2048 + col, a, b, c, d); }, (float*)smem);
  });
}

DI unsigned f2key(float f, int idx) { unsigned u = __float_as_uint(f); u = (u & 0x80000000u) ? ~u : (u | 0x80000000u); return (u & ~127u) | (unsigned)(127 - idx); }
DI float key2f(unsigned k) { k &= ~127u; const unsigned u = (k & 0x80000000u) ? (k & 0x7fffffffu) : ~k; return __uint_as_float(u); }
DI void phase_route(const Params& p, unsigned char* smem, int layer) {
  unsigned char* ws = p.ws;
  bf16_t* As = (bf16_t*)smem;
  unsigned* sk = (unsigned*)smem;
  float* lv = (float*)smem;
  int* li = (int*)(smem + 16384);
  float* sv1 = (float*)(smem + 32768);
  unsigned char* si1 = smem + 32768 + 8192;
  float* sv0 = (float*)(smem + 65536);
  unsigned char* si0 = smem + 65536 + 8192;
  const bf16_t* QP = (const bf16_t*)(ws + OFF_QP);
  const bf16_t* SK = (const bf16_t*)(ws + OFF_SK);
  int* EIDX = (int*)(ws + OFF_EIDX); float* GATE = (float*)(ws + OFF_GATE);
  const int tid = threadIdx.x, lane = tid & 63, w = tid >> 6, wm = w >> 1, wn = w & 1;
  const int ntile = (NT / 128) * 8;
  for (int t = blockIdx.x; t < ntile; t += gridDim.x) {
    const int tm = t >> 3, h = t & 7;
    for (int p2 = 0; p2 < 2; ++p2) {
      f32x16 acc[2][2];
      gemm_tile<64>(LoadBf16{QP + (h * 2 + p2) * 128, 2048}, SK + (size_t)((layer * 8 + h) * 2 + p2) * 128 * 128, 128, 128, tm * 128, 0, acc, As);
      __syncthreads();
#pragma unroll
      for (int mi = 0; mi < 2; ++mi)
#pragma unroll
        for (int ni = 0; ni < 2; ++ni)
#pragma unroll
          for (int g4 = 0; g4 < 4; ++g4) {
            const int m = wm * 64 + mi * 32 + (lane & 31), n = wn * 64 + ni * 32 + 8 * g4 + 4 * (lane >> 5);
            *(u32x4*)(sk + m * 128 + 4 * ((n >> 2) ^ (m & 31))) = (u32x4){f2key(acc[mi][ni][4 * g4], n), f2key(acc[mi][ni][4 * g4 + 1], n + 1), f2key(acc[mi][ni][4 * g4 + 2], n + 2), f2key(acc[mi][ni][4 * g4 + 3], n + 3)};
          }
      __syncthreads();
      const int row = tid & 127, half = tid >> 7, sw = row & 31;
      unsigned keys[16];
#pragma unroll
      for (int r = 0; r < 16; ++r) {
        unsigned best = 0u;
#pragma unroll
        for (int q = 0; q < 16; ++q) {
          const u32x4 v = *(const u32x4*)(sk + row * 128 + 4 * ((half * 16 + q) ^ sw));
          best = max(max(best, v.x), v.y); best = max(max(best, v.z), v.w);
        }
        const int bidx = 127 - (int)(best & 127u);
        sk[row * 128 + 4 * ((bidx >> 2) ^ sw) + (bidx & 3)] = 0u;
        keys[r] = best;
      }
      __syncthreads();
#pragma unroll
      for (int r = 0; r < 16; ++r) { lv[r * 256 + tid] = key2f(keys[r]); li[r * 256 + tid] = 127 - (int)(keys[r] & 127u); }
      __syncthreads();
      if (tid < 128) {
        float* dv = p2 ? sv1 : sv0; unsigned char* di = p2 ? si1 : si0;
        int a = 0, b = 0;
#pragma unroll 1
        for (int r = 0; r < 16; ++r) {
          const float va = lv[a * 256 + row], vb = lv[b * 256 + 128 + row];
          const bool ta = va >= vb;
          dv[r * 128 + row] = ta ? va : vb;
          di[r * 128 + row] = (unsigned char)(ta ? li[a * 256 + row] : li[b * 256 + 128 + row]);
          a += ta ? 1 : 0; b += ta ? 0 : 1;
        }
      }
      __syncthreads();
    }
    if (tid < 128) {
      const int row = tid;
      unsigned long long jp = 0ull;
      float cs[16]; int ce[16];
#pragma unroll
      for (int r = 0; r < 16; ++r) {
        float best = -INFINITY; int bi_ = 0;
#pragma unroll
        for (int i = 0; i < 16; ++i) {
          const int j = (int)((jp >> (4 * i)) & 15ull);
          const float v = sv0[i * 128 + row] + sv1[j * 128 + row];
          if (v > best) { best = v; bi_ = i; }
        }
        const int j = (int)((jp >> (4 * bi_)) & 15ull);
        ce[r] = (int)si0[bi_ * 128 + row] * 128 + (int)si1[j * 128 + row];
        cs[r] = best;
        jp += 1ull << (4 * bi_);
      }
      float e[16], sum = 0.f;
#pragma unroll
      for (int r = 0; r < 16; ++r) { e[r] = __expf(cs[r] - cs[0]); sum += e[r]; }
      const float inv = 1.f / sum;
      const size_t base = ((size_t)(tm * 128 + row) * 8 + h) * 16;
#pragma unroll
      for (int r = 0; r < 16; ++r) { EIDX[base + r] = ce[r]; GATE[base + r] = e[r] * inv; }
    }
    __syncthreads();
  }
}

DI float dot2bf(unsigned a, unsigned b, float c) {
  typedef __bf16 bf2 __attribute__((ext_vector_type(2)));
  return __builtin_amdgcn_fdot2_f32_bf16(__builtin_bit_cast(bf2, a), __builtin_bit_cast(bf2, b), c, false);
}

#define CVT8(q, hi) __builtin_amdgcn_cvt_pk_f32_fp8((int)(q), hi)
DI float dpp_x1(float v) { return __uint_as_float(__builtin_amdgcn_update_dpp(0, __float_as_uint(v), 0xB1, 0xF, 0xF, true)); }
DI float dpp_x2(float v) { return __uint_as_float(__builtin_amdgcn_update_dpp(0, __float_as_uint(v), 0x4E, 0xF, 0xF, true)); }
DI float dpp_hm(float v) { return __uint_as_float(__builtin_amdgcn_update_dpp(0, __float_as_uint(v), 0x141, 0xF, 0xF, true)); }
DI f32x2 shx2(const f32x2& v, int m) { f32x2 r; r.x = __shfl_xor(v.x, m); r.y = __shfl_xor(v.y, m); return r; }

struct TokU { u32x4 xa, xb; int ev0, ev1; };
DI void phase_peer_u(const Params& p) {
  unsigned char* ws = p.ws;
  const int lane = threadIdx.x & 63, r = lane >> 3, s = lane & 7;
  const int x = blockIdx.x & 7, lw = (blockIdx.x >> 3) * 4 + (threadIdx.x >> 6), nlw = (gridDim.x >> 3) * 4;
  const unsigned char* U8s = ws + OFF_U8 + (size_t)x * 16384 * 128 + 16 * s;
  const int* EIDX = (const int*)(ws + OFF_EIDX);
  const bf16_t* HA = (const bf16_t*)(ws + OFF_HA);
  float* HP = (float*)(ws + OFF_HP) + (size_t)x * NT * 128;
  auto load_tok = [&](int t, TokU& k) {
    const bf16_t* hp = HA + (size_t)t * 1024 + 128 * x + 16 * s;
    k.xa = *(const u32x4*)hp; k.xb = *(const u32x4*)(hp + 8);
    k.ev0 = EIDX[(size_t)t * 128 + lane]; k.ev1 = EIDX[(size_t)t * 128 + 64 + lane];
  };
  auto gather = [&](const TokU& k, u32x4 (&g)[16]) {
#pragma unroll
    for (int i = 0; i < 16; ++i) { const int e = __shfl(i < 8 ? k.ev0 : k.ev1, (8 * i + r) & 63); g[i] = *(const u32x4*)(U8s + (size_t)e * 128); }
  };
  auto compute = [&](int t, const f32x2 (&xs)[8], const u32x4 (&g)[16]) {
    float keep0 = 0.f, keep1 = 0.f;
#pragma unroll
    for (int i = 0; i < 16; ++i) {
      const u32x4 u = g[i];
      f32x2 d = CVT8(u.x, false) * xs[0];
      d = CVT8(u.x, true) * xs[1] + d; d = CVT8(u.y, false) * xs[2] + d; d = CVT8(u.y, true) * xs[3] + d;
      d = CVT8(u.z, false) * xs[4] + d; d = CVT8(u.z, true) * xs[5] + d; d = CVT8(u.w, false) * xs[6] + d; d = CVT8(u.w, true) * xs[7] + d;
      float ds = d.x + d.y;
      ds += dpp_x1(ds); ds += dpp_x2(ds); ds += dpp_hm(ds);
      if (s == (i & 7)) { if (i < 8) keep0 = ds; else keep1 = ds; }
    }
    HP[(size_t)t * 128 + 8 * s + r] = keep0; HP[(size_t)t * 128 + 64 + 8 * s + r] = keep1;
  };
#define PU_STEP(kc, gc, kn, gn)                                                                                        \
  {                                                                                                                    \
    const int tn = t + nlw; const bool has_next = tn < NT;                                                             \
    if (has_next) gather(kn, gn);                                                                                      \
    const f32x2 xs[8] = {{lo2f(kc.xa.x), hi2f(kc.xa.x)}, {lo2f(kc.xa.y), hi2f(kc.xa.y)}, {lo2f(kc.xa.z), hi2f(kc.xa.z)}, {lo2f(kc.xa.w), hi2f(kc.xa.w)}, \
                         {lo2f(kc.xb.x), hi2f(kc.xb.x)}, {lo2f(kc.xb.y), hi2f(kc.xb.y)}, {lo2f(kc.xb.z), hi2f(kc.xb.z)}, {lo2f(kc.xb.w), hi2f(kc.xb.w)}}; \
    if (tn + nlw < NT) load_tok(tn + nlw, kc);                                                                         \
    __builtin_amdgcn_sched_barrier(0);                                                                                 \
    compute(t, xs, gc);                                                                                                \
    t = tn; if (!has_next) break;                                                                                      \
  }
  int t = lw;
  if (t < NT) {
    TokU ka, kb; u32x4 ga[16], gb[16];
    load_tok(t, ka); gather(ka, ga);
    if (t + nlw < NT) load_tok(t + nlw, kb);
    while (true) {
      PU_STEP(ka, ga, kb, gb)
      PU_STEP(kb, gb, ka, ga)
    }
  }
#undef PU_STEP
}

DI void phase_peer_act(const Params& p) {
  unsigned char* ws = p.ws;
  const float* HP = (const float*)(ws + OFF_HP);
  const float* USC = (const float*)(ws + OFF_USC); const float* VSC = (const float*)(ws + OFF_VSC);
  const int* EIDX = (const int*)(ws + OFF_EIDX); float* GATE = (float*)(ws + OFF_GATE);
  const size_t n = (size_t)NT * 128, stride = (size_t)gridDim.x * 256 * 4;
  for (size_t idx = ((size_t)blockIdx.x * 256 + threadIdx.x) * 4; idx < n; idx += stride) {
    float4 hp[8];
#pragma unroll
    for (int x = 0; x < 8; ++x) hp[x] = *(const float4*)(HP + (size_t)x * n + idx);
    const int4 e4 = *(const int4*)(EIDX + idx);
    const float4 g4 = *(const float4*)(GATE + idx);
    __builtin_amdgcn_sched_barrier(0);
    const float us[4] = {USC[e4.x], USC[e4.y], USC[e4.z], USC[e4.w]};
    const float vs[4] = {VSC[e4.x], VSC[e4.y], VSC[e4.z], VSC[e4.w]};
    float h[4] = {0.f, 0.f, 0.f, 0.f};
#pragma unroll
    for (int x = 0; x < 8; ++x) { h[0] += hp[x].x; h[1] += hp[x].y; h[2] += hp[x].z; h[3] += hp[x].w; }
    const float gg[4] = {g4.x, g4.y, g4.z, g4.w};
    float o[4];
#pragma unroll
    for (int j = 0; j < 4; ++j) { const float hh = h[j] * us[j]; o[j] = 0.5f * hh * (1.f + erff(hh * 0.70710678118f)) * gg[j] * vs[j]; }
    *(float4*)(GATE + idx) = make_float4(o[0], o[1], o[2], o[3]);
  }
}

struct TokV { int ev0, ev1; float ac0, ac1; float2 xv; };
DI void phase_peer_v(const Params& p) {
  unsigned char* ws = p.ws;
  const int lane = threadIdx.x & 63, r = lane >> 3, s = lane & 7;
  const int x = blockIdx.x & 7, lw = (blockIdx.x >> 3) * 4 + (threadIdx.x >> 6), nlw = (gridDim.x >> 3) * 4;
  const unsigned char* V8s = ws + OFF_V8 + (size_t)x * 16384 * 128 + 16 * s;
  const int* EIDX = (const int*)(ws + OFF_EIDX); const float* ACT = (const float*)(ws + OFF_GATE);
  float* X = p.out; float* SSP = (float*)(ws + OFF_SSP) + (size_t)x * NT;
  const int xoff = 128 * x + 16 * s + 2 * r;
  auto load_tok = [&](int t, TokV& k) {
    k.ev0 = EIDX[(size_t)t * 128 + lane]; k.ev1 = EIDX[(size_t)t * 128 + 64 + lane];
    k.ac0 = ACT[(size_t)t * 128 + lane]; k.ac1 = ACT[(size_t)t * 128 + 64 + lane];
    k.xv = *(const float2*)(X + (size_t)t * 1024 + xoff);
  };
  auto gather = [&](const TokV& k, u32x4 (&g)[16]) {
#pragma unroll
    for (int i = 0; i < 16; ++i) { const int e = __shfl(i < 8 ? k.ev0 : k.ev1, (8 * i + r) & 63); g[i] = *(const u32x4*)(V8s + (size_t)e * 128); }
  };
  auto compute = [&](int t, float ac0, float ac1, float2 xv, const u32x4 (&g)[16]) {
    f32x2 acc[8];
#pragma unroll
    for (int i = 0; i < 8; ++i) acc[i] = (f32x2){0.f, 0.f};
#pragma unroll
    for (int i = 0; i < 16; ++i) {
      const float a = __shfl(i < 8 ? ac0 : ac1, (8 * i + r) & 63);
      const u32x4 v = g[i];
      const f32x2 aa = {a, a};
      acc[0] = CVT8(v.x, false) * aa + acc[0]; acc[1] = CVT8(v.x, true) * aa + acc[1];
      acc[2] = CVT8(v.y, false) * aa + acc[2]; acc[3] = CVT8(v.y, true) * aa + acc[3];
      acc[4] = CVT8(v.z, false) * aa + acc[4]; acc[5] = CVT8(v.z, true) * aa + acc[5];
      acc[6] = CVT8(v.w, false) * aa + acc[6]; acc[7] = CVT8(v.w, true) * aa + acc[7];
    }
    f32x2 b4[4], b2[2];
#pragma unroll
    for (int m = 0; m < 4; ++m) { const f32x2 keep = (r & 4) ? acc[4 + m] : acc[m], send = (r & 4) ? acc[m] : acc[4 + m]; b4[m] = keep + shx2(send, 32); }
#pragma unroll
    for (int m = 0; m < 2; ++m) { const f32x2 keep = (r & 2) ? b4[2 + m] : b4[m], send = (r & 2) ? b4[m] : b4[2 + m]; b2[m] = keep + shx2(send, 16); }
    const f32x2 keep = (r & 1) ? b2[1] : b2[0], send = (r & 1) ? b2[0] : b2[1];
    const f32x2 o = keep + shx2(send, 8);
    xv.x += o.x; xv.y += o.y;
    *(float2*)(X + (size_t)t * 1024 + xoff) = xv;
    const float ss = wave_sum(xv.x * xv.x + xv.y * xv.y);
    if (lane == 0) SSP[t] = ss;
  };
#define PV_STEP(kc, gc, kn, gn)                                                                                        \
  {                                                                                                                    \
    const int tn = t + nlw; const bool has_next = tn < NT;                                                             \
    if (has_next) gather(kn, gn);                                                                                      \
    const float c0 = kc.ac0, c1 = kc.ac1; const float2 cx = kc.xv;                                                     \
    if (tn + nlw < NT) load_tok(tn + nlw, kc);                                                                         \
    __builtin_amdgcn_sched_barrier(0);                                                                                 \
    compute(t, c0, c1, cx, gc);                                                                                        \
    t = tn; if (!has_next) break;                                                                                      \
  }
  int t = lw;
  if (t < NT) {
    TokV ka, kb; u32x4 ga[16], gb[16];
    load_tok(t, ka); gather(ka, ga);
    if (t + nlw < NT) load_tok(t + nlw, kb);
    while (true) {
      PV_STEP(ka, ga, kb, gb)
      PV_STEP(kb, gb, ka, ga)
    }
  }
#undef PV_STEP
}

DI void phase_peer_norm(const Params& p, int layer) {
  unsigned char* ws = p.ws;
  const int lane = threadIdx.x & 63, gw = blockIdx.x * 4 + (threadIdx.x >> 6), nw = gridDim.x * 4;
  const float* SSP = (const float*)(ws + OFF_SSP);
  bf16_t* HA = (bf16_t*)(ws + OFF_HA);
  float* X = p.out;
  const float* gn = layer == 0 ? p.in[I_N1] + 1024 : p.in[I_FG];
  float4 gv[4];
#pragma unroll
  for (int j = 0; j < 4; ++j) gv[j] = *(const float4*)(gn + lane * 4 + 256 * j);
  for (int row = gw; row < NT; row += nw) {
    float sp[8];
#pragma unroll
    for (int x = 0; x < 8; ++x) sp[x] = SSP[(size_t)x * NT + row];
    float* xr = X + (size_t)row * 1024;
    float4 xin[4];
#pragma unroll
    for (int j = 0; j < 4; ++j) xin[j] = *(const float4*)(xr + lane * 4 + 256 * j);
    __builtin_amdgcn_sched_barrier(0);
    const float ss = ((sp[0] + sp[1]) + (sp[2] + sp[3])) + ((sp[4] + sp[5]) + (sp[6] + sp[7]));
    const float rs = rsqrtf(ss * (1.f / 1024.f) + 1e-6f);
    float* so = nullptr;
    if (layer == 0) {
      if (row < NPR) { if ((row & 4095) == 4095) so = p.out + O_PS + (size_t)(row >> 12) * 1024; }
      else { if (((row - NPR) & 31) == 31) so = p.out + O_SS + (size_t)((row - NPR) >> 5) * 1024; }
    }
#pragma unroll
    for (int j = 0; j < 4; ++j) {
      const float4 v = xin[j];
      const float4 y = make_float4(v.x * rs * gv[j].x, v.y * rs * gv[j].y, v.z * rs * gv[j].z, v.w * rs * gv[j].w);
      if (layer == 0) {
        st_bf4(HA + (size_t)row * 1024 + lane * 4 + 256 * j, y.x, y.y, y.z, y.w);
        if (so) *(float4*)(so + lane * 4 + 256 * j) = y;
      } else *(float4*)(xr + lane * 4 + 256 * j) = y;
    }
  }
}

DI void phase9(const Params& p, unsigned char* smem) {
  unsigned char* ws = p.ws;
  bf16_t* As = (bf16_t*)smem;
  bf16_t* R = (bf16_t*)(ws + OFF_R); bf16_t* Kb = (bf16_t*)(ws + OFF_K); bf16_t* V = (bf16_t*)(ws + OFF_V);
  bf16_t* W1 = (bf16_t*)(ws + OFF_W1); bf16_t* A1 = (bf16_t*)(ws + OFF_A1); bf16_t* G1 = (bf16_t*)(ws + OFF_G1);
  for_tiles(NT / 128, 27, [&](int tm, int tn) {
    const int mi_ = tn < 24 ? (tn >> 3) : tn - 21;
    f32x16 acc[2][2];
    gemm_tile<64>(LoadShiftMix{(const bf16_t*)(ws + OFF_HA), p.in[I_MU] + mi_ * 1024, p.in[I_SS]}, (const bf16_t*)(ws + OFF_WT_RK), 1024, 1024, tm * 128, tn * 128, acc, As);
    epilogue(acc, tm * 128, tn * 128, [&](int row, int col, float a, float b, float c, float d) {
      if (col < 1024) st_bf4(R + (size_t)row * 1024 + col, a, b, c, d);
      else if (col < 2048) st_bf4(Kb + (size_t)row * 1024 + col - 1024, a, b, c, d);
      else if (col < 3072) st_bf4(V + (size_t)row * 1024 + col - 2048, a, b, c, d);
      else if (col < 3136) st_bf4(W1 + (size_t)row * 64 + col - 3072, tanhf(a), tanhf(b), tanhf(c), tanhf(d));
      else if (col < 3200) {}
      else if (col < 3264) st_bf4(A1 + (size_t)row * 64 + col - 3200, a, b, c, d);
      else if (col < 3328) {}
      else st_bf4(G1 + (size_t)row * 128 + col - 3328, sigmoidf_(a), sigmoidf_(b), sigmoidf_(c), sigmoidf_(d));
    }, (float*)smem);
  });
}

DI float decay_of(float w) {
  const float nw = -w;
  const float sp = nw > 20.f ? nw : log1pf(__expf(nw));
  return __expf(-__expf(-sp - 0.5f));
}
DI unsigned short f2h(float x) { return __builtin_bit_cast(unsigned short, (_Float16)x); }

DI void phase10(const Params& p, unsigned char* smem) {
  unsigned char* ws = p.ws;
  bf16_t* As = (bf16_t*)smem;
  unsigned short* DEC = (unsigned short*)(ws + OFF_DEC); bf16_t* AA = (bf16_t*)(ws + OFF_AA); bf16_t* GG = (bf16_t*)(ws + OFF_GG);
  for_tiles(NT / 128, 24, [&](int tm, int tn) {
    const int grp = tn >> 3, n0 = (tn & 7) * 128;
    f32x16 acc[2][2];
    if (grp == 0) {
      gemm_tile<64>(LoadBf16{(const bf16_t*)(ws + OFF_W1), 64}, (const bf16_t*)(ws + OFF_WT_W2), 64, 64, tm * 128, n0, acc, As);
      epilogue(acc, tm * 128, n0, [&](int row, int col, float a, float b, float c, float d) {
        const float4 w0 = *(const float4*)(p.in[I_W0] + col);
        u32x2 q; q.x = (unsigned)f2h(decay_of(w0.x + a)) | ((unsigned)f2h(decay_of(w0.y + b)) << 16); q.y = (unsigned)f2h(decay_of(w0.z + c)) | ((unsigned)f2h(decay_of(w0.w + d)) << 16);
        *(u32x2*)(DEC + (size_t)row * 1024 + col) = q;
      }, (float*)smem);
    } else if (grp == 1) {
      gemm_tile<64>(LoadBf16{(const bf16_t*)(ws + OFF_A1), 64}, (const bf16_t*)(ws + OFF_WT_A2), 64, 64, tm * 128, n0, acc, As);
      epilogue(acc, tm * 128, n0, [&](int row, int col, float a, float b, float c, float d) {
        const float4 a0 = *(const float4*)(p.in[I_A0] + col);
        st_bf4(AA + (size_t)row * 1024 + col, sigmoidf_(a0.x + a), sigmoidf_(a0.y + b), sigmoidf_(a0.z + c), sigmoidf_(a0.w + d));
      }, (float*)smem);
    } else {
      gemm_tile<128>(LoadBf16{(const bf16_t*)(ws + OFF_G1), 128}, (const bf16_t*)(ws + OFF_WT_G2), 128, 128, tm * 128, n0, acc, As);
      epilogue(acc, tm * 128, n0, [&](int row, int col, float a, float b, float c, float d) { st_bf4(GG + (size_t)row * 1024 + col, a, b, c, d); }, (float*)smem);
    }
  });
}

DI float dpp_xor1(float v) { return __uint_as_float(__builtin_amdgcn_update_dpp(0, __float_as_uint(v), 0xB1, 0xF, 0xF, true)); }
DI float dpp_xor2(float v) { return __uint_as_float(__builtin_amdgcn_update_dpp(0, __float_as_uint(v), 0x4E, 0xF, 0xF, true)); }

DI void rwkv_unit(const Params& p, int seq, int head, int ih, unsigned char* smem) {
  unsigned char* ws = p.ws;
  float* buf = (float*)smem;
  float* obuf = buf + 32 * 384;
  const int tid = threadIdx.x, lane = tid & 63, w = tid >> 6, il = lane >> 3, jq = lane & 7, ii = w * 8 + il, i = ih * 32 + ii;
  const int row0 = seq_row0(seq), T = seq_len(seq), nch = T >> 5;
  const int b = seq & 15;
  f32x2 s2[4];
  const size_t soff = ((size_t)(b * 16 + head) * 64 + i) * 64 + jq * 8;
  if (seq >= 16) {
    const float* sp = p.in[I_SR] + soff;
#pragma unroll
    for (int j = 0; j < 4; ++j) s2[j] = (f32x2){sp[2 * j], sp[2 * j + 1]};
  } else {
#pragma unroll
    for (int j = 0; j < 4; ++j) s2[j] = (f32x2){0.f, 0.f};
  }
  const int pt = tid >> 3, jg = tid & 7, col = head * 64 + jg * 8;
  float ckk[8], cka[8], crk[8];
#pragma unroll
  for (int j = 0; j < 8; ++j) { ckk[j] = p.in[I_KK][col + j]; cka[j] = p.in[I_KA][col + j]; crk[j] = p.in[I_RK][col + j]; }
  const bf16_t* R = (const bf16_t*)(ws + OFF_R); const bf16_t* Kb = (const bf16_t*)(ws + OFF_K); const bf16_t* V = (const bf16_t*)(ws + OFF_V);
  const unsigned short* DEC = (const unsigned short*)(ws + OFF_DEC); const bf16_t* AA = (const bf16_t*)(ws + OFF_AA);
  float* BON = (float*)(ws + OFF_BON);
  bf16_t* O2 = (bf16_t*)(ws + OFF_ORAW2);
  u32x4 qr, qk, qv, qd, qa;
  {
    const size_t o = (size_t)(row0 + pt) * 1024 + col;
    qr = *(const u32x4*)(R + o); qk = *(const u32x4*)(Kb + o); qv = *(const u32x4*)(V + o); qd = *(const u32x4*)(DEC + o); qa = *(const u32x4*)(AA + o);
  }
  __syncthreads();
  for (int c = 0; c < nch; ++c) {
    {
      float r8[8], k8[8], v8[8], a8[8], d8[8];
      unpack8(qr, r8); unpack8(qk, k8); unpack8(qv, v8); unpack8(qa, a8);
      const half8 dh = __builtin_bit_cast(half8, qd);
#pragma unroll
      for (int j = 0; j < 8; ++j) d8[j] = (float)dh[j];
      float kkr[8], ss = 0.f, bon = 0.f, kp[8];
#pragma unroll
      for (int j = 0; j < 8; ++j) { kkr[j] = k8[j] * ckk[j]; ss += kkr[j] * kkr[j]; kp[j] = k8[j] * (1.f + (a8[j] - 1.f) * cka[j]); bon += r8[j] * kp[j] * crk[j]; }
      ss += dpp_x1(ss); ss += dpp_x2(ss); ss += dpp_hm(ss);
      bon += dpp_x1(bon); bon += dpp_x2(bon); bon += dpp_hm(bon);
      const float inv = rsqrtf(ss + 1e-12f);
      float* bb = buf + pt * 384 + jg * 8;
      float kkn[8], bbv[8];
#pragma unroll
      for (int j = 0; j < 8; ++j) { kkn[j] = kkr[j] * inv; bbv[j] = kkn[j] * a8[j]; }
      *(float4*)(bb) = make_float4(r8[0], r8[1], r8[2], r8[3]); *(float4*)(bb + 4) = make_float4(r8[4], r8[5], r8[6], r8[7]);
      *(float4*)(bb + 64) = make_float4(d8[0], d8[1], d8[2], d8[3]); *(float4*)(bb + 68) = make_float4(d8[4], d8[5], d8[6], d8[7]);
      *(float4*)(bb + 128) = make_float4(kp[0], kp[1], kp[2], kp[3]); *(float4*)(bb + 132) = make_float4(kp[4], kp[5], kp[6], kp[7]);
      *(float4*)(bb + 192) = make_float4(kkn[0], kkn[1], kkn[2], kkn[3]); *(float4*)(bb + 196) = make_float4(kkn[4], kkn[5], kkn[6], kkn[7]);
      *(float4*)(bb + 256) = make_float4(bbv[0], bbv[1], bbv[2], bbv[3]); *(float4*)(bb + 260) = make_float4(bbv[4], bbv[5], bbv[6], bbv[7]);
      *(float4*)(bb + 320) = make_float4(v8[0], v8[1], v8[2], v8[3]); *(float4*)(bb + 324) = make_float4(v8[4], v8[5], v8[6], v8[7]);
      if (jg == 0 && ih == 0) BON[(size_t)(row0 + c * 32 + pt) * 16 + head] = bon;
    }
    __syncthreads();
    if (c + 1 < nch) {
      const size_t o = (size_t)(row0 + (c + 1) * 32 + pt) * 1024 + col;
      qr = *(const u32x4*)(R + o); qk = *(const u32x4*)(Kb + o); qv = *(const u32x4*)(V + o); qd = *(const u32x4*)(DEC + o); qa = *(const u32x4*)(AA + o);
    }
    struct StepOps { float4 r0, r1, w0, w1, k0, k1, n0, n1, b0, b1; float vi; };
    auto ldops = [&](int t, StepOps& q) {
      const float* sb = buf + t * 384 + jq * 8;
      q.n0 = *(const float4*)(sb + 192); q.n1 = *(const float4*)(sb + 196);
      q.w0 = *(const float4*)(sb + 64); q.w1 = *(const float4*)(sb + 68);
      q.b0 = *(const float4*)(sb + 256); q.b1 = *(const float4*)(sb + 260);
      q.k0 = *(const float4*)(sb + 128); q.k1 = *(const float4*)(sb + 132);
      q.r0 = *(const float4*)(sb); q.r1 = *(const float4*)(sb + 4);
      q.vi = buf[t * 384 + 320 + i];
    };
    StepOps cu; ldops(0, cu);
#pragma unroll 4
    for (int t = 0; t < 32; ++t) {
      StepOps nx = cu;
      if (t + 1 < 32) ldops(t + 1, nx);
      __builtin_amdgcn_sched_barrier(0);
      const f32x2 rr2[4] = {{cu.r0.x, cu.r0.y}, {cu.r0.z, cu.r0.w}, {cu.r1.x, cu.r1.y}, {cu.r1.z, cu.r1.w}};
      const f32x2 ww2[4] = {{cu.w0.x, cu.w0.y}, {cu.w0.z, cu.w0.w}, {cu.w1.x, cu.w1.y}, {cu.w1.z, cu.w1.w}};
      const f32x2 kp2[4] = {{cu.k0.x, cu.k0.y}, {cu.k0.z, cu.k0.w}, {cu.k1.x, cu.k1.y}, {cu.k1.z, cu.k1.w}};
      const f32x2 kn2[4] = {{cu.n0.x, cu.n0.y}, {cu.n0.z, cu.n0.w}, {cu.n1.x, cu.n1.y}, {cu.n1.z, cu.n1.w}};
      const f32x2 bb2[4] = {{cu.b0.x, cu.b0.y}, {cu.b0.z, cu.b0.w}, {cu.b1.x, cu.b1.y}, {cu.b1.z, cu.b1.w}};
      const float vi = cu.vi;
      f32x2 sa2 = s2[0] * kn2[0];
      sa2 = s2[1] * kn2[1] + sa2; sa2 = s2[2] * kn2[2] + sa2; sa2 = s2[3] * kn2[3] + sa2;
      float sa = sa2.x + sa2.y;
      sa += dpp_x1(sa); sa += dpp_x2(sa); sa += dpp_hm(sa);
      const f32x2 nsa = {-sa, -sa}, vv = {vi, vi};
      f32x2 o2 = {0.f, 0.f};
#pragma unroll
      for (int j = 0; j < 4; ++j) {
        s2[j] = vv * kp2[j] + (nsa * bb2[j] + s2[j] * ww2[j]);
        o2 = s2[j] * rr2[j] + o2;
      }
      float o = o2.x + o2.y;
      o += dpp_x1(o); o += dpp_x2(o); o += dpp_hm(o);
      if (jq == 0) obuf[t * 32 + ii] = o;
      cu = nx;
    }
    __syncthreads();
    {
      const int ot = tid >> 3, oc = (tid & 7) * 4;
      const float4 ov = *(const float4*)(obuf + ot * 32 + oc);
      st_bf4(O2 + (size_t)(row0 + c * 32 + ot) * 1024 + head * 64 + ih * 32 + oc, ov.x, ov.y, ov.z, ov.w);
    }
  }
  {
    float* so = p.out + (seq < 16 ? O_PR : O_SR) + soff;
#pragma unroll
    for (int j = 0; j < 4; ++j) { so[2 * j] = s2[j].x; so[2 * j + 1] = s2[j].y; }
  }
  __syncthreads();
}
DI void phase11(const Params& p, unsigned char* smem) {
  for (int u = blockIdx.x; u < 1024; u += gridDim.x) {
    const int uu = u & 511;
    rwkv_unit(p, (uu & 15) + (u >= 512 ? 16 : 0), (uu >> 4) & 15, uu >> 8, smem);
  }
}

DI void phase12(const Params& p) {
  unsigned char* ws = p.ws;
  const int lane = threadIdx.x & 63, gw = blockIdx.x * 4 + (threadIdx.x >> 6), nw = gridDim.x * 4;
  const bf16_t* O2 = (const bf16_t*)(ws + OFF_ORAW2); const bf16_t* V = (const bf16_t*)(ws + OFF_V); const bf16_t* GG = (const bf16_t*)(ws + OFF_GG);
  const float* BON = (const float*)(ws + OFF_BON);
  bf16_t* A5 = (bf16_t*)(ws + OFF_A5);
  float lg[16], lb[16];
#pragma unroll
  for (int i = 0; i < 16; ++i) { lg[i] = p.in[I_LNG][lane * 16 + i]; lb[i] = p.in[I_LNB][lane * 16 + i]; }
  for (int row = gw; row < NT; row += nw) {
    const size_t o = (size_t)row * 1024 + lane * 16;
    float ov[16], vv[16], gg[16];
    unpack8(*(const u32x4*)(O2 + o), ov); unpack8(*(const u32x4*)(O2 + o + 8), ov + 8);
    unpack8(*(const u32x4*)(V + o), vv); unpack8(*(const u32x4*)(V + o + 8), vv + 8);
    unpack8(*(const u32x4*)(GG + o), gg); unpack8(*(const u32x4*)(GG + o + 8), gg + 8);
    const float bon = BON[(size_t)row * 16 + (lane >> 2)];
    float sm = 0.f;
#pragma unroll
    for (int i = 0; i < 16; ++i) sm += ov[i];
    sm += __shfl_xor(sm, 1); sm += __shfl_xor(sm, 2);
    const float mean = sm * (1.f / 64.f);
    float sq = 0.f;
#pragma unroll
    for (int i = 0; i < 16; ++i) { const float d = ov[i] - mean; sq += d * d; }
    sq += __shfl_xor(sq, 1); sq += __shfl_xor(sq, 2);
    const float rs = rsqrtf(sq * (1.f / 64.f) + 64e-5f);
    float r[16];
#pragma unroll
    for (int i = 0; i < 16; ++i) r[i] = ((ov[i] - mean) * rs * lg[i] + lb[i] + bon * vv[i]) * gg[i];
    *(u32x4*)(A5 + o) = pack8(r); *(u32x4*)(A5 + o + 8) = pack8(r + 8);
  }
}

DI void phase13(const Params& p, unsigned char* smem) {
  cvt_fp8_rows(p.in[I_PU] + (size_t)16384 * 1024, p.ws + OFF_U8, (float*)(p.ws + OFF_USC));
  cvt_fp8_rows(p.in[I_PV] + (size_t)16384 * 1024, p.ws + OFF_V8, (float*)(p.ws + OFF_VSC));
  phase_outproj(p, smem, OFF_A5, OFF_WT_OUTC, false);
}

template <int PH>
DI void run_phase(const Params& p, unsigned char* smem) {
  if (PH == 0) phase0(p, smem);
  else if (PH == 1) phase1(p, smem);
  else if (PH == 2) phase2(p, smem);
  else if (PH == 3) phase3(p, smem);
  else if (PH == 4) phase_outproj(p, smem, OFF_HA, OFF_WT_OUTAB, true);
  else if (PH == 5) phase_norm2(p, 0);
  else if (PH == 6) phase_qp(p, smem, 0);
  else if (PH == 7) phase_route(p, smem, 0);
  else if (PH == 8) phase_peer_u(p);
  else if (PH == 9) phase_peer_act(p);
  else if (PH == 10) phase_peer_v(p);
  else if (PH == 11) phase_peer_norm(p, 0);
  else if (PH == 12) phase9(p, smem);
  else if (PH == 13) phase10(p, smem);
  else if (PH == 14) phase11(p, smem);
  else if (PH == 15) phase12(p);
  else if (PH == 16) phase13(p, smem);
  else if (PH == 17) phase_norm2(p, 1);
  else if (PH == 18) phase_qp(p, smem, 1);
  else if (PH == 19) phase_route(p, smem, 1);
  else if (PH == 20) phase_peer_u(p);
  else if (PH == 21) phase_peer_act(p);
  else if (PH == 22) phase_peer_v(p);
  else if (PH == 23) phase_peer_norm(p, 1);
  else if (PH == 24) phase_pre(p, smem);
}

template <int PH>
__global__ void __launch_bounds__(256, 2) k_phase(Params p) {
  extern __shared__ __attribute__((aligned(16))) unsigned char smem[];
  run_phase<PH>(p, smem);
}

#ifndef PROBE_MASK
#define PROBE_MASK 0u
#endif
DI void grid_barrier(unsigned* cnt, unsigned target) {
  asm volatile("s_waitcnt vmcnt(0) lgkmcnt(0)" ::: "memory");
  __syncthreads();
  if (threadIdx.x == 0) {
    __builtin_amdgcn_fence(__ATOMIC_RELEASE, "agent");
    asm volatile("s_waitcnt vmcnt(0)" ::: "memory");
    __hip_atomic_fetch_add(cnt, 1u, __ATOMIC_RELAXED, __HIP_MEMORY_SCOPE_AGENT);
    while (__hip_atomic_load(cnt, __ATOMIC_RELAXED, __HIP_MEMORY_SCOPE_AGENT) < target) __builtin_amdgcn_s_sleep(1);
    __builtin_amdgcn_fence(__ATOMIC_ACQUIRE, "agent");
    asm volatile("s_waitcnt vmcnt(0)" ::: "memory");
  }
  __syncthreads();
}
template <int PH>
DI void mega_step(const Params& p, unsigned char* smem, cg::grid_group& grid, unsigned& nb, bool last) {
  run_phase<PH>(p, smem);
  if ((PROBE_MASK >> PH) & 1u) { grid.sync(); run_phase<PH>(p, smem); }
  if (!last) {
    if (PH == 0) grid.sync();
    else { ++nb; grid_barrier((unsigned*)(p.ws + OFF_GBAR), nb * gridDim.x); }
  }
}
__global__ void __launch_bounds__(256, 2) k_mega(Params p) {
  extern __shared__ __attribute__((aligned(16))) unsigned char smem[];
  cg::grid_group grid = cg::this_grid();
  unsigned nb = 0;
  mega_step<0>(p, smem, grid, nb, false); mega_step<1>(p, smem, grid, nb, false); mega_step<24>(p, smem, grid, nb, false); mega_step<2>(p, smem, grid, nb, false); mega_step<3>(p, smem, grid, nb, false);
  mega_step<4>(p, smem, grid, nb, false); mega_step<5>(p, smem, grid, nb, false); mega_step<6>(p, smem, grid, nb, false); mega_step<7>(p, smem, grid, nb, false);
  mega_step<8>(p, smem, grid, nb, false); mega_step<9>(p, smem, grid, nb, false); mega_step<10>(p, smem, grid, nb, false); mega_step<11>(p, smem, grid, nb, false);
  mega_step<12>(p, smem, grid, nb, false); mega_step<13>(p, smem, grid, nb, false); mega_step<14>(p, smem, grid, nb, false); mega_step<15>(p, smem, grid, nb, false);
  mega_step<16>(p, smem, grid, nb, false); mega_step<17>(p, smem, grid, nb, false); mega_step<18>(p, smem, grid, nb, false); mega_step<19>(p, smem, grid, nb, false);
  mega_step<20>(p, smem, grid, nb, false); mega_step<21>(p, smem, grid, nb, false); mega_step<22>(p, smem, grid, nb, false); mega_step<23>(p, smem, grid, nb, true);
}

template <int PH>
static void launch_phase(const Params& p, int grid, hipStream_t stream) {
  static bool attr = false;
  if (!attr) { hipFuncSetAttribute((const void*)k_phase<PH>, hipFuncAttributeMaxDynamicSharedMemorySize, LDS_BYTES); attr = true; }
  hipLaunchKernelGGL(k_phase<PH>, dim3(grid), dim3(256), LDS_BYTES, stream, p);
}

extern "C" void kernel_launch(void* const* d_in, const int* in_sizes, int n_in, void* d_out, int out_size, void* d_ws, size_t ws_size, hipStream_t stream) {
  Params p{};
  for (int i = 0; i < 36; ++i) p.in[i] = (const float*)d_in[i];
  p.out = (float*)d_out; p.ws = (unsigned char*)d_ws;
  if (ws_size < WS_END) { fprintf(stderr, "workspace too small: %zu < %zu\n", ws_size, (size_t)WS_END); return; }
#if MEGA
  static int grid_blocks = 0;
  if (!grid_blocks) {
    hipFuncSetAttribute((const void*)k_mega, hipFuncAttributeMaxDynamicSharedMemorySize, LDS_BYTES);
    int dev = 0, cus = 0, per_cu = 0;
    hipGetDevice(&dev);
    hipDeviceGetAttribute(&cus, hipDeviceAttributeMultiprocessorCount, dev);
    hipOccupancyMaxActiveBlocksPerMultiprocessor(&per_cu, k_mega, 256, LDS_BYTES);
    if (per_cu > 2) per_cu = 2;
    if (per_cu < 1) per_cu = 1;
    grid_blocks = cus * per_cu;
  }
  hipMemsetAsync((unsigned char*)d_ws + OFF_GBAR, 0, 256, stream);
  void* args[] = {&p};
  hipError_t e = hipLaunchCooperativeKernel((void*)k_mega, dim3(grid_blocks), dim3(256), args, LDS_BYTES, stream);
  if (e != hipSuccess) fprintf(stderr, "cooperative launch failed: %s (grid %d)\n", hipGetErrorString(e), grid_blocks);
#else
  const int grid = 512;
  launch_phase<0>(p, grid, stream); launch_phase<1>(p, grid, stream); launch_phase<24>(p, grid, stream); launch_phase<2>(p, grid, stream); launch_phase<3>(p, grid, stream);
  launch_phase<4>(p, grid, stream); launch_phase<5>(p, grid, stream); launch_phase<6>(p, grid, stream); launch_phase<7>(p, grid, stream);
  launch_phase<8>(p, grid, stream); launch_phase<9>(p, grid, stream); launch_phase<10>(p, grid, stream); launch_phase<11>(p, grid, stream);
  launch_phase<12>(p, grid, stream); launch_phase<13>(p, grid, stream); launch_phase<14>(p, grid, stream); launch_phase<15>(p, grid, stream);
  launch_phase<16>(p, grid, stream); launch_phase<17>(p, grid, stream); launch_phase<18>(p, grid, stream); launch_phase<19>(p, grid, stream);
  launch_phase<20>(p, grid, stream); launch_phase<21>(p, grid, stream); launch_phase<22>(p, grid, stream); launch_phase<23>(p, grid, stream);
#endif
}
```

```cpp
#include <hip/hip_runtime.h>
#include <hip/hip_cooperative_groups.h>
#include <cstdio>
namespace cg = cooperative_groups;

#ifndef MEGA
#define MEGA 1
#endif

#define DI __device__ __forceinline__
typedef unsigned short bf16_t;
typedef short bf16x8 __attribute__((ext_vector_type(8)));
typedef float f32x16 __attribute__((ext_vector_type(16)));
typedef _Float16 half8 __attribute__((ext_vector_type(8)));
typedef unsigned u32x4 __attribute__((ext_vector_type(4)));
typedef unsigned u32x2 __attribute__((ext_vector_type(2)));
typedef float f32x2 __attribute__((ext_vector_type(2)));

constexpr int NT = 66048;
constexpr int NPR = 65536;
constexpr size_t U = (size_t)NT * 1024 * 2;
constexpr int LDS_BYTES = 77824;

constexpr size_t S0 = 0, S1 = U, S2 = 2 * U, S3 = 3 * U, S4 = 4 * U, S5 = 5 * U, S6 = 6 * U;
constexpr size_t OFF_HA = S0;
constexpr size_t OFF_QA = S1, OFF_F = S1 + U / 2, OFF_VA = S1 + U / 2 + U, OFF_GA = S1 + 2 * U, OFF_QB = S1 + 2 * U + U / 2,
                 OFF_KB = OFF_QB + U / 4, OFF_VB = S1 + 3 * U, OFF_GB = OFF_VB + U / 2, OFF_LR = S1 + 4 * U;
constexpr size_t OFF_ORAW = S6;
constexpr size_t OFF_EBL = S5 + (size_t)8 * 1024 * 1024, OFF_KTA = S5 + U / 4, OFF_KTB = OFF_KTA + U / 2;
constexpr size_t OFF_QP = S1;
constexpr size_t OFF_EIDX = S3, OFF_GATE = S3 + U / 4;
constexpr size_t OFF_HP = S1, OFF_SSP = S4;
constexpr size_t OFF_R = S1, OFF_K = S2, OFF_V = S3, OFF_DEC = S4, OFF_AA = S5, OFF_GG = S6, OFF_ORAW2 = S0, OFF_A5 = S4;
constexpr size_t OFF_TAB = 7 * U;
constexpr size_t TAB_BYTES = (size_t)16384 * 1024 * 2;
constexpr size_t OFF_U8 = OFF_TAB, OFF_V8 = OFF_TAB + (size_t)16384 * 1024, OFF_USC = OFF_V8 + (size_t)16384 * 1024, OFF_VSC = OFF_USC + 65536;
constexpr size_t OFF_W1 = OFF_TAB, OFF_A1 = OFF_W1 + (size_t)NT * 64 * 2, OFF_G1 = OFF_A1 + (size_t)NT * 64 * 2,
                 OFF_BON = OFF_G1 + (size_t)NT * 128 * 2;
constexpr size_t OFF_W = OFF_TAB + 2 * TAB_BYTES;
constexpr size_t OFF_WT_IN = OFF_W;
constexpr size_t OFF_WT_OUTAB = OFF_WT_IN + (size_t)3712 * 1024 * 2;
constexpr size_t OFF_WT_RK = OFF_WT_OUTAB + (size_t)1024 * 1024 * 2;
constexpr size_t OFF_WT_W2 = OFF_WT_RK + (size_t)3456 * 1024 * 2;
constexpr size_t OFF_WT_A2 = OFF_WT_W2 + (size_t)1024 * 64 * 2;
constexpr size_t OFF_WT_G2 = OFF_WT_A2 + (size_t)1024 * 64 * 2;
constexpr size_t OFF_WT_OUTC = OFF_WT_G2 + (size_t)1024 * 128 * 2;
constexpr size_t OFF_WT_Q = OFF_WT_OUTC + (size_t)1024 * 1024 * 2;
constexpr size_t OFF_SK = OFF_WT_Q + (size_t)2 * 2048 * 1024 * 2;
constexpr size_t OFF_LBS = OFF_SK + (size_t)2 * 16 * 128 * 128 * 2;
constexpr size_t OFF_GBAR = OFF_LBS + 2048;
constexpr size_t WS_END = OFF_GBAR + 256;

constexpr size_t O_PH = 67633152, O_PG = 68681728, O_PR = 69206016, O_PS = 70254592,
                 O_SH = 70270976, O_SG = 71319552, O_SR = 71843840, O_SS = 72892416;

struct Params { const float* in[36]; float* out; unsigned char* ws; };

enum { I_XP = 0, I_XS, I_SH, I_SG, I_SR, I_SS, I_WIN, I_LB, I_HNG, I_GW2, I_GB, I_GNG, I_WOUTAB, I_MU, I_WRKV, I_WW1, I_WW2, I_W0,
       I_AW1, I_AW2, I_A0, I_GW1, I_GWW2, I_KK, I_KA, I_RK, I_LNG, I_LNB, I_WOUTC, I_N1, I_N2, I_FG, I_PWQ, I_PSK, I_PU, I_PV };

DI float bf2f(bf16_t u) { return __uint_as_float(((unsigned)u) << 16); }
DI unsigned pack2(float lo, float hi) { unsigned r; asm("v_cvt_pk_bf16_f32 %0, %1, %2" : "=v"(r) : "v"(lo), "v"(hi)); return r; }
DI bf16_t f2bf(float x) { return (bf16_t)(pack2(x, 0.f) & 0xffffu); }
DI float lo2f(unsigned p) { return __uint_as_float(p << 16); }
DI float hi2f(unsigned p) { return __uint_as_float(p & 0xffff0000u); }
DI void unpack8(const u32x4& q, float* f) { f[0] = lo2f(q.x); f[1] = hi2f(q.x); f[2] = lo2f(q.y); f[3] = hi2f(q.y); f[4] = lo2f(q.z); f[5] = hi2f(q.z); f[6] = lo2f(q.w); f[7] = hi2f(q.w); }
DI u32x4 pack8(const float* f) { u32x4 q; q.x = pack2(f[0], f[1]); q.y = pack2(f[2], f[3]); q.z = pack2(f[4], f[5]); q.w = pack2(f[6], f[7]); return q; }
DI float sigmoidf_(float x) { return 1.f / (1.f + __expf(-x)); }
DI float siluf_(float x) { return x / (1.f + __expf(-x)); }
DI float wave_sum(float v) {
  v += __uint_as_float(__builtin_amdgcn_update_dpp(0, __float_as_uint(v), 0xB1, 0xF, 0xF, true));
  v += __uint_as_float(__builtin_amdgcn_update_dpp(0, __float_as_uint(v), 0x4E, 0xF, 0xF, true));
  v += __uint_as_float(__builtin_amdgcn_update_dpp(0, __float_as_uint(v), 0x141, 0xF, 0xF, true));
  v += __uint_as_float(__builtin_amdgcn_update_dpp(0, __float_as_uint(v), 0x140, 0xF, 0xF, true));
  v += __uint_as_float(__builtin_amdgcn_update_dpp(0, __float_as_uint(v), 0x142, 0xA, 0xF, false));
  v += __uint_as_float(__builtin_amdgcn_update_dpp(0, __float_as_uint(v), 0x143, 0xC, 0xF, false));
  return __uint_as_float(__builtin_amdgcn_readlane(__float_as_uint(v), 63));
}
DI int crow(int reg, int h) { return (reg & 3) + 8 * (reg >> 2) + 4 * h; }
#define MFMA(a, b, c) __builtin_amdgcn_mfma_f32_32x32x16_bf16((a), (b), (c), 0, 0, 0)

DI int seq_row0(int s) { return s < 16 ? s * 4096 : NPR + (s - 16) * 32; }
DI int seq_len(int s) { return s < 16 ? 4096 : 32; }

struct LoadBf16 {
  const bf16_t* A; int lda;
  DI void stage(int row, int k, u32x4& a, u32x4& b) const { a = *(const u32x4*)(A + (size_t)row * lda + k); b = a; }
  DI u32x4 finish(const u32x4& a, const u32x4& b, int k) const { return a; }
};
struct LoadShiftMix {
  const bf16_t* H; const float* mu; const float* xlast;
  DI void stage(int row, int k, u32x4& a, u32x4& b) const {
    a = *(const u32x4*)(H + (size_t)row * 1024 + k);
    const bool first = row < NPR ? ((row & 4095) == 0) : (((row - NPR) & 31) == 0);
    if (!first) b = *(const u32x4*)(H + (size_t)(row - 1) * 1024 + k);
    else if (row >= NPR) {
      const float* xl = xlast + (size_t)((row - NPR) >> 5) * 1024 + k;
      const float4 x0 = *(const float4*)xl, x1 = *(const float4*)(xl + 4);
      const float pv[8] = {x0.x, x0.y, x0.z, x0.w, x1.x, x1.y, x1.z, x1.w};
      b = pack8(pv);
    } else b = (u32x4){0u, 0u, 0u, 0u};
  }
  DI u32x4 finish(const u32x4& a, const u32x4& b, int k) const {
    float hv[8], pv[8], o[8];
    unpack8(a, hv); unpack8(b, pv);
    const float4 m0 = *(const float4*)(mu + k), m1 = *(const float4*)(mu + k + 4);
    const float mv[8] = {m0.x, m0.y, m0.z, m0.w, m1.x, m1.y, m1.z, m1.w};
#pragma unroll
    for (int i = 0; i < 8; ++i) o[i] = hv[i] + (pv[i] - hv[i]) * mv[i];
    return pack8(o);
  }
};

template <int BK, class AL>
DI void gemm_tile(const AL& al, const bf16_t* __restrict__ Bt, int ldb, int K, int m0, int n0, f32x16 (&acc)[2][2], bf16_t* As) {
  constexpr int LDK = BK + 8, CPR = BK / 8, NL = BK / 16, RSTEP = 256 / CPR;
  bf16_t* Bs = As + 128 * LDK;
  const int tid = threadIdx.x, lane = tid & 63, w = tid >> 6, wm = w >> 1, wn = w & 1;
#pragma unroll
  for (int mi = 0; mi < 2; ++mi)
#pragma unroll
    for (int ni = 0; ni < 2; ++ni)
#pragma unroll
      for (int r = 0; r < 16; ++r) acc[mi][ni][r] = 0.f;
  u32x4 ra[NL], ra2[NL], rb[NL];
  const int lr = tid / CPR, lk = (tid % CPR) * 8;
#pragma unroll
  for (int j = 0; j < NL; ++j) { al.stage(m0 + lr + RSTEP * j, lk, ra[j], ra2[j]); rb[j] = *(const u32x4*)(Bt + (size_t)(n0 + lr + RSTEP * j) * ldb + lk); }
  const int nk = K / BK;
  const int frow = lane & 31, fk = (lane >> 5) * 8;
  for (int kt = 0; kt < nk; ++kt) {
    __syncthreads();
#pragma unroll
    for (int j = 0; j < NL; ++j) { *(u32x4*)(As + (lr + RSTEP * j) * LDK + lk) = al.finish(ra[j], ra2[j], kt * BK + lk); *(u32x4*)(Bs + (lr + RSTEP * j) * LDK + lk) = rb[j]; }
    __syncthreads();
    if (kt + 1 < nk) {
      const int k0 = (kt + 1) * BK;
#pragma unroll
      for (int j = 0; j < NL; ++j) { al.stage(m0 + lr + RSTEP * j, k0 + lk, ra[j], ra2[j]); rb[j] = *(const u32x4*)(Bt + (size_t)(n0 + lr + RSTEP * j) * ldb + k0 + lk); }
    }
    __builtin_amdgcn_sched_barrier(0);
#pragma unroll
    for (int kk = 0; kk < BK / 16; ++kk) {
      bf16x8 af[2], bfr[2];
#pragma unroll
      for (int mi = 0; mi < 2; ++mi) af[mi] = *(const bf16x8*)(As + (wm * 64 + mi * 32 + frow) * LDK + kk * 16 + fk);
#pragma unroll
      for (int ni = 0; ni < 2; ++ni) bfr[ni] = *(const bf16x8*)(Bs + (wn * 64 + ni * 32 + frow) * LDK + kk * 16 + fk);
#pragma unroll
      for (int mi = 0; mi < 2; ++mi)
#pragma unroll
        for (int ni = 0; ni < 2; ++ni) acc[mi][ni] = MFMA(bfr[ni], af[mi], acc[mi][ni]);
    }
  }
}

template <class AL>
DI void gemm_tile_db(const AL& al, const bf16_t* __restrict__ Bt, int ldb, int K, int m0, int n0, f32x16 (&acc)[2][2], bf16_t* smem) {
  constexpr int LDK = 72, TB = 128 * LDK;
  const int tid = threadIdx.x, lane = tid & 63, w = tid >> 6, wm = w >> 1, wn = w & 1;
#pragma unroll
  for (int mi = 0; mi < 2; ++mi)
#pragma unroll
    for (int ni = 0; ni < 2; ++ni)
#pragma unroll
      for (int r = 0; r < 16; ++r) acc[mi][ni][r] = 0.f;
  u32x4 ra0[4], rc0[4], rb0[4], ra1[4], rc1[4], rb1[4];
  const int lr = tid >> 3, lk = (tid & 7) * 8;
  const int nk = K >> 6;
  const int frow = lane & 31, fk = (lane >> 5) * 8;
  const bf16_t* Bp = Bt + (size_t)(n0 + lr) * ldb + lk;
#define GDB_STAGE(RA, RC, RB, kt_)                                                                                     \
  {                                                                                                                    \
    _Pragma("unroll") for (int j = 0; j < 4; ++j) {                                                                    \
      al.stage(m0 + lr + 32 * j, (kt_) * 64 + lk, RA[j], RC[j]);                                                       \
      RB[j] = *(const u32x4*)(Bp + (size_t)(32 * j) * ldb + (kt_) * 64);                                               \
    }                                                                                                                  \
  }
#define GDB_WRITE(RA, RC, RB, kt_, buf_)                                                                               \
  {                                                                                                                    \
    bf16_t* Aw = smem + (buf_) * 2 * TB; bf16_t* Bw = Aw + TB;                                                         \
    _Pragma("unroll") for (int j = 0; j < 4; ++j) {                                                                    \
      *(u32x4*)(Aw + (lr + 32 * j) * LDK + lk) = al.finish(RA[j], RC[j], (kt_) * 64 + lk);                            \
      *(u32x4*)(Bw + (lr + 32 * j) * LDK + lk) = RB[j];                                                                \
    }                                                                                                                  \
  }
#define GDB_KK(buf_, kk_)                                                                                              \
  {                                                                                                                    \
    const bf16_t* Ar = smem + (buf_) * 2 * TB; const bf16_t* Br = Ar + TB;                                             \
    bf16x8 af[2], bfr[2];                                                                                              \
    _Pragma("unroll") for (int mi = 0; mi < 2; ++mi) af[mi] = *(const bf16x8*)(Ar + (wm * 64 + mi * 32 + frow) * LDK + (kk_) * 16 + fk);  \
    _Pragma("unroll") for (int ni = 0; ni < 2; ++ni) bfr[ni] = *(const bf16x8*)(Br + (wn * 64 + ni * 32 + frow) * LDK + (kk_) * 16 + fk); \
    _Pragma("unroll") for (int mi = 0; mi < 2; ++mi)                                                                   \
      _Pragma("unroll") for (int ni = 0; ni < 2; ++ni) acc[mi][ni] = MFMA(bfr[ni], af[mi], acc[mi][ni]);               \
  }
#define GDB_ITER(kt_, cur_, RAn, RCn, RBn)                                                                             \
  {                                                                                                                    \
    GDB_KK(cur_, 0)                                                                                                    \
    if ((kt_) + 1 < nk) GDB_WRITE(RAn, RCn, RBn, (kt_) + 1, (cur_) ^ 1)                                                \
    if ((kt_) + 3 < nk) GDB_STAGE(RAn, RCn, RBn, (kt_) + 3)                                                            \
    GDB_KK(cur_, 1) GDB_KK(cur_, 2) GDB_KK(cur_, 3)                                                                    \
    __syncthreads();                                                                                                   \
  }
  GDB_STAGE(ra0, rc0, rb0, 0)
  if (nk > 1) GDB_STAGE(ra1, rc1, rb1, 1)
  __syncthreads();
  GDB_WRITE(ra0, rc0, rb0, 0, 0)
  if (nk > 2) GDB_STAGE(ra0, rc0, rb0, 2)
  __syncthreads();
  for (int kt = 0; kt < nk; kt += 2) {
    GDB_ITER(kt, 0, ra1, rc1, rb1)
    if (kt + 1 < nk) GDB_ITER(kt + 1, 1, ra0, rc0, rb0)
  }
#undef GDB_STAGE
#undef GDB_WRITE
#undef GDB_KK
#undef GDB_ITER
}

template <class E>
DI void epilogue(const f32x16 (&acc)[2][2], int m0, int n0, E&& e, float* Cs) {
  const int tid = threadIdx.x, lane = tid & 63, w = tid >> 6, wm = w >> 1, wn = w & 1;
  __syncthreads();
#pragma unroll
  for (int mi = 0; mi < 2; ++mi)
#pragma unroll
    for (int ni = 0; ni < 2; ++ni)
#pragma unroll
      for (int g = 0; g < 4; ++g) {
        const int row = wm * 64 + mi * 32 + (lane & 31);
        const int col = wn * 64 + ni * 32 + 8 * g + 4 * (lane >> 5);
        *(float4*)(Cs + row * 132 + col) = make_float4(acc[mi][ni][4 * g], acc[mi][ni][4 * g + 1], acc[mi][ni][4 * g + 2], acc[mi][ni][4 * g + 3]);
      }
  __syncthreads();
#pragma unroll 4
  for (int it = 0; it < 16; ++it) {
    const int idx = tid + 256 * it, row = idx >> 5, col = (idx & 31) * 4;
    const float4 v = *(const float4*)(Cs + row * 132 + col);
    e(m0 + row, n0 + col, v.x, v.y, v.z, v.w);
  }
}

template <class F>
DI void for_tiles(int nM, int nN, F&& f) {
  const int x = blockIdx.x & 7, s = blockIdx.x >> 3, slots = gridDim.x >> 3;
  const int nFull = nN >> 3, wd = nN & 7, nRG8 = (nM + 7) >> 3, hr = wd ? 64 / wd : 1, cntP = wd ? (nM + hr - 1) / hr : 0;
  const int nSTf = nFull * nRG8, nST = nSTf + cntP;
  for (int e = s;; e += slots) {
    const int st = (e >> 6) * 8 + x;
    if (st >= nST) break;
    const int wi = e & 63;
    int tm, tn; bool ok;
    if (st < nSTf) { const int rg = st / nFull, cgi = st - rg * nFull; tm = rg * 8 + (wi & 7); tn = cgi * 8 + (wi >> 3); ok = tm < nM; }
    else { const int idx = st - nSTf, q = wi / hr; tm = idx * hr + (wi - q * hr); tn = nFull * 8 + q; ok = (q < wd) && (tm < nM); }
    if (ok) f(tm, tn);
  }
}

DI void st_bf4(bf16_t* p, float a, float b, float c, float d) { u32x2 q; q.x = pack2(a, b); q.y = pack2(c, d); *(u32x2*)p = q; }

DI void transpose_cvt(const float* __restrict__ W, int K, int N, bf16_t* __restrict__ Wt, int Npad, float* tile) {
  const int tK = K >> 5, tN = Npad >> 5;
  const int tx = threadIdx.x & 31, ty = threadIdx.x >> 5;
  for (int t = blockIdx.x; t < tK * tN; t += gridDim.x) {
    const int tk = t % tK, tn = t / tK;
    __syncthreads();
#pragma unroll
    for (int i = 0; i < 4; ++i) { const int k = tk * 32 + ty + 8 * i, n = tn * 32 + tx; tile[(ty + 8 * i) * 33 + tx] = (n < N) ? W[(size_t)k * N + n] : 0.f; }
    __syncthreads();
#pragma unroll
    for (int i = 0; i < 4; ++i) { const int n = tn * 32 + ty + 8 * i, k = tk * 32 + tx; Wt[(size_t)n * K + k] = f2bf(tile[tx * 33 + ty + 8 * i]); }
  }
}
DI void cvt_bf16(const float* __restrict__ src, bf16_t* __restrict__ dst, size_t n) {
  const size_t stride = (size_t)gridDim.x * 256 * 8;
  for (size_t i = ((size_t)blockIdx.x * 256 + threadIdx.x) * 8; i < n; i += stride) {
    float4 a = *(const float4*)(src + i), b = *(const float4*)(src + i + 4);
    float f[8] = {a.x, a.y, a.z, a.w, b.x, b.y, b.z, b.w};
    *(u32x4*)(dst + i) = pack8(f);
  }
}

DI void cvt_fp8_rows(const float* __restrict__ src, unsigned char* __restrict__ dst, float* __restrict__ scale) {
  const int lane = threadIdx.x & 63, gw = blockIdx.x * 4 + (threadIdx.x >> 6), nw = gridDim.x * 4;
  for (int row = gw; row < 16384; row += nw) {
    float4 v[4]; float m = 0.f;
#pragma unroll
    for (int j = 0; j < 4; ++j) { v[j] = *(const float4*)(src + (size_t)row * 1024 + lane * 4 + 256 * j); m = fmaxf(m, fmaxf(fmaxf(fabsf(v[j].x), fabsf(v[j].y)), fmaxf(fabsf(v[j].z), fabsf(v[j].w)))); }
    for (int o = 32; o > 0; o >>= 1) m = fmaxf(m, __shfl_xor(m, o));
    const float sc = m > 0.f ? m * (1.f / 224.f) : 1.f, inv = 1.f / sc;
#pragma unroll
    for (int j = 0; j < 4; ++j) {
      int q = 0;
      q = __builtin_amdgcn_cvt_pk_fp8_f32(v[j].x * inv, v[j].y * inv, q, false);
      q = __builtin_amdgcn_cvt_pk_fp8_f32(v[j].z * inv, v[j].w * inv, q, true);
      *(int*)(dst + ((size_t)(2 * j + (lane >> 5)) * 16384 + row) * 128 + ((lane * 4) & 127)) = q;
    }
    if (lane == 0) scale[row] = sc;
  }
}
DI void rmsnorm_rows(const Params& p, const float* __restrict__ X, bool from_input, const float* __restrict__ g, bf16_t* __restrict__ out) {
  const int lane = threadIdx.x & 63, gw = blockIdx.x * 4 + (threadIdx.x >> 6), nw = gridDim.x * 4;
  float4 gv[4];
#pragma unroll
  for (int j = 0; j < 4; ++j) gv[j] = *(const float4*)(g + lane * 4 + 256 * j);
  for (int row = gw; row < NT; row += nw) {
    const float* xr;
    if (from_input) xr = row < NPR ? p.in[I_XP] + (size_t)row * 1024 : p.in[I_XS] + (size_t)(row - NPR) * 1024;
    else xr = X + (size_t)row * 1024;
    float4 v[4]; float ss = 0.f;
#pragma unroll
    for (int j = 0; j < 4; ++j) { v[j] = *(const float4*)(xr + lane * 4 + 256 * j); ss += v[j].x * v[j].x + v[j].y * v[j].y + v[j].z * v[j].z + v[j].w * v[j].w; }
    ss = wave_sum(ss);
    const float rs = rsqrtf(ss * (1.f / 1024.f) + 1e-6f);
#pragma unroll
    for (int j = 0; j < 4; ++j) st_bf4(out + (size_t)row * 1024 + lane * 4 + 256 * j, v[j].x * rs * gv[j].x, v[j].y * rs * gv[j].y, v[j].z * rs * gv[j].z, v[j].w * rs * gv[j].w);
  }
}

DI void phase0(const Params& p, unsigned char* smem) {
  float* tile = (float*)smem;
  unsigned char* ws = p.ws;
  transpose_cvt(p.in[I_WIN], 1024, 3600, (bf16_t*)(ws + OFF_WT_IN), 3712, tile);
  transpose_cvt(p.in[I_WOUTAB], 1024, 1024, (bf16_t*)(ws + OFF_WT_OUTAB), 1024, tile);
  bf16_t* wrk = (bf16_t*)(ws + OFF_WT_RK);
  for (int i = 0; i < 3; ++i) transpose_cvt(p.in[I_WRKV] + (size_t)i * 1024 * 1024, 1024, 1024, wrk + (size_t)i * 1024 * 1024, 1024, tile);
  transpose_cvt(p.in[I_WW1], 1024, 64, wrk + (size_t)3072 * 1024, 128, tile);
  transpose_cvt(p.in[I_AW1], 1024, 64, wrk + (size_t)3200 * 1024, 128, tile);
  transpose_cvt(p.in[I_GW1], 1024, 128, wrk + (size_t)3328 * 1024, 128, tile);
  transpose_cvt(p.in[I_WW2], 64, 1024, (bf16_t*)(ws + OFF_WT_W2), 1024, tile);
  transpose_cvt(p.in[I_AW2], 64, 1024, (bf16_t*)(ws + OFF_WT_A2), 1024, tile);
  transpose_cvt(p.in[I_GWW2], 128, 1024, (bf16_t*)(ws + OFF_WT_G2), 1024, tile);
  transpose_cvt(p.in[I_WOUTC], 1024, 1024, (bf16_t*)(ws + OFF_WT_OUTC), 1024, tile);
  for (int l = 0; l < 2; ++l) transpose_cvt(p.in[I_PWQ] + (size_t)l * 1024 * 2048, 1024, 2048, (bf16_t*)(ws + OFF_WT_Q) + (size_t)l * 2048 * 1024, 2048, tile);
  cvt_bf16(p.in[I_PSK], (bf16_t*)(ws + OFF_SK), (size_t)2 * 16 * 128 * 128);
  cvt_fp8_rows(p.in[I_PU], ws + OFF_U8, (float*)(ws + OFF_USC));
  cvt_fp8_rows(p.in[I_PV], ws + OFF_V8, (float*)(ws + OFF_VSC));
  if (blockIdx.x == 0) {
    float* lbs = (float*)(ws + OFF_LBS);
    for (int c = threadIdx.x; c < 512; c += 256) {
      const float a0 = p.in[I_LB][c], a1 = p.in[I_LB][512 + c], a2 = p.in[I_LB][1024 + c];
      const float m = fmaxf(a0, fmaxf(a1, a2));
      const float e0 = expf(a0 - m), e1 = expf(a1 - m), e2 = expf(a2 - m);
      lbs[c] = e0 / (e0 + e1 + e2);
    }
  }
  rmsnorm_rows(p, nullptr, true, p.in[I_N1], (bf16_t*)(ws + OFF_HA));
}

DI void phase1(const Params& p, unsigned char* smem) {
  unsigned char* ws = p.ws;
  bf16_t* As = (bf16_t*)smem;
  const float* lbs = (const float*)(ws + OFF_LBS);
  bf16_t* QA = (bf16_t*)(ws + OFF_QA); float* F = (float*)(ws + OFF_F); bf16_t* VA = (bf16_t*)(ws + OFF_VA); bf16_t* GA = (bf16_t*)(ws + OFF_GA);
  bf16_t* QB = (bf16_t*)(ws + OFF_QB); bf16_t* KB = (bf16_t*)(ws + OFF_KB); bf16_t* VB = (bf16_t*)(ws + OFF_VB); bf16_t* GB = (bf16_t*)(ws + OFF_GB);
  float* LR = (float*)(ws + OFF_LR);
  for_tiles(NT / 128, 29, [&](int tm, int tn) {
    f32x16 acc[2][2];
    gemm_tile_db(LoadBf16{(const bf16_t*)(ws + OFF_HA), 1024}, (const bf16_t*)(ws + OFF_WT_IN), 1024, 1024, tm * 128, tn * 128, acc, As);
    epilogue(acc, tm * 128, tn * 128, [&](int row, int col, float a, float b, float c, float d) {
      if (col < 512) st_bf4(QA + (size_t)row * 512 + col, siluf_(a), siluf_(b), siluf_(c), siluf_(d));
      else if (col < 1024) {
        const int cc = col - 512; const float4 lb = *(const float4*)(lbs + cc);
        float4 o; o.x = lb.x + (1.f - lb.x) * sigmoidf_(a); o.y = lb.y + (1.f - lb.y) * sigmoidf_(b); o.z = lb.z + (1.f - lb.z) * sigmoidf_(c); o.w = lb.w + (1.f - lb.w) * sigmoidf_(d);
        *(float4*)(F + (size_t)row * 512 + cc) = o;
      } else if (col < 1536) st_bf4(VA + (size_t)row * 512 + col - 1024, a, b, c, d);
      else if (col < 2048) st_bf4(GA + (size_t)row * 512 + col - 1536, siluf_(a), siluf_(b), siluf_(c), siluf_(d));
      else if (col < 2304) st_bf4(QB + (size_t)row * 256 + col - 2048, a * 0.125f, b * 0.125f, c * 0.125f, d * 0.125f);
      else if (col < 2560) st_bf4(KB + (size_t)row * 256 + col - 2304, a, b, c, d);
      else if (col < 3072) st_bf4(VB + (size_t)row * 512 + col - 2560, a, b, c, d);
      else if (col < 3088) { float4 o = {a, b, c, d}; *(float4*)(LR + (size_t)row * 16 + col - 3072) = o; }
      else if (col < 3600) st_bf4(GB + (size_t)row * 512 + col - 3088, siluf_(a), siluf_(b), siluf_(c), siluf_(d));
    }, (float*)smem);
  });
}

DI int chunk_index(int seq, int c) { return seq < 16 ? seq * 64 + c : 1024 + (seq - 16); }
template <int K, bool GLA>
DI void pre_unit(const Params& p, int seq, int c, int head, unsigned char* smem) {
  constexpr int NPART = 256 / K, TPER = 64 / NPART;
  unsigned char* ws = p.ws;
  float* part = (float*)smem;
  const int tid = threadIdx.x, k = tid % K, tp = tid / K;
  const int row0 = seq_row0(seq), T = seq_len(seq);
  bf16_t* qsrc; const float* fsrc = nullptr; const bf16_t* ksrc = nullptr; bf16_t* kdst; int ldq;
  float w2c[16]; float gbias = 0.f;
  if (!GLA) {
    qsrc = (bf16_t*)(ws + OFF_QA) + head * 128 + k; fsrc = (const float*)(ws + OFF_F) + head * 128 + k; ldq = 512;
    kdst = (bf16_t*)(ws + OFF_KTA) + head * 128 + k;
#pragma unroll
    for (int r = 0; r < 16; ++r) w2c[r] = 0.f;
  } else {
    qsrc = (bf16_t*)(ws + OFF_QB) + head * 64 + k; ksrc = (const bf16_t*)(ws + OFF_KB) + head * 64 + k; ldq = 256;
    kdst = (bf16_t*)(ws + OFF_KTB) + head * 64 + k;
#pragma unroll
    for (int r = 0; r < 16; ++r) w2c[r] = p.in[I_GW2][r * 256 + head * 64 + k];
    gbias = p.in[I_GB][head * 64 + k];
  }
  const float* LR = (const float*)(ws + OFF_LR);
  struct LD { float4 l0, l1, l2, l3; float f; unsigned short kraw, qraw; };
  auto ld_issue = [&](size_t row, LD& d, bool withq) {
    if (!GLA) d.f = fsrc[row * 512];
    else { const float4* lp = (const float4*)(LR + row * 16); d.l0 = lp[0]; d.l1 = lp[1]; d.l2 = lp[2]; d.l3 = lp[3]; d.kraw = ksrc[row * ldq]; }
    if (withq) d.qraw = qsrc[row * ldq];
  };
  auto ld_eval = [&](const LD& d, float& kval) -> float {
    if (!GLA) { kval = 1.f - d.f; return __logf(d.f); }
    const float x = gbias + d.l0.x * w2c[0] + d.l0.y * w2c[1] + d.l0.z * w2c[2] + d.l0.w * w2c[3] + d.l1.x * w2c[4] + d.l1.y * w2c[5] + d.l1.z * w2c[6] + d.l1.w * w2c[7]
                    + d.l2.x * w2c[8] + d.l2.y * w2c[9] + d.l2.z * w2c[10] + d.l2.w * w2c[11] + d.l3.x * w2c[12] + d.l3.y * w2c[13] + d.l3.z * w2c[14] + d.l3.w * w2c[15];
    kval = bf2f(d.kraw);
    return (fminf(x, 0.f) - log1pf(__expf(-fabsf(x)))) * (1.f / 16.f);
  };
  constexpr int BT = GLA ? 4 : 16;
  float run = 0.f;
#pragma unroll
  for (int t0 = 0; t0 < TPER; t0 += BT) {
    LD ld[BT];
#pragma unroll
    for (int u = 0; u < BT; ++u) { const int ta = c * 64 + tp * TPER + t0 + u; ld_issue((size_t)(row0 + (ta < T ? ta : 0)), ld[u], false); }
    __builtin_amdgcn_sched_barrier(0);
#pragma unroll
    for (int u = 0; u < BT; ++u) { const int ta = c * 64 + tp * TPER + t0 + u; float kd; const float g = ld_eval(ld[u], kd); run += (ta < T) ? g : 0.f; }
  }
  __syncthreads();
  part[tp * K + k] = run;
  __syncthreads();
  float off = 0.f, tot = 0.f;
#pragma unroll
  for (int pp = 0; pp < NPART; ++pp) { const float v = part[pp * K + k]; tot += v; if (pp < tp) off += v; }
  if (tp == 0) ((float*)(ws + OFF_EBL))[(size_t)chunk_index(seq, c) * 768 + (GLA ? 512 : 0) + head * K + k] = __expf(tot);
  run = off;
#pragma unroll
  for (int t0 = 0; t0 < TPER; t0 += BT) {
    LD ld[BT];
#pragma unroll
    for (int u = 0; u < BT; ++u) { const int ta = c * 64 + tp * TPER + t0 + u; ld_issue((size_t)(row0 + (ta < T ? ta : 0)), ld[u], true); }
    __builtin_amdgcn_sched_barrier(0);
#pragma unroll
    for (int u = 0; u < BT; ++u) {
      const int ta = c * 64 + tp * TPER + t0 + u; const bool valid = ta < T;
      const size_t row = (size_t)(row0 + (valid ? ta : 0));
      float kd; const float g = ld_eval(ld[u], kd);
      run += valid ? g : 0.f;
      if (valid) {
        qsrc[row * ldq] = f2bf(bf2f(ld[u].qraw) * __expf(run));
        kdst[row * ldq] = f2bf(kd * __expf(-run));
      }
    }
  }
}
DI void phase_pre(const Params& p, unsigned char* smem) {
  for (int it = blockIdx.x; it < 1040 * 8; it += gridDim.x) {
    const int kind = it & 1, head = (it >> 1) & 3, ci = it >> 3;
    const int seq = ci < 1024 ? (ci >> 6) : 16 + (ci - 1024), c = ci < 1024 ? (ci & 63) : 0;
    if (kind == 0) pre_unit<128, false>(p, seq, c, head, smem);
    else pre_unit<64, true>(p, seq, c, head, smem);
  }
}

template <int K, bool GLA>
DI void chunk_unit(const Params& p, int seq, int head, int vs, unsigned char* smem) {
  constexpr int KP = K + 8, KT = K / 32, NQ = K / 32, CPR = K / 8;
  unsigned char* ws = p.ws;
  bf16_t* Qs = (bf16_t*)smem;
  bf16_t* Ks = Qs + 64 * KP;
  bf16_t* KsT = Ks + 64 * KP;
  bf16_t* VT = KsT + K * 72;
  bf16_t* Am = VT + 32 * 72;
  bf16_t* ST = Am + 64 * 72;
  float* bl = (float*)(ST + 32 * KP);
  const int tid = threadIdx.x, lane = tid & 63, w = tid >> 6, hh = lane >> 5, l31 = lane & 31;
  const int row0 = seq_row0(seq), T = seq_len(seq), nch = (T + 63) >> 6;
  const bf16_t* qsrc = GLA ? (const bf16_t*)(ws + OFF_QB) + head * 64 : (const bf16_t*)(ws + OFF_QA) + head * 128;
  const bf16_t* ksrc = GLA ? (const bf16_t*)(ws + OFF_KTB) + head * 64 : (const bf16_t*)(ws + OFF_KTA) + head * 128;
  const int ldq = GLA ? 256 : 512;
  const bf16_t* vsrc = (const bf16_t*)(ws + (GLA ? OFF_VB : OFF_VA)) + head * 128 + vs * 32;
  const float* ebl = (const float*)(ws + OFF_EBL) + (GLA ? 512 : 0) + head * K;
  bf16_t* odst = (bf16_t*)(ws + OFF_ORAW) + (GLA ? 512 : 0) + head * 128 + vs * 32;
  f32x16 S;
#pragma unroll
  for (int r = 0; r < 16; ++r) S[r] = 0.f;
  float* sout; const float* sin = nullptr;
  {
    const int b = seq & 15;
    const size_t hoff = GLA ? ((size_t)(b * 4 + head) * 64) * 128 : ((size_t)(b * 4 + head) * 128) * 128;
    sout = p.out + (seq < 16 ? (GLA ? O_PG : O_PH) : (GLA ? O_SG : O_SH)) + hoff + vs * 32;
    if (seq >= 16) sin = p.in[GLA ? I_SG : I_SH] + hoff + vs * 32;
  }
  u32x4 rq[NQ], rk[NQ], rv; float rbl = 1.f;
  auto gload = [&](int c) {
#pragma unroll
    for (int j = 0; j < NQ; ++j) {
      const int cj = tid + 256 * j, t = cj / CPR, k8 = (cj % CPR) * 8, ta = c * 64 + t;
      if (ta < T) { rq[j] = *(const u32x4*)(qsrc + (size_t)(row0 + ta) * ldq + k8); rk[j] = *(const u32x4*)(ksrc + (size_t)(row0 + ta) * ldq + k8); }
      else { rq[j] = (u32x4){0u, 0u, 0u, 0u}; rk[j] = (u32x4){0u, 0u, 0u, 0u}; }
    }
    const int s = tid >> 2, vq = tid & 3, ta = c * 64 + s;
    rv = (u32x4){0u, 0u, 0u, 0u};
    if (ta < T) rv = *(const u32x4*)(vsrc + (size_t)(row0 + ta) * 512 + vq * 8);
    if (tid < K) rbl = ebl[(size_t)chunk_index(seq, c) * 768 + tid];
  };
  gload(0);
  __syncthreads();
  if (w < KT) {
    if (sin) {
#pragma unroll
      for (int r = 0; r < 16; ++r) S[r] = sin[(size_t)(w * 32 + crow(r, hh)) * 128 + l31];
    }
#pragma unroll
    for (int g = 0; g < 4; ++g) st_bf4(ST + l31 * KP + w * 32 + 8 * g + 4 * hh, S[4 * g], S[4 * g + 1], S[4 * g + 2], S[4 * g + 3]);
  }
  for (int c = 0; c < nch; ++c) {
#pragma unroll
    for (int j = 0; j < NQ; ++j) {
      const int cj = tid + 256 * j, t = cj / CPR, k8 = (cj % CPR) * 8;
      *(u32x4*)(Qs + t * KP + k8) = rq[j];
      *(u32x4*)(Ks + t * KP + k8) = rk[j];
      const unsigned kk4[4] = {rk[j].x, rk[j].y, rk[j].z, rk[j].w};
      const int tsw = ((((t >> 3) ^ ((k8 >> 3) & 7)) << 3) | (t & 7));
#pragma unroll
      for (int e = 0; e < 4; ++e) { KsT[(k8 + 2 * e) * 72 + tsw] = (bf16_t)(kk4[e] & 0xffffu); KsT[(k8 + 2 * e + 1) * 72 + tsw] = (bf16_t)(kk4[e] >> 16); }
    }
    {
      const int s = tid >> 2, vq = tid & 3;
      const unsigned qq[4] = {rv.x, rv.y, rv.z, rv.w};
#pragma unroll
      for (int j = 0; j < 4; ++j) { VT[(vq * 8 + 2 * j) * 72 + s] = (bf16_t)(qq[j] & 0xffffu); VT[(vq * 8 + 2 * j + 1) * 72 + s] = (bf16_t)(qq[j] >> 16); }
    }
    if (tid < K) bl[tid] = rbl;
    __syncthreads();
    if (c + 1 < nch) gload(c + 1);
    {
      const int tm = w >> 1, tn = w & 1;
      f32x16 a;
#pragma unroll
      for (int r = 0; r < 16; ++r) a[r] = 0.f;
      if (tn <= tm) {
#pragma unroll
        for (int ks = 0; ks < K / 16; ++ks) {
          const bf16x8 qf = *(const bf16x8*)(Qs + (tm * 32 + l31) * KP + ks * 16 + hh * 8);
          const bf16x8 kf = *(const bf16x8*)(Ks + (tn * 32 + l31) * KP + ks * 16 + hh * 8);
          a = MFMA(kf, qf, a);
        }
      }
      const int t = tm * 32 + l31;
#pragma unroll
      for (int g = 0; g < 4; ++g) {
        const int s0 = tn * 32 + 8 * g + 4 * hh;
        float v0 = (s0 <= t) ? a[4 * g] : 0.f, v1 = (s0 + 1 <= t) ? a[4 * g + 1] : 0.f, v2 = (s0 + 2 <= t) ? a[4 * g + 2] : 0.f, v3 = (s0 + 3 <= t) ? a[4 * g + 3] : 0.f;
        if (tn > tm) { v0 = v1 = v2 = v3 = 0.f; }
        st_bf4(Am + t * 72 + s0, v0, v1, v2, v3);
      }
    }
    if (w < KT) {
#pragma unroll
      for (int ks = 0; ks < 4; ++ks) {
        const bf16x8 af = *(const bf16x8*)(KsT + (w * 32 + l31) * 72 + 8 * ((ks * 2 + hh) ^ (((w * 32 + l31) >> 3) & 7)));
        const bf16x8 bf = *(const bf16x8*)(VT + l31 * 72 + ks * 16 + hh * 8);
        S = MFMA(af, bf, S);
      }
    }
    __syncthreads();
    if (w < 2) {
      f32x16 o;
#pragma unroll
      for (int r = 0; r < 16; ++r) o[r] = 0.f;
#pragma unroll
      for (int ks = 0; ks < 4; ++ks) {
        const bf16x8 af = *(const bf16x8*)(Am + (w * 32 + l31) * 72 + ks * 16 + hh * 8);
        const bf16x8 bf = *(const bf16x8*)(VT + l31 * 72 + ks * 16 + hh * 8);
        o = MFMA(af, bf, o);
      }
#pragma unroll
      for (int ks = 0; ks < K / 16; ++ks) {
        const bf16x8 af = *(const bf16x8*)(Qs + (w * 32 + l31) * KP + ks * 16 + hh * 8);
        const bf16x8 bf = *(const bf16x8*)(ST + l31 * KP + ks * 16 + hh * 8);
        o = MFMA(af, bf, o);
      }
#pragma unroll
      for (int r = 0; r < 16; ++r) {
        const int ta = c * 64 + w * 32 + crow(r, hh);
        if (ta < T) odst[(size_t)(row0 + ta) * 1024 + l31] = f2bf(o[r]);
      }
    }
    __syncthreads();
    if (w < KT) {
#pragma unroll
      for (int r = 0; r < 16; ++r) S[r] *= bl[w * 32 + crow(r, hh)];
#pragma unroll
      for (int g = 0; g < 4; ++g) st_bf4(ST + l31 * KP + w * 32 + 8 * g + 4 * hh, S[4 * g], S[4 * g + 1], S[4 * g + 2], S[4 * g + 3]);
    }
    __syncthreads();
  }
  if (w < KT) {
#pragma unroll
    for (int r = 0; r < 16; ++r) sout[(size_t)(w * 32 + crow(r, hh)) * 128 + l31] = S[r];
  }
  __syncthreads();
}

DI void phase2(const Params& p, unsigned char* smem) {
  for (int u = blockIdx.x; u < 1024; u += gridDim.x) {
    const int kind = (u >> 8) & 1, idx = u & 255, seq = (idx >> 4) + (u >= 512 ? 16 : 0), head = (idx >> 2) & 3, vs = idx & 3;
    if (kind == 0) chunk_unit<128, false>(p, seq, head, vs, smem);
    else chunk_unit<64, true>(p, seq, head, vs, smem);
  }
}

DI void phase3(const Params& p, unsigned char*) {
  unsigned char* ws = p.ws;
  const int lane = threadIdx.x & 63, gw = blockIdx.x * 4 + (threadIdx.x >> 6), nw = gridDim.x * 4;
  const bf16_t* O = (const bf16_t*)(ws + OFF_ORAW);
  const bf16_t* G = (const bf16_t*)(ws + (lane < 32 ? OFF_GA : OFF_GB)) + (lane & 31) * 16;
  const float* ng = p.in[lane < 32 ? I_HNG : I_GNG] + (lane & 7) * 16;
  float gv[16];
#pragma unroll
  for (int i = 0; i < 16; ++i) gv[i] = ng[i];
  bf16_t* out = (bf16_t*)(ws + OFF_HA);
  for (int row = gw; row < NT; row += nw) {
    const u32x4 o0 = *(const u32x4*)(O + (size_t)row * 1024 + lane * 16), o1 = *(const u32x4*)(O + (size_t)row * 1024 + lane * 16 + 8);
    const u32x4 g0 = *(const u32x4*)(G + (size_t)row * 512), g1 = *(const u32x4*)(G + (size_t)row * 512 + 8);
    float ov[16], gt[16];
    unpack8(o0, ov); unpack8(o1, ov + 8); unpack8(g0, gt); unpack8(g1, gt + 8);
    float ss = 0.f;
#pragma unroll
    for (int i = 0; i < 16; ++i) ss += ov[i] * ov[i];
    ss += __shfl_xor(ss, 1); ss += __shfl_xor(ss, 2); ss += __shfl_xor(ss, 4);
    const float rs = rsqrtf(ss * (1.f / 128.f) + 1e-6f);
    float r[16];
#pragma unroll
    for (int i = 0; i < 16; ++i) r[i] = ov[i] * rs * gv[i] * gt[i];
    *(u32x4*)(out + (size_t)row * 1024 + lane * 16) = pack8(r);
    *(u32x4*)(out + (size_t)row * 1024 + lane * 16 + 8) = pack8(r + 8);
  }
}

DI void phase_outproj(const Params& p, unsigned char* smem, size_t offA, size_t offW, bool first) {
  unsigned char* ws = p.ws;
  bf16_t* As = (bf16_t*)smem;
  float* X = p.out;
  for_tiles(NT / 128, 8, [&](int tm, int tn) {
    f32x16 acc[2][2];
    gemm_tile_db(LoadBf16{(const bf16_t*)(ws + offA), 1024}, (const bf16_t*)(ws + offW), 1024, 1024, tm * 128, tn * 128, acc, As);
    epilogue(acc, tm * 128, tn * 128, [&](int row, int col, float a, float b, float c, float d) {
      const float* src = first ? (row < NPR ? p.in[I_XP] + (size_t)row * 1024 + col : p.in[I_XS] + (size_t)(row - NPR) * 1024 + col) : X + (size_t)row * 1024 + col;
      float4 x = *(const float4*)src;
      x.x += a; x.y += b; x.z += c; x.w += d;
      *(float4*)(X + (size_t)row * 1024 + col) = x;
    }, (float*)smem);
  });
}

DI void phase_norm2(const Params& p, int layer) { rmsnorm_rows(p, p.out, false, p.in[I_N2] + layer * 1024, (bf16_t*)(p.ws + OFF_HA)); }

DI void phase_qp(const Params& p, unsigned char* smem, int layer) {
  unsigned char* ws = p.ws;
  bf16_t* As = (bf16_t*)smem;
  bf16_t* QP = (bf16_t*)(ws + OFF_QP);
  for_tiles(NT / 128, 16, [&](int tm, int tn) {
    f32x16 acc[2][2];
    gemm_tile_db(LoadBf16{(const bf16_t*)(ws + OFF_HA), 1024}, (const bf16_t*)(ws + OFF_WT_Q) + (size_t)layer * 2048 * 1024, 1024, 1024, tm * 128, tn * 128, acc, As);
    epilogue(acc, tm * 128, tn * 128, [&](int row, int col, float a, float b, float c, float d) { st_bf4(QP + (size_t)row * 2048 + col, a, b, c, d); }, (float*)smem);
  });
}

DI unsigned f2key(float f, int idx) { unsigned u = __float_as_uint(f); u = (u & 0x80000000u) ? ~u : (u | 0x80000000u); return (u & ~127u) | (unsigned)(127 - idx); }
DI float key2f(unsigned k) { k &= ~127u; const unsigned u = (k & 0x80000000u) ? (k & 0x7fffffffu) : ~k; return __uint_as_float(u); }
DI void phase_route(const Params& p, unsigned char* smem, int layer) {
  unsigned char* ws = p.ws;
  bf16_t* As = (bf16_t*)smem;
  unsigned* sk = (unsigned*)smem;
  float* lv = (float*)smem;
  int* li = (int*)(smem + 16384);
  float* sv1 = (float*)(smem + 32768);
  unsigned char* si1 = smem + 32768 + 8192;
  float* sv0 = (float*)(smem + 65536);
  unsigned char* si0 = smem + 65536 + 8192;
  const bf16_t* QP = (const bf16_t*)(ws + OFF_QP);
  const bf16_t* SK = (const bf16_t*)(ws + OFF_SK);
  int* EIDX = (int*)(ws + OFF_EIDX); float* GATE = (float*)(ws + OFF_GATE);
  const int tid = threadIdx.x, lane = tid & 63, w = tid >> 6, wm = w >> 1, wn = w & 1;
  const int ntile = (NT / 128) * 8;
  for (int t = blockIdx.x; t < ntile; t += gridDim.x) {
    const int tm = t >> 3, h = t & 7;
    for (int p2 = 0; p2 < 2; ++p2) {
      f32x16 acc[2][2];
      gemm_tile<64>(LoadBf16{QP + (h * 2 + p2) * 128, 2048}, SK + (size_t)((layer * 8 + h) * 2 + p2) * 128 * 128, 128, 128, tm * 128, 0, acc, As);
      __syncthreads();
#pragma unroll
      for (int mi = 0; mi < 2; ++mi)
#pragma unroll
        for (int ni = 0; ni < 2; ++ni)
#pragma unroll
          for (int g4 = 0; g4 < 4; ++g4) {
            const int m = wm * 64 + mi * 32 + (lane & 31), n = wn * 64 + ni * 32 + 8 * g4 + 4 * (lane >> 5);
            *(u32x4*)(sk + m * 128 + 4 * ((n >> 2) ^ (m & 31))) = (u32x4){f2key(acc[mi][ni][4 * g4], n), f2key(acc[mi][ni][4 * g4 + 1], n + 1), f2key(acc[mi][ni][4 * g4 + 2], n + 2), f2key(acc[mi][ni][4 * g4 + 3], n + 3)};
          }
      __syncthreads();
      const int row = tid & 127, half = tid >> 7, sw = row & 31;
      unsigned keys[16];
#pragma unroll
      for (int r = 0; r < 16; ++r) {
        unsigned best = 0u;
#pragma unroll
        for (int q = 0; q < 16; ++q) {
          const u32x4 v = *(const u32x4*)(sk + row * 128 + 4 * ((half * 16 + q) ^ sw));
          best = max(max(best, v.x), v.y); best = max(max(best, v.z), v.w);
        }
        const int bidx = 127 - (int)(best & 127u);
        sk[row * 128 + 4 * ((bidx >> 2) ^ sw) + (bidx & 3)] = 0u;
        keys[r] = best;
      }
      __syncthreads();
#pragma unroll
      for (int r = 0; r < 16; ++r) { lv[r * 256 + tid] = key2f(keys[r]); li[r * 256 + tid] = 127 - (int)(keys[r] & 127u); }
      __syncthreads();
      if (tid < 128) {
        float* dv = p2 ? sv1 : sv0; unsigned char* di = p2 ? si1 : si0;
        int a = 0, b = 0;
#pragma unroll 1
        for (int r = 0; r < 16; ++r) {
          const float va = lv[a * 256 + row], vb = lv[b * 256 + 128 + row];
          const bool ta = va >= vb;
          dv[r * 128 + row] = ta ? va : vb;
          di[r * 128 + row] = (unsigned char)(ta ? li[a * 256 + row] : li[b * 256 + 128 + row]);
          a += ta ? 1 : 0; b += ta ? 0 : 1;
        }
      }
      __syncthreads();
    }
    if (tid < 128) {
      const int row = tid;
      unsigned long long jp = 0ull;
      float cs[16]; int ce[16];
#pragma unroll
      for (int r = 0; r < 16; ++r) {
        float best = -INFINITY; int bi_ = 0;
#pragma unroll
        for (int i = 0; i < 16; ++i) {
          const int j = (int)((jp >> (4 * i)) & 15ull);
          const float v = sv0[i * 128 + row] + sv1[j * 128 + row];
          if (v > best) { best = v; bi_ = i; }
        }
        const int j = (int)((jp >> (4 * bi_)) & 15ull);
        ce[r] = (int)si0[bi_ * 128 + row] * 128 + (int)si1[j * 128 + row];
        cs[r] = best;
        jp += 1ull << (4 * bi_);
      }
      float e[16], sum = 0.f;
#pragma unroll
      for (int r = 0; r < 16; ++r) { e[r] = __expf(cs[r] - cs[0]); sum += e[r]; }
      const float inv = 1.f / sum;
      const size_t base = ((size_t)(tm * 128 + row) * 8 + h) * 16;
#pragma unroll
      for (int r = 0; r < 16; ++r) { EIDX[base + r] = ce[r]; GATE[base + r] = e[r] * inv; }
    }
    __syncthreads();
  }
}

DI float dot2bf(unsigned a, unsigned b, float c) {
  typedef __bf16 bf2 __attribute__((ext_vector_type(2)));
  return __builtin_amdgcn_fdot2_f32_bf16(__builtin_bit_cast(bf2, a), __builtin_bit_cast(bf2, b), c, false);
}

#define CVT8(q, hi) __builtin_amdgcn_cvt_pk_f32_fp8((int)(q), hi)
DI float dpp_x1(float v) { return __uint_as_float(__builtin_amdgcn_update_dpp(0, __float_as_uint(v), 0xB1, 0xF, 0xF, true)); }
DI float dpp_x2(float v) { return __uint_as_float(__builtin_amdgcn_update_dpp(0, __float_as_uint(v), 0x4E, 0xF, 0xF, true)); }
DI float dpp_hm(float v) { return __uint_as_float(__builtin_amdgcn_update_dpp(0, __float_as_uint(v), 0x141, 0xF, 0xF, true)); }
DI f32x2 shx2(const f32x2& v, int m) { f32x2 r; r.x = __shfl_xor(v.x, m); r.y = __shfl_xor(v.y, m); return r; }

struct TokU { u32x4 xa, xb; int ev0, ev1; };
DI void phase_peer_u(const Params& p) {
  unsigned char* ws = p.ws;
  const int lane = threadIdx.x & 63, r = lane >> 3, s = lane & 7;
  const int x = blockIdx.x & 7, lw = (blockIdx.x >> 3) * 4 + (threadIdx.x >> 6), nlw = (gridDim.x >> 3) * 4;
  const unsigned char* U8s = ws + OFF_U8 + (size_t)x * 16384 * 128 + 16 * s;
  const int* EIDX = (const int*)(ws + OFF_EIDX);
  const bf16_t* HA = (const bf16_t*)(ws + OFF_HA);
  float* HP = (float*)(ws + OFF_HP) + (size_t)x * NT * 128;
  auto load_tok = [&](int t, TokU& k) {
    const bf16_t* hp = HA + (size_t)t * 1024 + 128 * x + 16 * s;
    k.xa = *(const u32x4*)hp; k.xb = *(const u32x4*)(hp + 8);
    k.ev0 = EIDX[(size_t)t * 128 + lane]; k.ev1 = EIDX[(size_t)t * 128 + 64 + lane];
  };
  auto gather = [&](const TokU& k, u32x4 (&g)[16]) {
#pragma unroll
    for (int i = 0; i < 16; ++i) { const int e = __shfl(i < 8 ? k.ev0 : k.ev1, (8 * i + r) & 63); g[i] = *(const u32x4*)(U8s + (size_t)e * 128); }
  };
  auto compute = [&](int t, const f32x2 (&xs)[8], const u32x4 (&g)[16]) {
    float keep0 = 0.f, keep1 = 0.f;
#pragma unroll
    for (int i = 0; i < 16; ++i) {
      const u32x4 u = g[i];
      f32x2 d = CVT8(u.x, false) * xs[0];
      d = CVT8(u.x, true) * xs[1] + d; d = CVT8(u.y, false) * xs[2] + d; d = CVT8(u.y, true) * xs[3] + d;
      d = CVT8(u.z, false) * xs[4] + d; d = CVT8(u.z, true) * xs[5] + d; d = CVT8(u.w, false) * xs[6] + d; d = CVT8(u.w, true) * xs[7] + d;
      float ds = d.x + d.y;
      ds += dpp_x1(ds); ds += dpp_x2(ds); ds += dpp_hm(ds);
      if (s == (i & 7)) { if (i < 8) keep0 = ds; else keep1 = ds; }
    }
    HP[(size_t)t * 128 + 8 * s + r] = keep0; HP[(size_t)t * 128 + 64 + 8 * s + r] = keep1;
  };
#define PU_STEP(kc, gc, kn, gn)                                                                                        \
  {                                                                                                                    \
    const int tn = t + nlw; const bool has_next = tn < NT;                                                             \
    if (has_next) gather(kn, gn);                                                                                      \
    const f32x2 xs[8] = {{lo2f(kc.xa.x), hi2f(kc.xa.x)}, {lo2f(kc.xa.y), hi2f(kc.xa.y)}, {lo2f(kc.xa.z), hi2f(kc.xa.z)}, {lo2f(kc.xa.w), hi2f(kc.xa.w)}, \
                         {lo2f(kc.xb.x), hi2f(kc.xb.x)}, {lo2f(kc.xb.y), hi2f(kc.xb.y)}, {lo2f(kc.xb.z), hi2f(kc.xb.z)}, {lo2f(kc.xb.w), hi2f(kc.xb.w)}}; \
    if (tn + nlw < NT) load_tok(tn + nlw, kc);                                                                         \
    __builtin_amdgcn_sched_barrier(0);                                                                                 \
    compute(t, xs, gc);                                                                                                \
    t = tn; if (!has_next) break;                                                                                      \
  }
  int t = lw;
  if (t < NT) {
    TokU ka, kb; u32x4 ga[16], gb[16];
    load_tok(t, ka); gather(ka, ga);
    if (t + nlw < NT) load_tok(t + nlw, kb);
    while (true) {
      PU_STEP(ka, ga, kb, gb)
      PU_STEP(kb, gb, ka, ga)
    }
  }
#undef PU_STEP
}

DI void phase_peer_act(const Params& p) {
  unsigned char* ws = p.ws;
  const float* HP = (const float*)(ws + OFF_HP);
  const float* USC = (const float*)(ws + OFF_USC); const float* VSC = (const float*)(ws + OFF_VSC);
  const int* EIDX = (const int*)(ws + OFF_EIDX); float* GATE = (float*)(ws + OFF_GATE);
  const size_t n = (size_t)NT * 128, stride = (size_t)gridDim.x * 256 * 4;
  for (size_t idx = ((size_t)blockIdx.x * 256 + threadIdx.x) * 4; idx < n; idx += stride) {
    float4 hp[8];
#pragma unroll
    for (int x = 0; x < 8; ++x) hp[x] = *(const float4*)(HP + (size_t)x * n + idx);
    const int4 e4 = *(const int4*)(EIDX + idx);
    const float4 g4 = *(const float4*)(GATE + idx);
    __builtin_amdgcn_sched_barrier(0);
    const float us[4] = {USC[e4.x], USC[e4.y], USC[e4.z], USC[e4.w]};
    const float vs[4] = {VSC[e4.x], VSC[e4.y], VSC[e4.z], VSC[e4.w]};
    float h[4] = {0.f, 0.f, 0.f, 0.f};
#pragma unroll
    for (int x = 0; x < 8; ++x) { h[0] += hp[x].x; h[1] += hp[x].y; h[2] += hp[x].z; h[3] += hp[x].w; }
    const float gg[4] = {g4.x, g4.y, g4.z, g4.w};
    float o[4];
#pragma unroll
    for (int j = 0; j < 4; ++j) { const float hh = h[j] * us[j]; o[j] = 0.5f * hh * (1.f + erff(hh * 0.70710678118f)) * gg[j] * vs[j]; }
    *(float4*)(GATE + idx) = make_float4(o[0], o[1], o[2], o[3]);
  }
}

struct TokV { int ev0, ev1; float ac0, ac1; float2 xv; };
DI void phase_peer_v(const Params& p) {
  unsigned char* ws = p.ws;
  const int lane = threadIdx.x & 63, r = lane >> 3, s = lane & 7;
  const int x = blockIdx.x & 7, lw = (blockIdx.x >> 3) * 4 + (threadIdx.x >> 6), nlw = (gridDim.x >> 3) * 4;
  const unsigned char* V8s = ws + OFF_V8 + (size_t)x * 16384 * 128 + 16 * s;
  const int* EIDX = (const int*)(ws + OFF_EIDX); const float* ACT = (const float*)(ws + OFF_GATE);
  float* X = p.out; float* SSP = (float*)(ws + OFF_SSP) + (size_t)x * NT;
  const int xoff = 128 * x + 16 * s + 2 * r;
  auto load_tok = [&](int t, TokV& k) {
    k.ev0 = EIDX[(size_t)t * 128 + lane]; k.ev1 = EIDX[(size_t)t * 128 + 64 + lane];
    k.ac0 = ACT[(size_t)t * 128 + lane]; k.ac1 = ACT[(size_t)t * 128 + 64 + lane];
    k.xv = *(const float2*)(X + (size_t)t * 1024 + xoff);
  };
  auto gather = [&](const TokV& k, u32x4 (&g)[16]) {
#pragma unroll
    for (int i = 0; i < 16; ++i) { const int e = __shfl(i < 8 ? k.ev0 : k.ev1, (8 * i + r) & 63); g[i] = *(const u32x4*)(V8s + (size_t)e * 128); }
  };
  auto compute = [&](int t, float ac0, float ac1, float2 xv, const u32x4 (&g)[16]) {
    f32x2 acc[8];
#pragma unroll
    for (int i = 0; i < 8; ++i) acc[i] = (f32x2){0.f, 0.f};
#pragma unroll
    for (int i = 0; i < 16; ++i) {
      const float a = __shfl(i < 8 ? ac0 : ac1, (8 * i + r) & 63);
      const u32x4 v = g[i];
      const f32x2 aa = {a, a};
      acc[0] = CVT8(v.x, false) * aa + acc[0]; acc[1] = CVT8(v.x, true) * aa + acc[1];
      acc[2] = CVT8(v.y, false) * aa + acc[2]; acc[3] = CVT8(v.y, true) * aa + acc[3];
      acc[4] = CVT8(v.z, false) * aa + acc[4]; acc[5] = CVT8(v.z, true) * aa + acc[5];
      acc[6] = CVT8(v.w, false) * aa + acc[6]; acc[7] = CVT8(v.w, true) * aa + acc[7];
    }
    f32x2 b4[4], b2[2];
#pragma unroll
    for (int m = 0; m < 4; ++m) { const f32x2 keep = (r & 4) ? acc[4 + m] : acc[m], send = (r & 4) ? acc[m] : acc[4 + m]; b4[m] = keep + shx2(send, 32); }
#pragma unroll
    for (int m = 0; m < 2; ++m) { const f32x2 keep = (r & 2) ? b4[2 + m] : b4[m], send = (r & 2) ? b4[m] : b4[2 + m]; b2[m] = keep + shx2(send, 16); }
    const f32x2 keep = (r & 1) ? b2[1] : b2[0], send = (r & 1) ? b2[0] : b2[1];
    const f32x2 o = keep + shx2(send, 8);
    xv.x += o.x; xv.y += o.y;
    *(float2*)(X + (size_t)t * 1024 + xoff) = xv;
    const float ss = wave_sum(xv.x * xv.x + xv.y * xv.y);
    if (lane == 0) SSP[t] = ss;
  };
#define PV_STEP(kc, gc, kn, gn)                                                                                        \
  {                                                                                                                    \
    const int tn = t + nlw; const bool has_next = tn < NT;                                                             \
    if (has_next) gather(kn, gn);                                                                                      \
    const float c0 = kc.ac0, c1 = kc.ac1; const float2 cx = kc.xv;                                                     \
    if (tn + nlw < NT) load_tok(tn + nlw, kc);                                                                         \
    __builtin_amdgcn_sched_barrier(0);                                                                                 \
    compute(t, c0, c1, cx, gc);                                                                                        \
    t = tn; if (!has_next) break;                                                                                      \
  }
  int t = lw;
  if (t < NT) {
    TokV ka, kb; u32x4 ga[16], gb[16];
    load_tok(t, ka); gather(ka, ga);
    if (t + nlw < NT) load_tok(t + nlw, kb);
    while (true) {
      PV_STEP(ka, ga, kb, gb)
      PV_STEP(kb, gb, ka, ga)
    }
  }
#undef PV_STEP
}

DI void phase_peer_norm(const Params& p, int layer) {
  unsigned char* ws = p.ws;
  const int lane = threadIdx.x & 63, gw = blockIdx.x * 4 + (threadIdx.x >> 6), nw = gridDim.x * 4;
  const float* SSP = (const float*)(ws + OFF_SSP);
  bf16_t* HA = (bf16_t*)(ws + OFF_HA);
  float* X = p.out;
  const float* gn = layer == 0 ? p.in[I_N1] + 1024 : p.in[I_FG];
  float4 gv[4];
#pragma unroll
  for (int j = 0; j < 4; ++j) gv[j] = *(const float4*)(gn + lane * 4 + 256 * j);
  for (int row = gw; row < NT; row += nw) {
    float sp[8];
#pragma unroll
    for (int x = 0; x < 8; ++x) sp[x] = SSP[(size_t)x * NT + row];
    float* xr = X + (size_t)row * 1024;
    float4 xin[4];
#pragma unroll
    for (int j = 0; j < 4; ++j) xin[j] = *(const float4*)(xr + lane * 4 + 256 * j);
    __builtin_amdgcn_sched_barrier(0);
    const float ss = ((sp[0] + sp[1]) + (sp[2] + sp[3])) + ((sp[4] + sp[5]) + (sp[6] + sp[7]));
    const float rs = rsqrtf(ss * (1.f / 1024.f) + 1e-6f);
    float* so = nullptr;
    if (layer == 0) {
      if (row < NPR) { if ((row & 4095) == 4095) so = p.out + O_PS + (size_t)(row >> 12) * 1024; }
      else { if (((row - NPR) & 31) == 31) so = p.out + O_SS + (size_t)((row - NPR) >> 5) * 1024; }
    }
#pragma unroll
    for (int j = 0; j < 4; ++j) {
      const float4 v = xin[j];
      const float4 y = make_float4(v.x * rs * gv[j].x, v.y * rs * gv[j].y, v.z * rs * gv[j].z, v.w * rs * gv[j].w);
      if (layer == 0) {
        st_bf4(HA + (size_t)row * 1024 + lane * 4 + 256 * j, y.x, y.y, y.z, y.w);
        if (so) *(float4*)(so + lane * 4 + 256 * j) = y;
      } else *(float4*)(xr + lane * 4 + 256 * j) = y;
    }
  }
}

DI void phase9(const Params& p, unsigned char* smem) {
  unsigned char* ws = p.ws;
  bf16_t* As = (bf16_t*)smem;
  bf16_t* R = (bf16_t*)(ws + OFF_R); bf16_t* Kb = (bf16_t*)(ws + OFF_K); bf16_t* V = (bf16_t*)(ws + OFF_V);
  bf16_t* W1 = (bf16_t*)(ws + OFF_W1); bf16_t* A1 = (bf16_t*)(ws + OFF_A1); bf16_t* G1 = (bf16_t*)(ws + OFF_G1);
  for_tiles(NT / 128, 27, [&](int tm, int tn) {
    const int mi_ = tn < 24 ? (tn >> 3) : tn - 21;
    f32x16 acc[2][2];
    gemm_tile<64>(LoadShiftMix{(const bf16_t*)(ws + OFF_HA), p.in[I_MU] + mi_ * 1024, p.in[I_SS]}, (const bf16_t*)(ws + OFF_WT_RK), 1024, 1024, tm * 128, tn * 128, acc, As);
    epilogue(acc, tm * 128, tn * 128, [&](int row, int col, float a, float b, float c, float d) {
      if (col < 1024) st_bf4(R + (size_t)row * 1024 + col, a, b, c, d);
      else if (col < 2048) st_bf4(Kb + (size_t)row * 1024 + col - 1024, a, b, c, d);
      else if (col < 3072) st_bf4(V + (size_t)row * 1024 + col - 2048, a, b, c, d);
      else if (col < 3136) st_bf4(W1 + (size_t)row * 64 + col - 3072, tanhf(a), tanhf(b), tanhf(c), tanhf(d));
      else if (col < 3200) {}
      else if (col < 3264) st_bf4(A1 + (size_t)row * 64 + col - 3200, a, b, c, d);
      else if (col < 3328) {}
      else st_bf4(G1 + (size_t)row * 128 + col - 3328, sigmoidf_(a), sigmoidf_(b), sigmoidf_(c), sigmoidf_(d));
    }, (float*)smem);
  });
}

DI float decay_of(float w) {
  const float nw = -w;
  const float sp = nw > 20.f ? nw : log1pf(__expf(nw));
  return __expf(-__expf(-sp - 0.5f));
}
DI unsigned short f2h(float x) { return __builtin_bit_cast(unsigned short, (_Float16)x); }

DI void phase10(const Params& p, unsigned char* smem) {
  unsigned char* ws = p.ws;
  bf16_t* As = (bf16_t*)smem;
  unsigned short* DEC = (unsigned short*)(ws + OFF_DEC); bf16_t* AA = (bf16_t*)(ws + OFF_AA); bf16_t* GG = (bf16_t*)(ws + OFF_GG);
  for_tiles(NT / 128, 24, [&](int tm, int tn) {
    const int grp = tn >> 3, n0 = (tn & 7) * 128;
    f32x16 acc[2][2];
    if (grp == 0) {
      gemm_tile<64>(LoadBf16{(const bf16_t*)(ws + OFF_W1), 64}, (const bf16_t*)(ws + OFF_WT_W2), 64, 64, tm * 128, n0, acc, As);
      epilogue(acc, tm * 128, n0, [&](int row, int col, float a, float b, float c, float d) {
        const float4 w0 = *(const float4*)(p.in[I_W0] + col);
        u32x2 q; q.x = (unsigned)f2h(decay_of(w0.x + a)) | ((unsigned)f2h(decay_of(w0.y + b)) << 16); q.y = (unsigned)f2h(decay_of(w0.z + c)) | ((unsigned)f2h(decay_of(w0.w + d)) << 16);
        *(u32x2*)(DEC + (size_t)row * 1024 + col) = q;
      }, (float*)smem);
    } else if (grp == 1) {
      gemm_tile<64>(LoadBf16{(const bf16_t*)(ws + OFF_A1), 64}, (const bf16_t*)(ws + OFF_WT_A2), 64, 64, tm * 128, n0, acc, As);
      epilogue(acc, tm * 128, n0, [&](int row, int col, float a, float b, float c, float d) {
        const float4 a0 = *(const float4*)(p.in[I_A0] + col);
        st_bf4(AA + (size_t)row * 1024 + col, sigmoidf_(a0.x + a), sigmoidf_(a0.y + b), sigmoidf_(a0.z + c), sigmoidf_(a0.w + d));
      }, (float*)smem);
    } else {
      gemm_tile<128>(LoadBf16{(const bf16_t*)(ws + OFF_G1), 128}, (const bf16_t*)(ws + OFF_WT_G2), 128, 128, tm * 128, n0, acc, As);
      epilogue(acc, tm * 128, n0, [&](int row, int col, float a, float b, float c, float d) { st_bf4(GG + (size_t)row * 1024 + col, a, b, c, d); }, (float*)smem);
    }
  });
}

DI float dpp_xor1(float v) { return __uint_as_float(__builtin_amdgcn_update_dpp(0, __float_as_uint(v), 0xB1, 0xF, 0xF, true)); }
DI float dpp_xor2(float v) { return __uint_as_float(__builtin_amdgcn_update_dpp(0, __float_as_uint(v), 0x4E, 0xF, 0xF, true)); }

DI void rwkv_unit(const Params& p, int seq, int head, int ih, unsigned char* smem) {
  unsigned char* ws = p.ws;
  float* buf = (float*)smem;
  float* obuf = buf + 32 * 384;
  const int tid = threadIdx.x, lane = tid & 63, w = tid >> 6, il = lane >> 3, jq = lane & 7, ii = w * 8 + il, i = ih * 32 + ii;
  const int row0 = seq_row0(seq), T = seq_len(seq), nch = T >> 5;
  const int b = seq & 15;
  f32x2 s2[4];
  const size_t soff = ((size_t)(b * 16 + head) * 64 + i) * 64 + jq * 8;
  if (seq >= 16) {
    const float* sp = p.in[I_SR] + soff;
#pragma unroll
    for (int j = 0; j < 4; ++j) s2[j] = (f32x2){sp[2 * j], sp[2 * j + 1]};
  } else {
#pragma unroll
    for (int j = 0; j < 4; ++j) s2[j] = (f32x2){0.f, 0.f};
  }
  const int pt = tid >> 3, jg = tid & 7, col = head * 64 + jg * 8;
  float ckk[8], cka[8], crk[8];
#pragma unroll
  for (int j = 0; j < 8; ++j) { ckk[j] = p.in[I_KK][col + j]; cka[j] = p.in[I_KA][col + j]; crk[j] = p.in[I_RK][col + j]; }
  const bf16_t* R = (const bf16_t*)(ws + OFF_R); const bf16_t* Kb = (const bf16_t*)(ws + OFF_K); const bf16_t* V = (const bf16_t*)(ws + OFF_V);
  const unsigned short* DEC = (const unsigned short*)(ws + OFF_DEC); const bf16_t* AA = (const bf16_t*)(ws + OFF_AA);
  float* BON = (float*)(ws + OFF_BON);
  bf16_t* O2 = (bf16_t*)(ws + OFF_ORAW2);
  u32x4 qr, qk, qv, qd, qa;
  {
    const size_t o = (size_t)(row0 + pt) * 1024 + col;
    qr = *(const u32x4*)(R + o); qk = *(const u32x4*)(Kb + o); qv = *(const u32x4*)(V + o); qd = *(const u32x4*)(DEC + o); qa = *(const u32x4*)(AA + o);
  }
  __syncthreads();
  for (int c = 0; c < nch; ++c) {
    {
      float r8[8], k8[8], v8[8], a8[8], d8[8];
      unpack8(qr, r8); unpack8(qk, k8); unpack8(qv, v8); unpack8(qa, a8);
      const half8 dh = __builtin_bit_cast(half8, qd);
#pragma unroll
      for (int j = 0; j < 8; ++j) d8[j] = (float)dh[j];
      float kkr[8], ss = 0.f, bon = 0.f, kp[8];
#pragma unroll
      for (int j = 0; j < 8; ++j) { kkr[j] = k8[j] * ckk[j]; ss += kkr[j] * kkr[j]; kp[j] = k8[j] * (1.f + (a8[j] - 1.f) * cka[j]); bon += r8[j] * kp[j] * crk[j]; }
      ss += dpp_x1(ss); ss += dpp_x2(ss); ss += dpp_hm(ss);
      bon += dpp_x1(bon); bon += dpp_x2(bon); bon += dpp_hm(bon);
      const float inv = rsqrtf(ss + 1e-12f);
      float* bb = buf + pt * 384 + jg * 8;
      float kkn[8], bbv[8];
#pragma unroll
      for (int j = 0; j < 8; ++j) { kkn[j] = kkr[j] * inv; bbv[j] = kkn[j] * a8[j]; }
      *(float4*)(bb) = make_float4(r8[0], r8[1], r8[2], r8[3]); *(float4*)(bb + 4) = make_float4(r8[4], r8[5], r8[6], r8[7]);
      *(float4*)(bb + 64) = make_float4(d8[0], d8[1], d8[2], d8[3]); *(float4*)(bb + 68) = make_float4(d8[4], d8[5], d8[6], d8[7]);
      *(float4*)(bb + 128) = make_float4(kp[0], kp[1], kp[2], kp[3]); *(float4*)(bb + 132) = make_float4(kp[4], kp[5], kp[6], kp[7]);
      *(float4*)(bb + 192) = make_float4(kkn[0], kkn[1], kkn[2], kkn[3]); *(float4*)(bb + 196) = make_float4(kkn[4], kkn[5], kkn[6], kkn[7]);
      *(float4*)(bb + 256) = make_float4(bbv[0], bbv[1], bbv[2], bbv[3]); *(float4*)(bb + 260) = make_float4(bbv[4], bbv[5], bbv[6], bbv[7]);
      *(float4*)(bb + 320) = make_float4(v8[0], v8[1], v8[2], v8[3]); *(float4*)(bb + 324) = make_float4(v8[4], v8[5], v8[6], v8[7]);
      if (jg == 0 && ih == 0) BON[(size_t)(row0 + c * 32 + pt) * 16 + head] = bon;
    }
    __syncthreads();
    if (c + 1 < nch) {
      const size_t o = (size_t)(row0 + (c + 1) * 32 + pt) * 1024 + col;
      qr = *(const u32x4*)(R + o); qk = *(const u32x4*)(Kb + o); qv = *(const u32x4*)(V + o); qd = *(const u32x4*)(DEC + o); qa = *(const u32x4*)(AA + o);
    }
    struct StepOps { float4 r0, r1, w0, w1, k0, k1, n0, n1, b0, b1; float vi; };
    auto ldops = [&](int t, StepOps& q) {
      const float* sb = buf + t * 384 + jq * 8;
      q.n0 = *(const float4*)(sb + 192); q.n1 = *(const float4*)(sb + 196);
      q.w0 = *(const float4*)(sb + 64); q.w1 = *(const float4*)(sb + 68);
      q.b0 = *(const float4*)(sb + 256); q.b1 = *(const float4*)(sb + 260);
      q.k0 = *(const float4*)(sb + 128); q.k1 = *(const float4*)(sb + 132);
      q.r0 = *(const float4*)(sb); q.r1 = *(const float4*)(sb + 4);
      q.vi = buf[t * 384 + 320 + i];
    };
    StepOps cu; ldops(0, cu);
#pragma unroll 4
    for (int t = 0; t < 32; ++t) {
      StepOps nx = cu;
      if (t + 1 < 32) ldops(t + 1, nx);
      __builtin_amdgcn_sched_barrier(0);
      const f32x2 rr2[4] = {{cu.r0.x, cu.r0.y}, {cu.r0.z, cu.r0.w}, {cu.r1.x, cu.r1.y}, {cu.r1.z, cu.r1.w}};
      const f32x2 ww2[4] = {{cu.w0.x, cu.w0.y}, {cu.w0.z, cu.w0.w}, {cu.w1.x, cu.w1.y}, {cu.w1.z, cu.w1.w}};
      const f32x2 kp2[4] = {{cu.k0.x, cu.k0.y}, {cu.k0.z, cu.k0.w}, {cu.k1.x, cu.k1.y}, {cu.k1.z, cu.k1.w}};
      const f32x2 kn2[4] = {{cu.n0.x, cu.n0.y}, {cu.n0.z, cu.n0.w}, {cu.n1.x, cu.n1.y}, {cu.n1.z, cu.n1.w}};
      const f32x2 bb2[4] = {{cu.b0.x, cu.b0.y}, {cu.b0.z, cu.b0.w}, {cu.b1.x, cu.b1.y}, {cu.b1.z, cu.b1.w}};
      const float vi = cu.vi;
      f32x2 sa2 = s2[0] * kn2[0];
      sa2 = s2[1] * kn2[1] + sa2; sa2 = s2[2] * kn2[2] + sa2; sa2 = s2[3] * kn2[3] + sa2;
      float sa = sa2.x + sa2.y;
      sa += dpp_x1(sa); sa += dpp_x2(sa); sa += dpp_hm(sa);
      const f32x2 nsa = {-sa, -sa}, vv = {vi, vi};
      f32x2 o2 = {0.f, 0.f};
#pragma unroll
      for (int j = 0; j < 4; ++j) {
        s2[j] = vv * kp2[j] + (nsa * bb2[j] + s2[j] * ww2[j]);
        o2 = s2[j] * rr2[j] + o2;
      }
      float o = o2.x + o2.y;
      o += dpp_x1(o); o += dpp_x2(o); o += dpp_hm(o);
      if (jq == 0) obuf[t * 32 + ii] = o;
      cu = nx;
    }
    __syncthreads();
    {
      const int ot = tid >> 3, oc = (tid & 7) * 4;
      const float4 ov = *(const float4*)(obuf + ot * 32 + oc);
      st_bf4(O2 + (size_t)(row0 + c * 32 + ot) * 1024 + head * 64 + ih * 32 + oc, ov.x, ov.y, ov.z, ov.w);
    }
  }
  {
    float* so = p.out + (seq < 16 ? O_PR : O_SR) + soff;
#pragma unroll
    for (int j = 0; j < 4; ++j) { so[2 * j] = s2[j].x; so[2 * j + 1] = s2[j].y; }
  }
  __syncthreads();
}
DI void phase11(const Params& p, unsigned char* smem) {
  for (int u = blockIdx.x; u < 1024; u += gridDim.x) {
    const int uu = u & 511;
    rwkv_unit(p, (uu & 15) + (u >= 512 ? 16 : 0), (uu >> 4) & 15, uu >> 8, smem);
  }
}

DI void phase12(const Params& p) {
  unsigned char* ws = p.ws;
  const int lane = threadIdx.x & 63, gw = blockIdx.x * 4 + (threadIdx.x >> 6), nw = gridDim.x * 4;
  const bf16_t* O2 = (const bf16_t*)(ws + OFF_ORAW2); const bf16_t* V = (const bf16_t*)(ws + OFF_V); const bf16_t* GG = (const bf16_t*)(ws + OFF_GG);
  const float* BON = (const float*)(ws + OFF_BON);
  bf16_t* A5 = (bf16_t*)(ws + OFF_A5);
  float lg[16], lb[16];
#pragma unroll
  for (int i = 0; i < 16; ++i) { lg[i] = p.in[I_LNG][lane * 16 + i]; lb[i] = p.in[I_LNB][lane * 16 + i]; }
  for (int row = gw; row < NT; row += nw) {
    const size_t o = (size_t)row * 1024 + lane * 16;
    float ov[16], vv[16], gg[16];
    unpack8(*(const u32x4*)(O2 + o), ov); unpack8(*(const u32x4*)(O2 + o + 8), ov + 8);
    unpack8(*(const u32x4*)(V + o), vv); unpack8(*(const u32x4*)(V + o + 8), vv + 8);
    unpack8(*(const u32x4*)(GG + o), gg); unpack8(*(const u32x4*)(GG + o + 8), gg + 8);
    const float bon = BON[(size_t)row * 16 + (lane >> 2)];
    float sm = 0.f;
#pragma unroll
    for (int i = 0; i < 16; ++i) sm += ov[i];
    sm += __shfl_xor(sm, 1); sm += __shfl_xor(sm, 2);
    const float mean = sm * (1.f / 64.f);
    float sq = 0.f;
#pragma unroll
    for (int i = 0; i < 16; ++i) { const float d = ov[i] - mean; sq += d * d; }
    sq += __shfl_xor(sq, 1); sq += __shfl_xor(sq, 2);
    const float rs = rsqrtf(sq * (1.f / 64.f) + 64e-5f);
    float r[16];
#pragma unroll
    for (int i = 0; i < 16; ++i) r[i] = ((ov[i] - mean) * rs * lg[i] + lb[i] + bon * vv[i]) * gg[i];
    *(u32x4*)(A5 + o) = pack8(r); *(u32x4*)(A5 + o + 8) = pack8(r + 8);
  }
}

DI void phase13(const Params& p, unsigned char* smem) {
  cvt_fp8_rows(p.in[I_PU] + (size_t)16384 * 1024, p.ws + OFF_U8, (float*)(p.ws + OFF_USC));
  cvt_fp8_rows(p.in[I_PV] + (size_t)16384 * 1024, p.ws + OFF_V8, (float*)(p.ws + OFF_VSC));
  phase_outproj(p, smem, OFF_A5, OFF_WT_OUTC, false);
}

template <int PH>
DI void run_phase(const Params& p, unsigned char* smem) {
  if (PH == 0) phase0(p, smem);
  else if (PH == 1) phase1(p, smem);
  else if (PH == 2) phase2(p, smem);
  else if (PH == 3) phase3(p, smem);
  else if (PH == 4) phase_outproj(p, smem, OFF_HA, OFF_WT_OUTAB, true);
  else if (PH == 5) phase_norm2(p, 0);
  else if (PH == 6) phase_qp(p, smem, 0);
  else if (PH == 7) phase_route(p, smem, 0);
  else if (PH == 8) phase_peer_u(p);
  else if (PH == 9) phase_peer_act(p);
  else if (PH == 10) phase_peer_v(p);
  else if (PH == 11) phase_peer_norm(p, 0);
  else if (PH == 12) phase9(p, smem);
  else if (PH == 13) phase10(p, smem);
  else if (PH == 14) phase11(p, smem);
  else if (PH == 15) phase12(p);
  else if (PH == 16) phase13(p, smem);
  else if (PH == 17) phase_norm2(p, 1);
  else if (PH == 18) phase_qp(p, smem, 1);
  else if (PH == 19) phase_route(p, smem, 1);
  else if (PH == 20) phase_peer_u(p);
  else if (PH == 21) phase_peer_act(p);
  else if (PH == 22) phase_peer_v(p);
  else if (PH == 23) phase_peer_norm(p, 1);
  else if (PH == 24) phase_pre(p, smem);
}

template <int PH>
__global__ void __launch_bounds__(256, 2) k_phase(Params p) {
  extern __shared__ __attribute__((aligned(16))) unsigned char smem[];
  run_phase<PH>(p, smem);
}

#ifndef PROBE_MASK
#define PROBE_MASK 0u
#endif
DI void grid_barrier(unsigned* cnt, unsigned target) {
  asm volatile("s_waitcnt vmcnt(0) lgkmcnt(0)" ::: "memory");
  __syncthreads();
  if (threadIdx.x == 0) {
    __builtin_amdgcn_fence(__ATOMIC_RELEASE, "agent");
    asm volatile("s_waitcnt vmcnt(0)" ::: "memory");
    __hip_atomic_fetch_add(cnt, 1u, __ATOMIC_RELAXED, __HIP_MEMORY_SCOPE_AGENT);
    while (__hip_atomic_load(cnt, __ATOMIC_RELAXED, __HIP_MEMORY_SCOPE_AGENT) < target) __builtin_amdgcn_s_sleep(1);
    __builtin_amdgcn_fence(__ATOMIC_ACQUIRE, "agent");
    asm volatile("s_waitcnt vmcnt(0)" ::: "memory");
  }
  __syncthreads();
}
template <int PH>
DI void mega_step(const Params& p, unsigned char* smem, cg::grid_group& grid, unsigned& nb, bool last) {
  run_phase<PH>(p, smem);
  if ((PROBE_MASK >> PH) & 1u) { grid.sync(); run_phase<PH>(p, smem); }
  if (!last) {
    if (PH == 0) grid.sync();
    else { ++nb; grid_barrier((unsigned*)(p.ws + OFF_GBAR), nb * gridDim.x); }
  }
}
__global__ void __launch_bounds__(256, 2) k_mega(Params p) {
  extern __shared__ __attribute__((aligned(16))) unsigned char smem[];
  cg::grid_group grid = cg::this_grid();
  unsigned nb = 0;
  mega_step<0>(p, smem, grid, nb, false); mega_step<1>(p, smem, grid, nb, false); mega_step<24>(p, smem, grid, nb, false); mega_step<2>(p, smem, grid, nb, false); mega_step<3>(p, smem, grid, nb, false);
  mega_step<4>(p, smem, grid, nb, false); mega_step<5>(p, smem, grid, nb, false); mega_step<6>(p, smem, grid, nb, false); mega_step<7>(p, smem, grid, nb, false);
  mega_step<8>(p, smem, grid, nb, false); mega_step<9>(p, smem, grid, nb, false); mega_step<10>(p, smem, grid, nb, false); mega_step<11>(p, smem, grid, nb, false);
  mega_step<12>(p, smem, grid, nb, false); mega_step<13>(p, smem, grid, nb, false); mega_step<14>(p, smem, grid, nb, false); mega_step<15>(p, smem, grid, nb, false);
  mega_step<16>(p, smem, grid, nb, false); mega_step<17>(p, smem, grid, nb, false); mega_step<18>(p, smem, grid, nb, false); mega_step<19>(p, smem, grid, nb, false);
  mega_step<20>(p, smem, grid, nb, false); mega_step<21>(p, smem, grid, nb, false); mega_step<22>(p, smem, grid, nb, false); mega_step<23>(p, smem, grid, nb, true);
}

template <int PH>
static void launch_phase(const Params& p, int grid, hipStream_t stream) {
  static bool attr = false;
  if (!attr) { hipFuncSetAttribute((const void*)k_phase<PH>, hipFuncAttributeMaxDynamicSharedMemorySize, LDS_BYTES); attr = true; }
  hipLaunchKernelGGL(k_phase<PH>, dim3(grid), dim3(256), LDS_BYTES, stream, p);
}

extern "C" void kernel_launch(void* const* d_in, const int* in_sizes, int n_in, void* d_out, int out_size, void* d_ws, size_t ws_size, hipStream_t stream) {
  Params p{};
  for (int i = 0; i < 36; ++i) p.in[i] = (const float*)d_in[i];
  p.out = (float*)d_out; p.ws = (unsigned char*)d_ws;
  if (ws_size < WS_END) { fprintf(stderr, "workspace too small: %zu < %zu\n", ws_size, (size_t)WS_END); return; }
#if MEGA
  static int grid_blocks = 0;
  if (!grid_blocks) {
    hipFuncSetAttribute((const void*)k_mega, hipFuncAttributeMaxDynamicSharedMemorySize, LDS_BYTES);
    int dev = 0, cus = 0, per_cu = 0;
    hipGetDevice(&dev);
    hipDeviceGetAttribute(&cus, hipDeviceAttributeMultiprocessorCount, dev);
    hipOccupancyMaxActiveBlocksPerMultiprocessor(&per_cu, k_mega, 256, LDS_BYTES);
    if (per_cu > 2) per_cu = 2;
    if (per_cu < 1) per_cu = 1;
    grid_blocks = cus * per_cu;
  }
  hipMemsetAsync((unsigned char*)d_ws + OFF_GBAR, 0, 256, stream);
  void* args[] = {&p};
  hipError_t e = hipLaunchCooperativeKernel((void*)k_mega, dim3(grid_blocks), dim3(256), args, LDS_BYTES, stream);
  if (e != hipSuccess) fprintf(stderr, "cooperative launch failed: %s (grid %d)\n", hipGetErrorString(e), grid_blocks);
#else
  const int grid = 512;
  launch_phase<0>(p, grid, stream); launch_phase<1>(p, grid, stream); launch_phase<24>(p, grid, stream); launch_phase<2>(p, grid, stream); launch_phase<3>(p, grid, stream);
  launch_phase<4>(p, grid, stream); launch_phase<5>(p, grid, stream); launch_phase<6>(p, grid, stream); launch_phase<7>(p, grid, stream);
  launch_phase<8>(p, grid, stream); launch_phase<9>(p, grid, stream); launch_phase<10>(p, grid, stream); launch_phase<11>(p, grid, stream);
  launch_phase<12>(p, grid, stream); launch_phase<13>(p, grid, stream); launch_phase<14>(p, grid, stream); launch_phase<15>(p, grid, stream);
  launch_phase<16>(p, grid, stream); launch_phase<17>(p, grid, stream); launch_phase<18>(p, grid, stream); launch_phase<19>(p, grid, stream);
  launch_phase<20>(p, grid, stream); launch_phase<21>(p, grid, stream); launch_phase<22>(p, grid, stream); launch_phase<23>(p, grid, stream);
#endif
}
```

```cpp
#include <hip/hip_runtime.h>
#include <hip/hip_cooperative_groups.h>
#include <cstdio>
namespace cg = cooperative_groups;

#ifndef MEGA
#define MEGA 1
#endif

#define DI __device__ __forceinline__
typedef unsigned short bf16_t;
typedef short bf16x8 __attribute__((ext_vector_type(8)));
typedef float f32x16 __attribute__((ext_vector_type(16)));
typedef _Float16 half8 __attribute__((ext_vector_type(8)));
typedef unsigned u32x4 __attribute__((ext_vector_type(4)));
typedef unsigned u32x2 __attribute__((ext_vector_type(2)));
typedef float f32x2 __attribute__((ext_vector_type(2)));

constexpr int NT = 66048;
constexpr int NPR = 65536;
constexpr size_t U = (size_t)NT * 1024 * 2;
constexpr int LDS_BYTES = 77824;

constexpr size_t S0 = 0, S1 = U, S2 = 2 * U, S3 = 3 * U, S4 = 4 * U, S5 = 5 * U, S6 = 6 * U;
constexpr size_t OFF_HA = S0;
constexpr size_t OFF_QA = S1, OFF_F = S1 + U / 2, OFF_VA = S1 + U / 2 + U, OFF_GA = S1 + 2 * U, OFF_QB = S1 + 2 * U + U / 2,
                 OFF_KB = OFF_QB + U / 4, OFF_VB = S1 + 3 * U, OFF_GB = OFF_VB + U / 2, OFF_LR = S1 + 4 * U;
constexpr size_t OFF_ORAW = S6;
constexpr size_t OFF_EBL = S5 + (size_t)8 * 1024 * 1024, OFF_KTA = S5 + U / 4, OFF_KTB = OFF_KTA + U / 2;
constexpr size_t OFF_QP = S1;
constexpr size_t OFF_EIDX = S3, OFF_GATE = S3 + U / 4;
constexpr size_t OFF_HP = S1, OFF_SSP = S4;
constexpr size_t OFF_R = S1, OFF_K = S2, OFF_V = S3, OFF_DEC = S4, OFF_AA = S5, OFF_GG = S6, OFF_ORAW2 = S0, OFF_A5 = S4;
constexpr size_t OFF_TAB = 7 * U;
constexpr size_t TAB_BYTES = (size_t)16384 * 1024 * 2;
constexpr size_t OFF_U8 = OFF_TAB, OFF_V8 = OFF_TAB + (size_t)16384 * 1024, OFF_USC = OFF_V8 + (size_t)16384 * 1024, OFF_VSC = OFF_USC + 65536;
constexpr size_t OFF_W1 = OFF_TAB, OFF_A1 = OFF_W1 + (size_t)NT * 64 * 2, OFF_G1 = OFF_A1 + (size_t)NT * 64 * 2,
                 OFF_BON = OFF_G1 + (size_t)NT * 128 * 2;
constexpr size_t OFF_W = OFF_TAB + 2 * TAB_BYTES;
constexpr size_t OFF_WT_IN = OFF_W;
constexpr size_t OFF_WT_OUTAB = OFF_WT_IN + (size_t)3712 * 1024 * 2;
constexpr size_t OFF_WT_RK = OFF_WT_OUTAB + (size_t)1024 * 1024 * 2;
constexpr size_t OFF_WT_W2 = OFF_WT_RK + (size_t)3456 * 1024 * 2;
constexpr size_t OFF_WT_A2 = OFF_WT_W2 + (size_t)1024 * 64 * 2;
constexpr size_t OFF_WT_G2 = OFF_WT_A2 + (size_t)1024 * 64 * 2;
constexpr size_t OFF_WT_OUTC = OFF_WT_G2 + (size_t)1024 * 128 * 2;
constexpr size_t OFF_WT_Q = OFF_WT_OUTC + (size_t)1024 * 1024 * 2;
constexpr size_t OFF_SK = OFF_WT_Q + (size_t)2 * 2048 * 1024 * 2;
constexpr size_t OFF_LBS = OFF_SK + (size_t)2 * 16 * 128 * 128 * 2;
constexpr size_t OFF_GBAR = OFF_LBS + 2048;
constexpr size_t WS_END = OFF_GBAR + 256;

constexpr size_t O_PH = 67633152, O_PG = 68681728, O_PR = 69206016, O_PS = 70254592,
                 O_SH = 70270976, O_SG = 71319552, O_SR = 71843840, O_SS = 72892416;

struct Params { const float* in[36]; float* out; unsigned char* ws; };

enum { I_XP = 0, I_XS, I_SH, I_SG, I_SR, I_SS, I_WIN, I_LB, I_HNG, I_GW2, I_GB, I_GNG, I_WOUTAB, I_MU, I_WRKV, I_WW1, I_WW2, I_W0,
       I_AW1, I_AW2, I_A0, I_GW1, I_GWW2, I_KK, I_KA, I_RK, I_LNG, I_LNB, I_WOUTC, I_N1, I_N2, I_FG, I_PWQ, I_PSK, I_PU, I_PV };

DI float bf2f(bf16_t u) { return __uint_as_float(((unsigned)u) << 16); }
DI unsigned pack2(float lo, float hi) { unsigned r; asm("v_cvt_pk_bf16_f32 %0, %1, %2" : "=v"(r) : "v"(lo), "v"(hi)); return r; }
DI bf16_t f2bf(float x) { return (bf16_t)(pack2(x, 0.f) & 0xffffu); }
DI float lo2f(unsigned p) { return __uint_as_float(p << 16); }
DI float hi2f(unsigned p) { return __uint_as_float(p & 0xffff0000u); }
DI void unpack8(const u32x4& q, float* f) { f[0] = lo2f(q.x); f[1] = hi2f(q.x); f[2] = lo2f(q.y); f[3] = hi2f(q.y); f[4] = lo2f(q.z); f[5] = hi2f(q.z); f[6] = lo2f(q.w); f[7] = hi2f(q.w); }
DI u32x4 pack8(const float* f) { u32x4 q; q.x = pack2(f[0], f[1]); q.y = pack2(f[2], f[3]); q.z = pack2(f[4], f[5]); q.w = pack2(f[6], f[7]); return q; }
DI float sigmoidf_(float x) { return 1.f / (1.f + __expf(-x)); }
DI float siluf_(float x) { return x / (1.f + __expf(-x)); }
DI float wave_sum(float v) {
  v += __uint_as_float(__builtin_amdgcn_update_dpp(0, __float_as_uint(v), 0xB1, 0xF, 0xF, true));
  v += __uint_as_float(__builtin_amdgcn_update_dpp(0, __float_as_uint(v), 0x4E, 0xF, 0xF, true));
  v += __uint_as_float(__builtin_amdgcn_update_dpp(0, __float_as_uint(v), 0x141, 0xF, 0xF, true));
  v += __uint_as_float(__builtin_amdgcn_update_dpp(0, __float_as_uint(v), 0x140, 0xF, 0xF, true));
  v += __uint_as_float(__builtin_amdgcn_update_dpp(0, __float_as_uint(v), 0x142, 0xA, 0xF, false));
  v += __uint_as_float(__builtin_amdgcn_update_dpp(0, __float_as_uint(v), 0x143, 0xC, 0xF, false));
  return __uint_as_float(__builtin_amdgcn_readlane(__float_as_uint(v), 63));
}
DI int crow(int reg, int h) { return (reg & 3) + 8 * (reg >> 2) + 4 * h; }
#define MFMA(a, b, c) __builtin_amdgcn_mfma_f32_32x32x16_bf16((a), (b), (c), 0, 0, 0)

DI int seq_row0(int s) { return s < 16 ? s * 4096 : NPR + (s - 16) * 32; }
DI int seq_len(int s) { return s < 16 ? 4096 : 32; }

struct LoadBf16 {
  const bf16_t* A; int lda;
  DI void stage(int row, int k, u32x4& a, u32x4& b) const { a = *(const u32x4*)(A + (size_t)row * lda + k); b = a; }
  DI u32x4 finish(const u32x4& a, const u32x4& b, int k) const { return a; }
};
struct LoadShiftMix {
  const bf16_t* H; const float* mu; const float* xlast;
  DI void stage(int row, int k, u32x4& a, u32x4& b) const {
    a = *(const u32x4*)(H + (size_t)row * 1024 + k);
    const bool first = row < NPR ? ((row & 4095) == 0) : (((row - NPR) & 31) == 0);
    if (!first) b = *(const u32x4*)(H + (size_t)(row - 1) * 1024 + k);
    else if (row >= NPR) {
      const float* xl = xlast + (size_t)((row - NPR) >> 5) * 1024 + k;
      const float4 x0 = *(const float4*)xl, x1 = *(const float4*)(xl + 4);
      const float pv[8] = {x0.x, x0.y, x0.z, x0.w, x1.x, x1.y, x1.z, x1.w};
      b = pack8(pv);
    } else b = (u32x4){0u, 0u, 0u, 0u};
  }
  DI u32x4 finish(const u32x4& a, const u32x4& b, int k) const {
    float hv[8], pv[8], o[8];
    unpack8(a, hv); unpack8(b, pv);
    const float4 m0 = *(const float4*)(mu + k), m1 = *(const float4*)(mu + k + 4);
    const float mv[8] = {m0.x, m0.y, m0.z, m0.w, m1.x, m1.y, m1.z, m1.w};
#pragma unroll
    for (int i = 0; i < 8; ++i) o[i] = hv[i] + (pv[i] - hv[i]) * mv[i];
    return pack8(o);
  }
};

template <int BK, class AL>
DI void gemm_tile(const AL& al, const bf16_t* __restrict__ Bt, int ldb, int K, int m0, int n0, f32x16 (&acc)[2][2], bf16_t* As) {
  constexpr int LDK = BK + 8, CPR = BK / 8, NL = BK / 16, RSTEP = 256 / CPR;
  bf16_t* Bs = As + 128 * LDK;
  const int tid = threadIdx.x, lane = tid & 63, w = tid >> 6, wm = w >> 1, wn = w & 1;
#pragma unroll
  for (int mi = 0; mi < 2; ++mi)
#pragma unroll
    for (int ni = 0; ni < 2; ++ni)
#pragma unroll
      for (int r = 0; r < 16; ++r) acc[mi][ni][r] = 0.f;
  u32x4 ra[NL], ra2[NL], rb[NL];
  const int lr = tid / CPR, lk = (tid % CPR) * 8;
#pragma unroll
  for (int j = 0; j < NL; ++j) { al.stage(m0 + lr + RSTEP * j, lk, ra[j], ra2[j]); rb[j] = *(const u32x4*)(Bt + (size_t)(n0 + lr + RSTEP * j) * ldb + lk); }
  const int nk = K / BK;
  const int frow = lane & 31, fk = (lane >> 5) * 8;
  for (int kt = 0; kt < nk; ++kt) {
    __syncthreads();
#pragma unroll
    for (int j = 0; j < NL; ++j) { *(u32x4*)(As + (lr + RSTEP * j) * LDK + lk) = al.finish(ra[j], ra2[j], kt * BK + lk); *(u32x4*)(Bs + (lr + RSTEP * j) * LDK + lk) = rb[j]; }
    __syncthreads();
    if (kt + 1 < nk) {
      const int k0 = (kt + 1) * BK;
#pragma unroll
      for (int j = 0; j < NL; ++j) { al.stage(m0 + lr + RSTEP * j, k0 + lk, ra[j], ra2[j]); rb[j] = *(const u32x4*)(Bt + (size_t)(n0 + lr + RSTEP * j) * ldb + k0 + lk); }
    }
    __builtin_amdgcn_sched_barrier(0);
#pragma unroll
    for (int kk = 0; kk < BK / 16; ++kk) {
      bf16x8 af[2], bfr[2];
#pragma unroll
      for (int mi = 0; mi < 2; ++mi) af[mi] = *(const bf16x8*)(As + (wm * 64 + mi * 32 + frow) * LDK + kk * 16 + fk);
#pragma unroll
      for (int ni = 0; ni < 2; ++ni) bfr[ni] = *(const bf16x8*)(Bs + (wn * 64 + ni * 32 + frow) * LDK + kk * 16 + fk);
#pragma unroll
      for (int mi = 0; mi < 2; ++mi)
#pragma unroll
        for (int ni = 0; ni < 2; ++ni) acc[mi][ni] = MFMA(bfr[ni], af[mi], acc[mi][ni]);
    }
  }
}

template <class AL>
DI void gemm_tile_db(const AL& al, const bf16_t* __restrict__ Bt, int ldb, int K, int m0, int n0, f32x16 (&acc)[2][2], bf16_t* smem) {
  constexpr int LDK = 72, TB = 128 * LDK;
  const int tid = threadIdx.x, lane = tid & 63, w = tid >> 6, wm = w >> 1, wn = w & 1;
#pragma unroll
  for (int mi = 0; mi < 2; ++mi)
#pragma unroll
    for (int ni = 0; ni < 2; ++ni)
#pragma unroll
      for (int r = 0; r < 16; ++r) acc[mi][ni][r] = 0.f;
  u32x4 ra0[4], rc0[4], rb0[4], ra1[4], rc1[4], rb1[4];
  const int lr = tid >> 3, lk = (tid & 7) * 8;
  const int nk = K >> 6;
  const int frow = lane & 31, fk = (lane >> 5) * 8;
  const bf16_t* Bp = Bt + (size_t)(n0 + lr) * ldb + lk;
#define GDB_STAGE(RA, RC, RB, kt_)                                                                                     \
  {                                                                                                                    \
    _Pragma("unroll") for (int j = 0; j < 4; ++j) {                                                                    \
      al.stage(m0 + lr + 32 * j, (kt_) * 64 + lk, RA[j], RC[j]);                                                       \
      RB[j] = *(const u32x4*)(Bp + (size_t)(32 * j) * ldb + (kt_) * 64);                                               \
    }                                                                                                                  \
  }
#define GDB_WRITE(RA, RC, RB, kt_, buf_)                                                                               \
  {                                                                                                                    \
    bf16_t* Aw = smem + (buf_) * 2 * TB; bf16_t* Bw = Aw + TB;                                                         \
    _Pragma("unroll") for (int j = 0; j < 4; ++j) {                                                                    \
      *(u32x4*)(Aw + (lr + 32 * j) * LDK + lk) = al.finish(RA[j], RC[j], (kt_) * 64 + lk);                            \
      *(u32x4*)(Bw + (lr + 32 * j) * LDK + lk) = RB[j];                                                                \
    }                                                                                                                  \
  }
#define GDB_KK(buf_, kk_)                                                                                              \
  {                                                                                                                    \
    const bf16_t* Ar = smem + (buf_) * 2 * TB; const bf16_t* Br = Ar + TB;                                             \
    bf16x8 af[2], bfr[2];                                                                                              \
    _Pragma("unroll") for (int mi = 0; mi < 2; ++mi) af[mi] = *(const bf16x8*)(Ar + (wm * 64 + mi * 32 + frow) * LDK + (kk_) * 16 + fk);  \
    _Pragma("unroll") for (int ni = 0; ni < 2; ++ni) bfr[ni] = *(const bf16x8*)(Br + (wn * 64 + ni * 32 + frow) * LDK + (kk_) * 16 + fk); \
    _Pragma("unroll") for (int mi = 0; mi < 2; ++mi)                                                                   \
      _Pragma("unroll") for (int ni = 0; ni < 2; ++ni) acc[mi][ni] = MFMA(bfr[ni], af[mi], acc[mi][ni]);               \
  }
#define GDB_ITER(kt_, cur_, RAn, RCn, RBn)                                                                             \
  {                                                                                                                    \
    GDB_KK(cur_, 0)                                                                                                    \
    if ((kt_) + 1 < nk) GDB_WRITE(RAn, RCn, RBn, (kt_) + 1, (cur_) ^ 1)                                                \
    if ((kt_) + 3 < nk) GDB_STAGE(RAn, RCn, RBn, (kt_) + 3)                                                            \
    GDB_KK(cur_, 1) GDB_KK(cur_, 2) GDB_KK(cur_, 3)                                                                    \
    __syncthreads();                                                                                                   \
  }
  GDB_STAGE(ra0, rc0, rb0, 0)
  if (nk > 1) GDB_STAGE(ra1, rc1, rb1, 1)
  __syncthreads();
  GDB_WRITE(ra0, rc0, rb0, 0, 0)
  if (nk > 2) GDB_STAGE(ra0, rc0, rb0, 2)
  __syncthreads();
  for (int kt = 0; kt < nk; kt += 2) {
    GDB_ITER(kt, 0, ra1, rc1, rb1)
    if (kt + 1 < nk) GDB_ITER(kt + 1, 1, ra0, rc0, rb0)
  }
#undef GDB_STAGE
#undef GDB_WRITE
#undef GDB_KK
#undef GDB_ITER
}

template <class E>
DI void epilogue(const f32x16 (&acc)[2][2], int m0, int n0, E&& e, float* Cs) {
  const int tid = threadIdx.x, lane = tid & 63, w = tid >> 6, wm = w >> 1, wn = w & 1;
  __syncthreads();
#pragma unroll
  for (int mi = 0; mi < 2; ++mi)
#pragma unroll
    for (int ni = 0; ni < 2; ++ni)
#pragma unroll
      for (int g = 0; g < 4; ++g) {
        const int row = wm * 64 + mi * 32 + (lane & 31);
        const int col = wn * 64 + ni * 32 + 8 * g + 4 * (lane >> 5);
        *(float4*)(Cs + row * 132 + col) = make_float4(acc[mi][ni][4 * g], acc[mi][ni][4 * g + 1], acc[mi][ni][4 * g + 2], acc[mi][ni][4 * g + 3]);
      }
  __syncthreads();
#pragma unroll 4
  for (int it = 0; it < 16; ++it) {
    const int idx = tid + 256 * it, row = idx >> 5, col = (idx & 31) * 4;
    const float4 v = *(const float4*)(Cs + row * 132 + col);
    e(m0 + row, n0 + col, v.x, v.y, v.z, v.w);
  }
}

template <class F>
DI void for_tiles(int nM, int nN, F&& f) {
  const int x = blockIdx.x & 7, s = blockIdx.x >> 3, slots = gridDim.x >> 3;
  const int nFull = nN >> 3, wd = nN & 7, nRG8 = (nM + 7) >> 3, hr = wd ? 64 / wd : 1, cntP = wd ? (nM + hr - 1) / hr : 0;
  const int nSTf = nFull * nRG8, nST = nSTf + cntP;
  for (int e = s;; e += slots) {
    const int st = (e >> 6) * 8 + x;
    if (st >= nST) break;
    const int wi = e & 63;
    int tm, tn; bool ok;
    if (st < nSTf) { const int rg = st / nFull, cgi = st - rg * nFull; tm = rg * 8 + (wi & 7); tn = cgi * 8 + (wi >> 3); ok = tm < nM; }
    else { const int idx = st - nSTf, q = wi / hr; tm = idx * hr + (wi - q * hr); tn = nFull * 8 + q; ok = (q < wd) && (tm < nM); }
    if (ok) f(tm, tn);
  }
}

DI void st_bf4(bf16_t* p, float a, float b, float c, float d) { u32x2 q; q.x = pack2(a, b); q.y = pack2(c, d); *(u32x2*)p = q; }

DI void transpose_cvt(const float* __restrict__ W, int K, int N, bf16_t* __restrict__ Wt, int Npad, float* tile) {
  const int tK = K >> 5, tN = Npad >> 5;
  const int tx = threadIdx.x & 31, ty = threadIdx.x >> 5;
  for (int t = blockIdx.x; t < tK * tN; t += gridDim.x) {
    const int tk = t % tK, tn = t / tK;
    __syncthreads();
#pragma unroll
    for (int i = 0; i < 4; ++i) { const int k = tk * 32 + ty + 8 * i, n = tn * 32 + tx; tile[(ty + 8 * i) * 33 + tx] = (n < N) ? W[(size_t)k * N + n] : 0.f; }
    __syncthreads();
#pragma unroll
    for (int i = 0; i < 4; ++i) { const int n = tn * 32 + ty + 8 * i, k = tk * 32 + tx; Wt[(size_t)n * K + k] = f2bf(tile[tx * 33 + ty + 8 * i]); }
  }
}
DI void cvt_bf16(const float* __restrict__ src, bf16_t* __restrict__ dst, size_t n) {
  const size_t stride = (size_t)gridDim.x * 256 * 8;
  for (size_t i = ((size_t)blockIdx.x * 256 + threadIdx.x) * 8; i < n; i += stride) {
    float4 a = *(const float4*)(src + i), b = *(const float4*)(src + i + 4);
    float f[8] = {a.x, a.y, a.z, a.w, b.x, b.y, b.z, b.w};
    *(u32x4*)(dst + i) = pack8(f);
  }
}

DI void cvt_fp8_rows(const float* __restrict__ src, unsigned char* __restrict__ dst, float* __restrict__ scale) {
  const int lane = threadIdx.x & 63, gw = blockIdx.x * 4 + (threadIdx.x >> 6), nw = gridDim.x * 4;
  for (int row = gw; row < 16384; row += nw) {
    float4 v[4]; float m = 0.f;
#pragma unroll
    for (int j = 0; j < 4; ++j) { v[j] = *(const float4*)(src + (size_t)row * 1024 + lane * 4 + 256 * j); m = fmaxf(m, fmaxf(fmaxf(fabsf(v[j].x), fabsf(v[j].y)), fmaxf(fabsf(v[j].z), fabsf(v[j].w)))); }
    for (int o = 32; o > 0; o >>= 1) m = fmaxf(m, __shfl_xor(m, o));
    const float sc = m > 0.f ? m * (1.f / 224.f) : 1.f, inv = 1.f / sc;
#pragma unroll
    for (int j = 0; j < 4; ++j) {
      int q = 0;
      q = __builtin_amdgcn_cvt_pk_fp8_f32(v[j].x * inv, v[j].y * inv, q, false);
      q = __builtin_amdgcn_cvt_pk_fp8_f32(v[j].z * inv, v[j].w * inv, q, true);
      *(int*)(dst + ((size_t)(2 * j + (lane >> 5)) * 16384 + row) * 128 + ((lane * 4) & 127)) = q;
    }
    if (lane == 0) scale[row] = sc;
  }
}
DI void rmsnorm_rows(const Params& p, const float* __restrict__ X, bool from_input, const float* __restrict__ g, bf16_t* __restrict__ out) {
  const int lane = threadIdx.x & 63, gw = blockIdx.x * 4 + (threadIdx.x >> 6), nw = gridDim.x * 4;
  float4 gv[4];
#pragma unroll
  for (int j = 0; j < 4; ++j) gv[j] = *(const float4*)(g + lane * 4 + 256 * j);
  for (int row = gw; row < NT; row += nw) {
    const float* xr;
    if (from_input) xr = row < NPR ? p.in[I_XP] + (size_t)row * 1024 : p.in[I_XS] + (size_t)(row - NPR) * 1024;
    else xr = X + (size_t)row * 1024;
    float4 v[4]; float ss = 0.f;
#pragma unroll
    for (int j = 0; j < 4; ++j) { v[j] = *(const float4*)(xr + lane * 4 + 256 * j); ss += v[j].x * v[j].x + v[j].y * v[j].y + v[j].z * v[j].z + v[j].w * v[j].w; }
    ss = wave_sum(ss);
    const float rs = rsqrtf(ss * (1.f / 1024.f) + 1e-6f);
#pragma unroll
    for (int j = 0; j < 4; ++j) st_bf4(out + (size_t)row * 1024 + lane * 4 + 256 * j, v[j].x * rs * gv[j].x, v[j].y * rs * gv[j].y, v[j].z * rs * gv[j].z, v[j].w * rs * gv[j].w);
  }
}

DI void phase0(const Params& p, unsigned char* smem) {
  float* tile = (float*)smem;
  unsigned char* ws = p.ws;
  transpose_cvt(p.in[I_WIN], 1024, 3600, (bf16_t*)(ws + OFF_WT_IN), 3712, tile);
  transpose_cvt(p.in[I_WOUTAB], 1024, 1024, (bf16_t*)(ws + OFF_WT_OUTAB), 1024, tile);
  bf16_t* wrk = (bf16_t*)(ws + OFF_WT_RK);
  for (int i = 0; i < 3; ++i) transpose_cvt(p.in[I_WRKV] + (size_t)i * 1024 * 1024, 1024, 1024, wrk + (size_t)i * 1024 * 1024, 1024, tile);
  transpose_cvt(p.in[I_WW1], 1024, 64, wrk + (size_t)3072 * 1024, 128, tile);
  transpose_cvt(p.in[I_AW1], 1024, 64, wrk + (size_t)3200 * 1024, 128, tile);
  transpose_cvt(p.in[I_GW1], 1024, 128, wrk + (size_t)3328 * 1024, 128, tile);
  transpose_cvt(p.in[I_WW2], 64, 1024, (bf16_t*)(ws + OFF_WT_W2), 1024, tile);
  transpose_cvt(p.in[I_AW2], 64, 1024, (bf16_t*)(ws + OFF_WT_A2), 1024, tile);
  transpose_cvt(p.in[I_GWW2], 128, 1024, (bf16_t*)(ws + OFF_WT_G2), 1024, tile);
  transpose_cvt(p.in[I_WOUTC], 1024, 1024, (bf16_t*)(ws + OFF_WT_OUTC), 1024, tile);
  for (int l = 0; l < 2; ++l) transpose_cvt(p.in[I_PWQ] + (size_t)l * 1024 * 2048, 1024, 2048, (bf16_t*)(ws + OFF_WT_Q) + (size_t)l * 2048 * 1024, 2048, tile);
  cvt_bf16(p.in[I_PSK], (bf16_t*)(ws + OFF_SK), (size_t)2 * 16 * 128 * 128);
  cvt_fp8_rows(p.in[I_PU], ws + OFF_U8, (float*)(ws + OFF_USC));
  cvt_fp8_rows(p.in[I_PV], ws + OFF_V8, (float*)(ws + OFF_VSC));
  if (blockIdx.x == 0) {
    float* lbs = (float*)(ws + OFF_LBS);
    for (int c = threadIdx.x; c < 512; c += 256) {
      const float a0 = p.in[I_LB][c], a1 = p.in[I_LB][512 + c], a2 = p.in[I_LB][1024 + c];
      const float m = fmaxf(a0, fmaxf(a1, a2));
      const float e0 = expf(a0 - m), e1 = expf(a1 - m), e2 = expf(a2 - m);
      lbs[c] = e0 / (e0 + e1 + e2);
    }
  }
  rmsnorm_rows(p, nullptr, true, p.in[I_N1], (bf16_t*)(ws + OFF_HA));
}

DI void phase1(const Params& p, unsigned char* smem) {
  unsigned char* ws = p.ws;
  bf16_t* As = (bf16_t*)smem;
  const float* lbs = (const float*)(ws + OFF_LBS);
  bf16_t* QA = (bf16_t*)(ws + OFF_QA); float* F = (float*)(ws + OFF_F); bf16_t* VA = (bf16_t*)(ws + OFF_VA); bf16_t* GA = (bf16_t*)(ws + OFF_GA);
  bf16_t* QB = (bf16_t*)(ws + OFF_QB); bf16_t* KB = (bf16_t*)(ws + OFF_KB); bf16_t* VB = (bf16_t*)(ws + OFF_VB); bf16_t* GB = (bf16_t*)(ws + OFF_GB);
  float* LR = (float*)(ws + OFF_LR);
  for_tiles(NT / 128, 29, [&](int tm, int tn) {
    f32x16 acc[2][2];
    gemm_tile_db(LoadBf16{(const bf16_t*)(ws + OFF_HA), 1024}, (const bf16_t*)(ws + OFF_WT_IN), 1024, 1024, tm * 128, tn * 128, acc, As);
    epilogue(acc, tm * 128, tn * 128, [&](int row, int col, float a, float b, float c, float d) {
      if (col < 512) st_bf4(QA + (size_t)row * 512 + col, siluf_(a), siluf_(b), siluf_(c), siluf_(d));
      else if (col < 1024) {
        const int cc = col - 512; const float4 lb = *(const float4*)(lbs + cc);
        float4 o; o.x = lb.x + (1.f - lb.x) * sigmoidf_(a); o.y = lb.y + (1.f - lb.y) * sigmoidf_(b); o.z = lb.z + (1.f - lb.z) * sigmoidf_(c); o.w = lb.w + (1.f - lb.w) * sigmoidf_(d);
        *(float4*)(F + (size_t)row * 512 + cc) = o;
      } else if (col < 1536) st_bf4(VA + (size_t)row * 512 + col - 1024, a, b, c, d);
      else if (col < 2048) st_bf4(GA + (size_t)row * 512 + col - 1536, siluf_(a), siluf_(b), siluf_(c), siluf_(d));
      else if (col < 2304) st_bf4(QB + (size_t)row * 256 + col - 2048, a * 0.125f, b * 0.125f, c * 0.125f, d * 0.125f);
      else if (col < 2560) st_bf4(KB + (size_t)row * 256 + col - 2304, a, b, c, d);
      else if (col < 3072) st_bf4(VB + (size_t)row * 512 + col - 2560, a, b, c, d);
      else if (col < 3088) { float4 o = {a, b, c, d}; *(float4*)(LR + (size_t)row * 16 + col - 3072) = o; }
      else if (col < 3600) st_bf4(GB + (size_t)row * 512 + col - 3088, siluf_(a), siluf_(b), siluf_(c), siluf_(d));
    }, (float*)smem);
  });
}

DI int chunk_index(int seq, int c) { return seq < 16 ? seq * 64 + c : 1024 + (seq - 16); }
template <int K, bool GLA>
DI void pre_unit(const Params& p, int seq, int c, int head, unsigned char* smem) {
  constexpr int NPART = 256 / K, TPER = 64 / NPART;
  unsigned char* ws = p.ws;
  float* part = (float*)smem;
  const int tid = threadIdx.x, k = tid % K, tp = tid / K;
  const int row0 = seq_row0(seq), T = seq_len(seq);
  bf16_t* qsrc; const float* fsrc = nullptr; const bf16_t* ksrc = nullptr; bf16_t* kdst; int ldq;
  float w2c[16]; float gbias = 0.f;
  if (!GLA) {
    qsrc = (bf16_t*)(ws + OFF_QA) + head * 128 + k; fsrc = (const float*)(ws + OFF_F) + head * 128 + k; ldq = 512;
    kdst = (bf16_t*)(ws + OFF_KTA) + head * 128 + k;
#pragma unroll
    for (int r = 0; r < 16; ++r) w2c[r] = 0.f;
  } else {
    qsrc = (bf16_t*)(ws + OFF_QB) + head * 64 + k; ksrc = (const bf16_t*)(ws + OFF_KB) + head * 64 + k; ldq = 256;
    kdst = (bf16_t*)(ws + OFF_KTB) + head * 64 + k;
#pragma unroll
    for (int r = 0; r < 16; ++r) w2c[r] = p.in[I_GW2][r * 256 + head * 64 + k];
    gbias = p.in[I_GB][head * 64 + k];
  }
  const float* LR = (const float*)(ws + OFF_LR);
  struct LD { float4 l0, l1, l2, l3; float f; unsigned short kraw, qraw; };
  auto ld_issue = [&](size_t row, LD& d, bool withq) {
    if (!GLA) d.f = fsrc[row * 512];
    else { const float4* lp = (const float4*)(LR + row * 16); d.l0 = lp[0]; d.l1 = lp[1]; d.l2 = lp[2]; d.l3 = lp[3]; d.kraw = ksrc[row * ldq]; }
    if (withq) d.qraw = qsrc[row * ldq];
  };
  auto ld_eval = [&](const LD& d, float& kval) -> float {
    if (!GLA) { kval = 1.f - d.f; return __logf(d.f); }
    const float x = gbias + d.l0.x * w2c[0] + d.l0.y * w2c[1] + d.l0.z * w2c[2] + d.l0.w * w2c[3] + d.l1.x * w2c[4] + d.l1.y * w2c[5] + d.l1.z * w2c[6] + d.l1.w * w2c[7]
                    + d.l2.x * w2c[8] + d.l2.y * w2c[9] + d.l2.z * w2c[10] + d.l2.w * w2c[11] + d.l3.x * w2c[12] + d.l3.y * w2c[13] + d.l3.z * w2c[14] + d.l3.w * w2c[15];
    kval = bf2f(d.kraw);
    return (fminf(x, 0.f) - log1pf(__expf(-fabsf(x)))) * (1.f / 16.f);
  };
  constexpr int BT = GLA ? 4 : 16;
  float run = 0.f;
#pragma unroll
  for (int t0 = 0; t0 < TPER; t0 += BT) {
    LD ld[BT];
#pragma unroll
    for (int u = 0; u < BT; ++u) { const int ta = c * 64 + tp * TPER + t0 + u; ld_issue((size_t)(row0 + (ta < T ? ta : 0)), ld[u], false); }
    __builtin_amdgcn_sched_barrier(0);
#pragma unroll
    for (int u = 0; u < BT; ++u) { const int ta = c * 64 + tp * TPER + t0 + u; float kd; const float g = ld_eval(ld[u], kd); run += (ta < T) ? g : 0.f; }
  }
  __syncthreads();
  part[tp * K + k] = run;
  __syncthreads();
  float off = 0.f, tot = 0.f;
#pragma unroll
  for (int pp = 0; pp < NPART; ++pp) { const float v = part[pp * K + k]; tot += v; if (pp < tp) off += v; }
  if (tp == 0) ((float*)(ws + OFF_EBL))[(size_t)chunk_index(seq, c) * 768 + (GLA ? 512 : 0) + head * K + k] = __expf(tot);
  run = off;
#pragma unroll
  for (int t0 = 0; t0 < TPER; t0 += BT) {
    LD ld[BT];
#pragma unroll
    for (int u = 0; u < BT; ++u) { const int ta = c * 64 + tp * TPER + t0 + u; ld_issue((size_t)(row0 + (ta < T ? ta : 0)), ld[u], true); }
    __builtin_amdgcn_sched_barrier(0);
#pragma unroll
    for (int u = 0; u < BT; ++u) {
      const int ta = c * 64 + tp * TPER + t0 + u; const bool valid = ta < T;
      const size_t row = (size_t)(row0 + (valid ? ta : 0));
      float kd; const float g = ld_eval(ld[u], kd);
      run += valid ? g : 0.f;
      if (valid) {
        qsrc[row * ldq] = f2bf(bf2f(ld[u].qraw) * __expf(run));
        kdst[row * ldq] = f2bf(kd * __expf(-run));
      }
    }
  }
}
DI void phase_pre(const Params& p, unsigned char* smem) {
  for (int it = blockIdx.x; it < 1040 * 8; it += gridDim.x) {
    const int kind = it & 1, head = (it >> 1) & 3, ci = it >> 3;
    const int seq = ci < 1024 ? (ci >> 6) : 16 + (ci - 1024), c = ci < 1024 ? (ci & 63) : 0;
    if (kind == 0) pre_unit<128, false>(p, seq, c, head, smem);
    else pre_unit<64, true>(p, seq, c, head, smem);
  }
}

template <int K, bool GLA>
DI void chunk_unit(const Params& p, int seq, int head, int vs, unsigned char* smem) {
  constexpr int KP = K + 8, KT = K / 32, NQ = K / 32, CPR = K / 8;
  unsigned char* ws = p.ws;
  bf16_t* Qs = (bf16_t*)smem;
  bf16_t* Ks = Qs + 64 * KP;
  bf16_t* KsT = Ks + 64 * KP;
  bf16_t* VT = KsT + K * 72;
  bf16_t* Am = VT + 32 * 72;
  bf16_t* ST = Am + 64 * 72;
  float* bl = (float*)(ST + 32 * KP);
  const int tid = threadIdx.x, lane = tid & 63, w = tid >> 6, hh = lane >> 5, l31 = lane & 31;
  const int row0 = seq_row0(seq), T = seq_len(seq), nch = (T + 63) >> 6;
  const bf16_t* qsrc = GLA ? (const bf16_t*)(ws + OFF_QB) + head * 64 : (const bf16_t*)(ws + OFF_QA) + head * 128;
  const bf16_t* ksrc = GLA ? (const bf16_t*)(ws + OFF_KTB) + head * 64 : (const bf16_t*)(ws + OFF_KTA) + head * 128;
  const int ldq = GLA ? 256 : 512;
  const bf16_t* vsrc = (const bf16_t*)(ws + (GLA ? OFF_VB : OFF_VA)) + head * 128 + vs * 32;
  const float* ebl = (const float*)(ws + OFF_EBL) + (GLA ? 512 : 0) + head * K;
  bf16_t* odst = (bf16_t*)(ws + OFF_ORAW) + (GLA ? 512 : 0) + head * 128 + vs * 32;
  f32x16 S;
#pragma unroll
  for (int r = 0; r < 16; ++r) S[r] = 0.f;
  float* sout; const float* sin = nullptr;
  {
    const int b = seq & 15;
    const size_t hoff = GLA ? ((size_t)(b * 4 + head) * 64) * 128 : ((size_t)(b * 4 + head) * 128) * 128;
    sout = p.out + (seq < 16 ? (GLA ? O_PG : O_PH) : (GLA ? O_SG : O_SH)) + hoff + vs * 32;
    if (seq >= 16) sin = p.in[GLA ? I_SG : I_SH] + hoff + vs * 32;
  }
  u32x4 rq[NQ], rk[NQ], rv; float rbl = 1.f;
  auto gload = [&](int c) {
#pragma unroll
    for (int j = 0; j < NQ; ++j) {
      const int cj = tid + 256 * j, t = cj / CPR, k8 = (cj % CPR) * 8, ta = c * 64 + t;
      if (ta < T) { rq[j] = *(const u32x4*)(qsrc + (size_t)(row0 + ta) * ldq + k8); rk[j] = *(const u32x4*)(ksrc + (size_t)(row0 + ta) * ldq + k8); }
      else { rq[j] = (u32x4){0u, 0u, 0u, 0u}; rk[j] = (u32x4){0u, 0u, 0u, 0u}; }
    }
    const int s = tid >> 2, vq = tid & 3, ta = c * 64 + s;
    rv = (u32x4){0u, 0u, 0u, 0u};
    if (ta < T) rv = *(const u32x4*)(vsrc + (size_t)(row0 + ta) * 512 + vq * 8);
    if (tid < K) rbl = ebl[(size_t)chunk_index(seq, c) * 768 + tid];
  };
  gload(0);
  __syncthreads();
  if (w < KT) {
    if (sin) {
#pragma unroll
      for (int r = 0; r < 16; ++r) S[r] = sin[(size_t)(w * 32 + crow(r, hh)) * 128 + l31];
    }
#pragma unroll
    for (int g = 0; g < 4; ++g) st_bf4(ST + l31 * KP + w * 32 + 8 * g + 4 * hh, S[4 * g], S[4 * g + 1], S[4 * g + 2], S[4 * g + 3]);
  }
  for (int c = 0; c < nch; ++c) {
#pragma unroll
    for (int j = 0; j < NQ; ++j) {
      const int cj = tid + 256 * j, t = cj / CPR, k8 = (cj % CPR) * 8;
      *(u32x4*)(Qs + t * KP + k8) = rq[j];
      *(u32x4*)(Ks + t * KP + k8) = rk[j];
      const unsigned kk4[4] = {rk[j].x, rk[j].y, rk[j].z, rk[j].w};
      const int tsw = ((((t >> 3) ^ ((k8 >> 3) & 7)) << 3) | (t & 7));
#pragma unroll
      for (int e = 0; e < 4; ++e) { KsT[(k8 + 2 * e) * 72 + tsw] = (bf16_t)(kk4[e] & 0xffffu); KsT[(k8 + 2 * e + 1) * 72 + tsw] = (bf16_t)(kk4[e] >> 16); }
    }
    {
      const int s = tid >> 2, vq = tid & 3;
      const unsigned qq[4] = {rv.x, rv.y, rv.z, rv.w};
#pragma unroll
      for (int j = 0; j < 4; ++j) { VT[(vq * 8 + 2 * j) * 72 + s] = (bf16_t)(qq[j] & 0xffffu); VT[(vq * 8 + 2 * j + 1) * 72 + s] = (bf16_t)(qq[j] >> 16); }
    }
    if (tid < K) bl[tid] = rbl;
    __syncthreads();
    if (c + 1 < nch) gload(c + 1);
    {
      const int tm = w >> 1, tn = w & 1;
      f32x16 a;
#pragma unroll
      for (int r = 0; r < 16; ++r) a[r] = 0.f;
      if (tn <= tm) {
#pragma unroll
        for (int ks = 0; ks < K / 16; ++ks) {
          const bf16x8 qf = *(const bf16x8*)(Qs + (tm * 32 + l31) * KP + ks * 16 + hh * 8);
          const bf16x8 kf = *(const bf16x8*)(Ks + (tn * 32 + l31) * KP + ks * 16 + hh * 8);
          a = MFMA(kf, qf, a);
        }
      }
      const int t = tm * 32 + l31;
#pragma unroll
      for (int g = 0; g < 4; ++g) {
        const int s0 = tn * 32 + 8 * g + 4 * hh;
        float v0 = (s0 <= t) ? a[4 * g] : 0.f, v1 = (s0 + 1 <= t) ? a[4 * g + 1] : 0.f, v2 = (s0 + 2 <= t) ? a[4 * g + 2] : 0.f, v3 = (s0 + 3 <= t) ? a[4 * g + 3] : 0.f;
        if (tn > tm) { v0 = v1 = v2 = v3 = 0.f; }
        st_bf4(Am + t * 72 + s0, v0, v1, v2, v3);
      }
    }
    if (w < KT) {
#pragma unroll
      for (int ks = 0; ks < 4; ++ks) {
        const bf16x8 af = *(const bf16x8*)(KsT + (w * 32 + l31) * 72 + 8 * ((ks * 2 + hh) ^ (((w * 32 + l31) >> 3) & 7)));
        const bf16x8 bf = *(const bf16x8*)(VT + l31 * 72 + ks * 16 + hh * 8);
        S = MFMA(af, bf, S);
      }
    }
    __syncthreads();
    if (w < 2) {
      f32x16 o;
#pragma unroll
      for (int r = 0; r < 16; ++r) o[r] = 0.f;
#pragma unroll
      for (int ks = 0; ks < 4; ++ks) {
        const bf16x8 af = *(const bf16x8*)(Am + (w * 32 + l31) * 72 + ks * 16 + hh * 8);
        const bf16x8 bf = *(const bf16x8*)(VT + l31 * 72 + ks * 16 + hh * 8);
        o = MFMA(af, bf, o);
      }
#pragma unroll
      for (int ks = 0; ks < K / 16; ++ks) {
        const bf16x8 af = *(const bf16x8*)(Qs + (w * 32 + l31) * KP + ks * 16 + hh * 8);
        const bf16x8 bf = *(const bf16x8*)(ST + l31 * KP + ks * 16 + hh * 8);
        o = MFMA(af, bf, o);
      }
#pragma unroll
      for (int r = 0; r < 16; ++r) {
        const int ta = c * 64 + w * 32 + crow(r, hh);
        if (ta < T) odst[(size_t)(row0 + ta) * 1024 + l31] = f2bf(o[r]);
      }
    }
    __syncthreads();
    if (w < KT) {
#pragma unroll
      for (int r = 0; r < 16; ++r) S[r] *= bl[w * 32 + crow(r, hh)];
#pragma unroll
      for (int g = 0; g < 4; ++g) st_bf4(ST + l31 * KP + w * 32 + 8 * g + 4 * hh, S[4 * g], S[4 * g + 1], S[4 * g + 2], S[4 * g + 3]);
    }
    __syncthreads();
  }
  if (w < KT) {
#pragma unroll
    for (int r = 0; r < 16; ++r) sout[(size_t)(w * 32 + crow(r, hh)) * 128 + l31] = S[r];
  }
  __syncthreads();
}

DI void phase2(const Params& p, unsigned char* smem) {
  for (int u = blockIdx.x; u < 1024; u += gridDim.x) {
    const int kind = (u >> 8) & 1, idx = u & 255, seq = (idx >> 4) + (u >= 512 ? 16 : 0), head = (idx >> 2) & 3, vs = idx & 3;
    if (kind == 0) chunk_unit<128, false>(p, seq, head, vs, smem);
    else chunk_unit<64, true>(p, seq, head, vs, smem);
  }
}

DI void phase3(const Params& p, unsigned char*) {
  unsigned char* ws = p.ws;
  const int lane = threadIdx.x & 63, gw = blockIdx.x * 4 + (threadIdx.x >> 6), nw = gridDim.x * 4;
  const bf16_t* O = (const bf16_t*)(ws + OFF_ORAW);
  const bf16_t* G = (const bf16_t*)(ws + (lane < 32 ? OFF_GA : OFF_GB)) + (lane & 31) * 16;
  const float* ng = p.in[lane < 32 ? I_HNG : I_GNG] + (lane & 7) * 16;
  float gv[16];
#pragma unroll
  for (int i = 0; i < 16; ++i) gv[i] = ng[i];
  bf16_t* out = (bf16_t*)(ws + OFF_HA);
  for (int row = gw; row < NT; row += nw) {
    const u32x4 o0 = *(const u32x4*)(O + (size_t)row * 1024 + lane * 16), o1 = *(const u32x4*)(O + (size_t)row * 1024 + lane * 16 + 8);
    const u32x4 g0 = *(const u32x4*)(G + (size_t)row * 512), g1 = *(const u32x4*)(G + (size_t)row * 512 + 8);
    float ov[16], gt[16];
    unpack8(o0, ov); unpack8(o1, ov + 8); unpack8(g0, gt); unpack8(g1, gt + 8);
    float ss = 0.f;
#pragma unroll
    for (int i = 0; i < 16; ++i) ss += ov[i] * ov[i];
    ss += __shfl_xor(ss, 1); ss += __shfl_xor(ss, 2); ss += __shfl_xor(ss, 4);
    const float rs = rsqrtf(ss * (1.f / 128.f) + 1e-6f);
    float r[16];
#pragma unroll
    for (int i = 0; i < 16; ++i) r[i] = ov[i] * rs * gv[i] * gt[i];
    *(u32x4*)(out + (size_t)row * 1024 + lane * 16) = pack8(r);
    *(u32x4*)(out + (size_t)row * 1024 + lane * 16 + 8) = pack8(r + 8);
  }
}

DI void phase_outproj(const Params& p, unsigned char* smem, size_t offA, size_t offW, bool first) {
  unsigned char* ws = p.ws;
  bf16_t* As = (bf16_t*)smem;
  float* X = p.out;
  for_tiles(NT / 128, 8, [&](int tm, int tn) {
    f32x16 acc[2][2];
    gemm_tile_db(LoadBf16{(const bf16_t*)(ws + offA), 1024}, (const bf16_t*)(ws + offW), 1024, 1024, tm * 128, tn * 128, acc, As);
    epilogue(acc, tm * 128, tn * 128, [&](int row, int col, float a, float b, float c, float d) {
      const float* src = first ? (row < NPR ? p.in[I_XP] + (size_t)row * 1024 + col : p.in[I_XS] + (size_t)(row - NPR) * 1024 + col) : X + (size_t)row * 1024 + col;
      float4 x = *(const float4*)src;
      x.x += a; x.y += b; x.z += c; x.w += d;
      *(float4*)(X + (size_t)row * 1024 + col) = x;
    }, (float*)smem);
  });
}

DI void phase_norm2(const Params& p, int layer) { rmsnorm_rows(p, p.out, false, p.in[I_N2] + layer * 1024, (bf16_t*)(p.ws + OFF_HA)); }

DI void phase_qp(const Params& p, unsigned char* smem, int layer) {
  unsigned char* ws = p.ws;
  bf16_t* As = (bf16_t*)smem;
  bf16_t* QP = (bf16_t*)(ws + OFF_QP);
  for_tiles(NT / 128, 16, [&](int tm, int tn) {
    f32x16 acc[2][2];
    gemm_tile_db(LoadBf16{(const bf16_t*)(ws + OFF_HA), 1024}, (const bf16_t*)(ws + OFF_WT_Q) + (size_t)layer * 2048 * 1024, 1024, 1024, tm * 128, tn * 128, acc, As);
    epilogue(acc, tm * 128, tn * 128, [&](int row, int col, float a, float b, float c, float d) { st_bf4(QP + (size_t)row * 2048 + col, a, b, c, d); }, (float*)smem);
  });
}

DI unsigned f2key(float f, int idx) { unsigned u = __float_as_uint(f); u = (u & 0x80000000u) ? ~u : (u | 0x80000000u); return (u & ~127u) | (unsigned)(127 - idx); }
DI float key2f(unsigned k) { k &= ~127u; const unsigned u = (k & 0x80000000u) ? (k & 0x7fffffffu) : ~k; return __uint_as_float(u); }
DI void phase_route(const Params& p, unsigned char* smem, int layer) {
  unsigned char* ws = p.ws;
  bf16_t* As = (bf16_t*)smem;
  unsigned* sk = (unsigned*)smem;
  float* lv = (float*)smem;
  int* li = (int*)(smem + 16384);
  float* sv1 = (float*)(smem + 32768);
  unsigned char* si1 = smem + 32768 + 8192;
  float* sv0 = (float*)(smem + 65536);
  unsigned char* si0 = smem + 65536 + 8192;
  const bf16_t* QP = (const bf16_t*)(ws + OFF_QP);
  const bf16_t* SK = (const bf16_t*)(ws + OFF_SK);
  int* EIDX = (int*)(ws + OFF_EIDX); float* GATE = (float*)(ws + OFF_GATE);
  const int tid = threadIdx.x, lane = tid & 63, w = tid >> 6, wm = w >> 1, wn = w & 1;
  const int ntile = (NT / 128) * 8;
  for (int t = blockIdx.x; t < ntile; t += gridDim.x) {
    const int tm = t >> 3, h = t & 7;
    for (int p2 = 0; p2 < 2; ++p2) {
      f32x16 acc[2][2];
      gemm_tile<64>(LoadBf16{QP + (h * 2 + p2) * 128, 2048}, SK + (size_t)((layer * 8 + h) * 2 + p2) * 128 * 128, 128, 128, tm * 128, 0, acc, As);
      __syncthreads();
#pragma unroll
      for (int mi = 0; mi < 2; ++mi)
#pragma unroll
        for (int ni = 0; ni < 2; ++ni)
#pragma unroll
          for (int g4 = 0; g4 < 4; ++g4) {
            const int m = wm * 64 + mi * 32 + (lane & 31), n = wn * 64 + ni * 32 + 8 * g4 + 4 * (lane >> 5);
            *(u32x4*)(sk + m * 128 + 4 * ((n >> 2) ^ (m & 31))) = (u32x4){f2key(acc[mi][ni][4 * g4], n), f2key(acc[mi][ni][4 * g4 + 1], n + 1), f2key(acc[mi][ni][4 * g4 + 2], n + 2), f2key(acc[mi][ni][4 * g4 + 3], n + 3)};
          }
      __syncthreads();
      const int row = tid & 127, half = tid >> 7, sw = row & 31;
      unsigned keys[16];
#pragma unroll
      for (int r = 0; r < 16; ++r) {
        unsigned best = 0u;
#pragma unroll
        for (int q = 0; q < 16; ++q) {
          const u32x4 v = *(const u32x4*)(sk + row * 128 + 4 * ((half * 16 + q) ^ sw));
          best = max(max(best, v.x), v.y); best = max(max(best, v.z), v.w);
        }
        const int bidx = 127 - (int)(best & 127u);
        sk[row * 128 + 4 * ((bidx >> 2) ^ sw) + (bidx & 3)] = 0u;
        keys[r] = best;
      }
      __syncthreads();
#pragma unroll
      for (int r = 0; r < 16; ++r) { lv[r * 256 + tid] = key2f(keys[r]); li[r * 256 + tid] = 127 - (int)(keys[r] & 127u); }
      __syncthreads();
      if (tid < 128) {
        float* dv = p2 ? sv1 : sv0; unsigned char* di = p2 ? si1 : si0;
        int a = 0, b = 0;
#pragma unroll 1
        for (int r = 0; r < 16; ++r) {
          const float va = lv[a * 256 + row], vb = lv[b * 256 + 128 + row];
          const bool ta = va >= vb;
          dv[r * 128 + row] = ta ? va : vb;
          di[r * 128 + row] = (unsigned char)(ta ? li[a * 256 + row] : li[b * 256 + 128 + row]);
          a += ta ? 1 : 0; b += ta ? 0 : 1;
        }
      }
      __syncthreads();
    }
    if (tid < 128) {
      const int row = tid;
      unsigned long long jp = 0ull;
      float cs[16]; int ce[16];
#pragma unroll
      for (int r = 0; r < 16; ++r) {
        float best = -INFINITY; int bi_ = 0;
#pragma unroll
        for (int i = 0; i < 16; ++i) {
          const int j = (int)((jp >> (4 * i)) & 15ull);
          const float v = sv0[i * 128 + row] + sv1[j * 128 + row];
          if (v > best) { best = v; bi_ = i; }
        }
        const int j = (int)((jp >> (4 * bi_)) & 15ull);
        ce[r] = (int)si0[bi_ * 128 + row] * 128 + (int)si1[j * 128 + row];
        cs[r] = best;
        jp += 1ull << (4 * bi_);
      }
      float e[16], sum = 0.f;
#pragma unroll
      for (int r = 0; r < 16; ++r) { e[r] = __expf(cs[r] - cs[0]); sum += e[r]; }
      const float inv = 1.f / sum;
      const size_t base = ((size_t)(tm * 128 + row) * 8 + h) * 16;
#pragma unroll
      for (int r = 0; r < 16; ++r) { EIDX[base + r] = ce[r]; GATE[base + r] = e[r] * inv; }
    }
    __syncthreads();
  }
}

DI float dot2bf(unsigned a, unsigned b, float c) {
  typedef __bf16 bf2 __attribute__((ext_vector_type(2)));
  return __builtin_amdgcn_fdot2_f32_bf16(__builtin_bit_cast(bf2, a), __builtin_bit_cast(bf2, b), c, false);
}

#define CVT8(q, hi) __builtin_amdgcn_cvt_pk_f32_fp8((int)(q), hi)
DI float dpp_x1(float v) { return __uint_as_float(__builtin_amdgcn_update_dpp(0, __float_as_uint(v), 0xB1, 0xF, 0xF, true)); }
DI float dpp_x2(float v) { return __uint_as_float(__builtin_amdgcn_update_dpp(0, __float_as_uint(v), 0x4E, 0xF, 0xF, true)); }
DI float dpp_hm(float v) { return __uint_as_float(__builtin_amdgcn_update_dpp(0, __float_as_uint(v), 0x141, 0xF, 0xF, true)); }
DI f32x2 shx2(const f32x2& v, int m) { f32x2 r; r.x = __shfl_xor(v.x, m); r.y = __shfl_xor(v.y, m); return r; }

struct TokU { u32x4 xa, xb; int ev0, ev1; };
DI void phase_peer_u(const Params& p) {
  unsigned char* ws = p.ws;
  const int lane = threadIdx.x & 63, r = lane >> 3, s = lane & 7;
  const int x = blockIdx.x & 7, lw = (blockIdx.x >> 3) * 4 + (threadIdx.x >> 6), nlw = (gridDim.x >> 3) * 4;
  const unsigned char* U8s = ws + OFF_U8 + (size_t)x * 16384 * 128 + 16 * s;
  const int* EIDX = (const int*)(ws + OFF_EIDX);
  const bf16_t* HA = (const bf16_t*)(ws + OFF_HA);
  float* HP = (float*)(ws + OFF_HP) + (size_t)x * NT * 128;
  auto load_tok = [&](int t, TokU& k) {
    const bf16_t* hp = HA + (size_t)t * 1024 + 128 * x + 16 * s;
    k.xa = *(const u32x4*)hp; k.xb = *(const u32x4*)(hp + 8);
    k.ev0 = EIDX[(size_t)t * 128 + lane]; k.ev1 = EIDX[(size_t)t * 128 + 64 + lane];
  };
  auto gather = [&](const TokU& k, u32x4 (&g)[16]) {
#pragma unroll
    for (int i = 0; i < 16; ++i) { const int e = __shfl(i < 8 ? k.ev0 : k.ev1, (8 * i + r) & 63); g[i] = *(const u32x4*)(U8s + (size_t)e * 128); }
  };
  auto compute = [&](int t, const f32x2 (&xs)[8], const u32x4 (&g)[16]) {
    float keep0 = 0.f, keep1 = 0.f;
#pragma unroll
    for (int i = 0; i < 16; ++i) {
      const u32x4 u = g[i];
      f32x2 d = CVT8(u.x, false) * xs[0];
      d = CVT8(u.x, true) * xs[1] + d; d = CVT8(u.y, false) * xs[2] + d; d = CVT8(u.y, true) * xs[3] + d;
      d = CVT8(u.z, false) * xs[4] + d; d = CVT8(u.z, true) * xs[5] + d; d = CVT8(u.w, false) * xs[6] + d; d = CVT8(u.w, true) * xs[7] + d;
      float ds = d.x + d.y;
      ds += dpp_x1(ds); ds += dpp_x2(ds); ds += dpp_hm(ds);
      if (s == (i & 7)) { if (i < 8) keep0 = ds; else keep1 = ds; }
    }
    HP[(size_t)t * 128 + 8 * s + r] = keep0; HP[(size_t)t * 128 + 64 + 8 * s + r] = keep1;
  };
#define PU_STEP(kc, gc, kn, gn)                                                                                        \
  {                                                                                                                    \
    const int tn = t + nlw; const bool has_next = tn < NT;                                                             \
    if (has_next) gather(kn, gn);                                                                                      \
    const f32x2 xs[8] = {{lo2f(kc.xa.x), hi2f(kc.xa.x)}, {lo2f(kc.xa.y), hi2f(kc.xa.y)}, {lo2f(kc.xa.z), hi2f(kc.xa.z)}, {lo2f(kc.xa.w), hi2f(kc.xa.w)}, \
                         {lo2f(kc.xb.x), hi2f(kc.xb.x)}, {lo2f(kc.xb.y), hi2f(kc.xb.y)}, {lo2f(kc.xb.z), hi2f(kc.xb.z)}, {lo2f(kc.xb.w), hi2f(kc.xb.w)}}; \
    if (tn + nlw < NT) load_tok(tn + nlw, kc);                                                                         \
    __builtin_amdgcn_sched_barrier(0);                                                                                 \
    compute(t, xs, gc);                                                                                                \
    t = tn; if (!has_next) break;                                                                                      \
  }
  int t = lw;
  if (t < NT) {
    TokU ka, kb; u32x4 ga[16], gb[16];
    load_tok(t, ka); gather(ka, ga);
    if (t + nlw < NT) load_tok(t + nlw, kb);
    while (true) {
      PU_STEP(ka, ga, kb, gb)
      PU_STEP(kb, gb, ka, ga)
    }
  }
#undef PU_STEP
}

DI void phase_peer_act(const Params& p) {
  unsigned char* ws = p.ws;
  const float* HP = (const float*)(ws + OFF_HP);
  const float* USC = (const float*)(ws + OFF_USC); const float* VSC = (const float*)(ws + OFF_VSC);
  const int* EIDX = (const int*)(ws + OFF_EIDX); float* GATE = (float*)(ws + OFF_GATE);
  const size_t n = (size_t)NT * 128, stride = (size_t)gridDim.x * 256 * 4;
  for (size_t idx = ((size_t)blockIdx.x * 256 + threadIdx.x) * 4; idx < n; idx += stride) {
    float4 hp[8];
#pragma unroll
    for (int x = 0; x < 8; ++x) hp[x] = *(const float4*)(HP + (size_t)x * n + idx);
    const int4 e4 = *(const int4*)(EIDX + idx);
    const float4 g4 = *(const float4*)(GATE + idx);
    __builtin_amdgcn_sched_barrier(0);
    const float us[4] = {USC[e4.x], USC[e4.y], USC[e4.z], USC[e4.w]};
    const float vs[4] = {VSC[e4.x], VSC[e4.y], VSC[e4.z], VSC[e4.w]};
    float h[4] = {0.f, 0.f, 0.f, 0.f};
#pragma unroll
    for (int x = 0; x < 8; ++x) { h[0] += hp[x].x; h[1] += hp[x].y; h[2] += hp[x].z; h[3] += hp[x].w; }
    const float gg[4] = {g4.x, g4.y, g4.z, g4.w};
    float o[4];
#pragma unroll
    for (int j = 0; j < 4; ++j) { const float hh = h[j] * us[j]; o[j] = 0.5f * hh * (1.f + erff(hh * 0.70710678118f)) * gg[j] * vs[j]; }
    *(float4*)(GATE + idx) = make_float4(o[0], o[1], o[2], o[3]);
  }
}

struct TokV { int ev0, ev1; float ac0, ac1; float2 xv; };
DI void phase_peer_v(const Params& p) {
  unsigned char* ws = p.ws;
  const int lane = threadIdx.x & 63, r = lane >> 3, s = lane & 7;
  const int x = blockIdx.x & 7, lw = (blockIdx.x >> 3) * 4 + (threadIdx.x >> 6), nlw = (gridDim.x >> 3) * 4;
  const unsigned char* V8s = ws + OFF_V8 + (size_t)x * 16384 * 128 + 16 * s;
  const int* EIDX = (const int*)(ws + OFF_EIDX); const float* ACT = (const float*)(ws + OFF_GATE);
  float* X = p.out; float* SSP = (float*)(ws + OFF_SSP) + (size_t)x * NT;
  const int xoff = 128 * x + 16 * s + 2 * r;
  auto load_tok = [&](int t, TokV& k) {
    k.ev0 = EIDX[(size_t)t * 128 + lane]; k.ev1 = EIDX[(size_t)t * 128 + 64 + lane];
    k.ac0 = ACT[(size_t)t * 128 + lane]; k.ac1 = ACT[(size_t)t * 128 + 64 + lane];
    k.xv = *(const float2*)(X + (size_t)t * 1024 + xoff);
  };
  auto gather = [&](const TokV& k, u32x4 (&g)[16], unsigned (&pk)[16]) {
    const unsigned w0 = (pack2(0.f, k.ac0) & 0xffff0000u) | (unsigned)k.ev0, w1 = (pack2(0.f, k.ac1) & 0xffff0000u) | (unsigned)k.ev1;
#pragma unroll
    for (int i = 0; i < 16; ++i) { pk[i] = (unsigned)__shfl((int)(i < 8 ? w0 : w1), (8 * i + r) & 63); g[i] = *(const u32x4*)(V8s + (size_t)(pk[i] & 0xffffu) * 128); }
  };
  auto compute = [&](int t, float2 xv, const u32x4 (&g)[16], const unsigned (&pk)[16]) {
    f32x2 acc[8];
#pragma unroll
    for (int i = 0; i < 8; ++i) acc[i] = (f32x2){0.f, 0.f};
#pragma unroll
    for (int i = 0; i < 16; ++i) {
      const float a = __uint_as_float(pk[i] & 0xffff0000u);
      const u32x4 v = g[i];
      const f32x2 aa = {a, a};
      acc[0] = CVT8(v.x, false) * aa + acc[0]; acc[1] = CVT8(v.x, true) * aa + acc[1];
      acc[2] = CVT8(v.y, false) * aa + acc[2]; acc[3] = CVT8(v.y, true) * aa + acc[3];
      acc[4] = CVT8(v.z, false) * aa + acc[4]; acc[5] = CVT8(v.z, true) * aa + acc[5];
      acc[6] = CVT8(v.w, false) * aa + acc[6]; acc[7] = CVT8(v.w, true) * aa + acc[7];
    }
    f32x2 b4[4], b2[2];
#pragma unroll
    for (int m = 0; m < 4; ++m) { const f32x2 keep = (r & 4) ? acc[4 + m] : acc[m], send = (r & 4) ? acc[m] : acc[4 + m]; b4[m] = keep + shx2(send, 32); }
#pragma unroll
    for (int m = 0; m < 2; ++m) { const f32x2 keep = (r & 2) ? b4[2 + m] : b4[m], send = (r & 2) ? b4[m] : b4[2 + m]; b2[m] = keep + shx2(send, 16); }
    const f32x2 keep = (r & 1) ? b2[1] : b2[0], send = (r & 1) ? b2[0] : b2[1];
    const f32x2 o = keep + shx2(send, 8);
    xv.x += o.x; xv.y += o.y;
    *(float2*)(X + (size_t)t * 1024 + xoff) = xv;
    const float ss = wave_sum(xv.x * xv.x + xv.y * xv.y);
    if (lane == 0) SSP[t] = ss;
  };
#define PV_STEP(kc, gc, pc, kn, gn, pn)                                                                                       \
  {                                                                                                                    \
    const int tn = t + nlw; const bool has_next = tn < NT;                                                             \
    if (has_next) gather(kn, gn, pn);                                                                                  \
    const float2 cx = kc.xv;                                                     \
    if (tn + nlw < NT) load_tok(tn + nlw, kc);                                                                         \
    __builtin_amdgcn_sched_barrier(0);                                                                                 \
    compute(t, cx, gc, pc);                                                                                        \
    t = tn; if (!has_next) break;                                                                                      \
  }
  int t = lw;
  if (t < NT) {
    TokV ka, kb; u32x4 ga[16], gb[16]; unsigned pa[16], pb[16];
    load_tok(t, ka); gather(ka, ga, pa);
    if (t + nlw < NT) load_tok(t + nlw, kb);
    while (true) {
      PV_STEP(ka, ga, pa, kb, gb, pb)
      PV_STEP(kb, gb, pb, ka, ga, pa)
    }
  }
#undef PV_STEP
}

DI void phase_peer_norm(const Params& p, int layer) {
  unsigned char* ws = p.ws;
  const int lane = threadIdx.x & 63, gw = blockIdx.x * 4 + (threadIdx.x >> 6), nw = gridDim.x * 4;
  const float* SSP = (const float*)(ws + OFF_SSP);
  bf16_t* HA = (bf16_t*)(ws + OFF_HA);
  float* X = p.out;
  const float* gn = layer == 0 ? p.in[I_N1] + 1024 : p.in[I_FG];
  float4 gv[4];
#pragma unroll
  for (int j = 0; j < 4; ++j) gv[j] = *(const float4*)(gn + lane * 4 + 256 * j);
  for (int row = gw; row < NT; row += nw) {
    float sp[8];
#pragma unroll
    for (int x = 0; x < 8; ++x) sp[x] = SSP[(size_t)x * NT + row];
    float* xr = X + (size_t)row * 1024;
    float4 xin[4];
#pragma unroll
    for (int j = 0; j < 4; ++j) xin[j] = *(const float4*)(xr + lane * 4 + 256 * j);
    __builtin_amdgcn_sched_barrier(0);
    const float ss = ((sp[0] + sp[1]) + (sp[2] + sp[3])) + ((sp[4] + sp[5]) + (sp[6] + sp[7]));
    const float rs = rsqrtf(ss * (1.f / 1024.f) + 1e-6f);
    float* so = nullptr;
    if (layer == 0) {
      if (row < NPR) { if ((row & 4095) == 4095) so = p.out + O_PS + (size_t)(row >> 12) * 1024; }
      else { if (((row - NPR) & 31) == 31) so = p.out + O_SS + (size_t)((row - NPR) >> 5) * 1024; }
    }
#pragma unroll
    for (int j = 0; j < 4; ++j) {
      const float4 v = xin[j];
      const float4 y = make_float4(v.x * rs * gv[j].x, v.y * rs * gv[j].y, v.z * rs * gv[j].z, v.w * rs * gv[j].w);
      if (layer == 0) {
        st_bf4(HA + (size_t)row * 1024 + lane * 4 + 256 * j, y.x, y.y, y.z, y.w);
        if (so) *(float4*)(so + lane * 4 + 256 * j) = y;
      } else *(float4*)(xr + lane * 4 + 256 * j) = y;
    }
  }
}

DI void phase9(const Params& p, unsigned char* smem) {
  unsigned char* ws = p.ws;
  bf16_t* As = (bf16_t*)smem;
  bf16_t* R = (bf16_t*)(ws + OFF_R); bf16_t* Kb = (bf16_t*)(ws + OFF_K); bf16_t* V = (bf16_t*)(ws + OFF_V);
  bf16_t* W1 = (bf16_t*)(ws + OFF_W1); bf16_t* A1 = (bf16_t*)(ws + OFF_A1); bf16_t* G1 = (bf16_t*)(ws + OFF_G1);
  for_tiles(NT / 128, 27, [&](int tm, int tn) {
    const int mi_ = tn < 24 ? (tn >> 3) : tn - 21;
    f32x16 acc[2][2];
    gemm_tile<64>(LoadShiftMix{(const bf16_t*)(ws + OFF_HA), p.in[I_MU] + mi_ * 1024, p.in[I_SS]}, (const bf16_t*)(ws + OFF_WT_RK), 1024, 1024, tm * 128, tn * 128, acc, As);
    epilogue(acc, tm * 128, tn * 128, [&](int row, int col, float a, float b, float c, float d) {
      if (col < 1024) st_bf4(R + (size_t)row * 1024 + col, a, b, c, d);
      else if (col < 2048) st_bf4(Kb + (size_t)row * 1024 + col - 1024, a, b, c, d);
      else if (col < 3072) st_bf4(V + (size_t)row * 1024 + col - 2048, a, b, c, d);
      else if (col < 3136) st_bf4(W1 + (size_t)row * 64 + col - 3072, tanhf(a), tanhf(b), tanhf(c), tanhf(d));
      else if (col < 3200) {}
      else if (col < 3264) st_bf4(A1 + (size_t)row * 64 + col - 3200, a, b, c, d);
      else if (col < 3328) {}
      else st_bf4(G1 + (size_t)row * 128 + col - 3328, sigmoidf_(a), sigmoidf_(b), sigmoidf_(c), sigmoidf_(d));
    }, (float*)smem);
  });
}

DI float decay_of(float w) {
  const float nw = -w;
  const float sp = nw > 20.f ? nw : log1pf(__expf(nw));
  return __expf(-__expf(-sp - 0.5f));
}
DI unsigned short f2h(float x) { return __builtin_bit_cast(unsigned short, (_Float16)x); }

DI void phase10(const Params& p, unsigned char* smem) {
  unsigned char* ws = p.ws;
  bf16_t* As = (bf16_t*)smem;
  unsigned short* DEC = (unsigned short*)(ws + OFF_DEC); bf16_t* AA = (bf16_t*)(ws + OFF_AA); bf16_t* GG = (bf16_t*)(ws + OFF_GG);
  for_tiles(NT / 128, 24, [&](int tm, int tn) {
    const int grp = tn >> 3, n0 = (tn & 7) * 128;
    f32x16 acc[2][2];
    if (grp == 0) {
      gemm_tile<64>(LoadBf16{(const bf16_t*)(ws + OFF_W1), 64}, (const bf16_t*)(ws + OFF_WT_W2), 64, 64, tm * 128, n0, acc, As);
      epilogue(acc, tm * 128, n0, [&](int row, int col, float a, float b, float c, float d) {
        const float4 w0 = *(const float4*)(p.in[I_W0] + col);
        u32x2 q; q.x = (unsigned)f2h(decay_of(w0.x + a)) | ((unsigned)f2h(decay_of(w0.y + b)) << 16); q.y = (unsigned)f2h(decay_of(w0.z + c)) | ((unsigned)f2h(decay_of(w0.w + d)) << 16);
        *(u32x2*)(DEC + (size_t)row * 1024 + col) = q;
      }, (float*)smem);
    } else if (grp == 1) {
      gemm_tile<64>(LoadBf16{(const bf16_t*)(ws + OFF_A1), 64}, (const bf16_t*)(ws + OFF_WT_A2), 64, 64, tm * 128, n0, acc, As);
      epilogue(acc, tm * 128, n0, [&](int row, int col, float a, float b, float c, float d) {
        const float4 a0 = *(const float4*)(p.in[I_A0] + col);
        st_bf4(AA + (size_t)row * 1024 + col, sigmoidf_(a0.x + a), sigmoidf_(a0.y + b), sigmoidf_(a0.z + c), sigmoidf_(a0.w + d));
      }, (float*)smem);
    } else {
      gemm_tile<128>(LoadBf16{(const bf16_t*)(ws + OFF_G1), 128}, (const bf16_t*)(ws + OFF_WT_G2), 128, 128, tm * 128, n0, acc, As);
      epilogue(acc, tm * 128, n0, [&](int row, int col, float a, float b, float c, float d) { st_bf4(GG + (size_t)row * 1024 + col, a, b, c, d); }, (float*)smem);
    }
  });
}

DI float dpp_xor1(float v) { return __uint_as_float(__builtin_amdgcn_update_dpp(0, __float_as_uint(v), 0xB1, 0xF, 0xF, true)); }
DI float dpp_xor2(float v) { return __uint_as_float(__builtin_amdgcn_update_dpp(0, __float_as_uint(v), 0x4E, 0xF, 0xF, true)); }

DI void rwkv_unit(const Params& p, int seq, int head, int ih, unsigned char* smem) {
  unsigned char* ws = p.ws;
  float* buf = (float*)smem;
  float* obuf = buf + 32 * 384;
  const int tid = threadIdx.x, lane = tid & 63, w = tid >> 6, il = lane >> 3, jq = lane & 7, ii = w * 8 + il, i = ih * 32 + ii;
  const int row0 = seq_row0(seq), T = seq_len(seq), nch = T >> 5;
  const int b = seq & 15;
  f32x2 s2[4];
  const size_t soff = ((size_t)(b * 16 + head) * 64 + i) * 64 + jq * 8;
  if (seq >= 16) {
    const float* sp = p.in[I_SR] + soff;
#pragma unroll
    for (int j = 0; j < 4; ++j) s2[j] = (f32x2){sp[2 * j], sp[2 * j + 1]};
  } else {
#pragma unroll
    for (int j = 0; j < 4; ++j) s2[j] = (f32x2){0.f, 0.f};
  }
  const int pt = tid >> 3, jg = tid & 7, col = head * 64 + jg * 8;
  float ckk[8], cka[8], crk[8];
#pragma unroll
  for (int j = 0; j < 8; ++j) { ckk[j] = p.in[I_KK][col + j]; cka[j] = p.in[I_KA][col + j]; crk[j] = p.in[I_RK][col + j]; }
  const bf16_t* R = (const bf16_t*)(ws + OFF_R); const bf16_t* Kb = (const bf16_t*)(ws + OFF_K); const bf16_t* V = (const bf16_t*)(ws + OFF_V);
  const unsigned short* DEC = (const unsigned short*)(ws + OFF_DEC); const bf16_t* AA = (const bf16_t*)(ws + OFF_AA);
  float* BON = (float*)(ws + OFF_BON);
  bf16_t* O2 = (bf16_t*)(ws + OFF_ORAW2);
  u32x4 qr, qk, qv, qd, qa;
  {
    const size_t o = (size_t)(row0 + pt) * 1024 + col;
    qr = *(const u32x4*)(R + o); qk = *(const u32x4*)(Kb + o); qv = *(const u32x4*)(V + o); qd = *(const u32x4*)(DEC + o); qa = *(const u32x4*)(AA + o);
  }
  __syncthreads();
  for (int c = 0; c < nch; ++c) {
    {
      float r8[8], k8[8], v8[8], a8[8], d8[8];
      unpack8(qr, r8); unpack8(qk, k8); unpack8(qv, v8); unpack8(qa, a8);
      const half8 dh = __builtin_bit_cast(half8, qd);
#pragma unroll
      for (int j = 0; j < 8; ++j) d8[j] = (float)dh[j];
      float kkr[8], ss = 0.f, bon = 0.f, kp[8];
#pragma unroll
      for (int j = 0; j < 8; ++j) { kkr[j] = k8[j] * ckk[j]; ss += kkr[j] * kkr[j]; kp[j] = k8[j] * (1.f + (a8[j] - 1.f) * cka[j]); bon += r8[j] * kp[j] * crk[j]; }
      ss += dpp_x1(ss); ss += dpp_x2(ss); ss += dpp_hm(ss);
      bon += dpp_x1(bon); bon += dpp_x2(bon); bon += dpp_hm(bon);
      const float inv = rsqrtf(ss + 1e-12f);
      float* bb = buf + pt * 384 + jg * 8;
      float kkn[8], bbv[8];
#pragma unroll
      for (int j = 0; j < 8; ++j) { kkn[j] = kkr[j] * inv; bbv[j] = kkn[j] * a8[j]; }
      *(float4*)(bb) = make_float4(r8[0], r8[1], r8[2], r8[3]); *(float4*)(bb + 4) = make_float4(r8[4], r8[5], r8[6], r8[7]);
      *(float4*)(bb + 64) = make_float4(d8[0], d8[1], d8[2], d8[3]); *(float4*)(bb + 68) = make_float4(d8[4], d8[5], d8[6], d8[7]);
      *(float4*)(bb + 128) = make_float4(kp[0], kp[1], kp[2], kp[3]); *(float4*)(bb + 132) = make_float4(kp[4], kp[5], kp[6], kp[7]);
      *(float4*)(bb + 192) = make_float4(kkn[0], kkn[1], kkn[2], kkn[3]); *(float4*)(bb + 196) = make_float4(kkn[4], kkn[5], kkn[6], kkn[7]);
      *(float4*)(bb + 256) = make_float4(bbv[0], bbv[1], bbv[2], bbv[3]); *(float4*)(bb + 260) = make_float4(bbv[4], bbv[5], bbv[6], bbv[7]);
      *(float4*)(bb + 320) = make_float4(v8[0], v8[1], v8[2], v8[3]); *(float4*)(bb + 324) = make_float4(v8[4], v8[5], v8[6], v8[7]);
      if (jg == 0 && ih == 0) BON[(size_t)(row0 + c * 32 + pt) * 16 + head] = bon;
    }
    __syncthreads();
    if (c + 1 < nch) {
      const size_t o = (size_t)(row0 + (c + 1) * 32 + pt) * 1024 + col;
      qr = *(const u32x4*)(R + o); qk = *(const u32x4*)(Kb + o); qv = *(const u32x4*)(V + o); qd = *(const u32x4*)(DEC + o); qa = *(const u32x4*)(AA + o);
    }
    struct StepOps { float4 r0, r1, w0, w1, k0, k1, n0, n1, b0, b1; float vi; };
    auto ldops = [&](int t, StepOps& q) {
      const float* sb = buf + t * 384 + jq * 8;
      q.n0 = *(const float4*)(sb + 192); q.n1 = *(const float4*)(sb + 196);
      q.w0 = *(const float4*)(sb + 64); q.w1 = *(const float4*)(sb + 68);
      q.b0 = *(const float4*)(sb + 256); q.b1 = *(const float4*)(sb + 260);
      q.k0 = *(const float4*)(sb + 128); q.k1 = *(const float4*)(sb + 132);
      q.r0 = *(const float4*)(sb); q.r1 = *(const float4*)(sb + 4);
      q.vi = buf[t * 384 + 320 + i];
    };
    StepOps cu; ldops(0, cu);
#pragma unroll 4
    for (int t = 0; t < 32; ++t) {
      StepOps nx = cu;
      if (t + 1 < 32) ldops(t + 1, nx);
      __builtin_amdgcn_sched_barrier(0);
      const f32x2 rr2[4] = {{cu.r0.x, cu.r0.y}, {cu.r0.z, cu.r0.w}, {cu.r1.x, cu.r1.y}, {cu.r1.z, cu.r1.w}};
      const f32x2 ww2[4] = {{cu.w0.x, cu.w0.y}, {cu.w0.z, cu.w0.w}, {cu.w1.x, cu.w1.y}, {cu.w1.z, cu.w1.w}};
      const f32x2 kp2[4] = {{cu.k0.x, cu.k0.y}, {cu.k0.z, cu.k0.w}, {cu.k1.x, cu.k1.y}, {cu.k1.z, cu.k1.w}};
      const f32x2 kn2[4] = {{cu.n0.x, cu.n0.y}, {cu.n0.z, cu.n0.w}, {cu.n1.x, cu.n1.y}, {cu.n1.z, cu.n1.w}};
      const f32x2 bb2[4] = {{cu.b0.x, cu.b0.y}, {cu.b0.z, cu.b0.w}, {cu.b1.x, cu.b1.y}, {cu.b1.z, cu.b1.w}};
      const float vi = cu.vi;
      f32x2 sa2 = s2[0] * kn2[0];
      sa2 = s2[1] * kn2[1] + sa2; sa2 = s2[2] * kn2[2] + sa2; sa2 = s2[3] * kn2[3] + sa2;
      float sa = sa2.x + sa2.y;
      sa += dpp_x1(sa); sa += dpp_x2(sa); sa += dpp_hm(sa);
      const f32x2 nsa = {-sa, -sa}, vv = {vi, vi};
      f32x2 o2 = {0.f, 0.f};
#pragma unroll
      for (int j = 0; j < 4; ++j) {
        s2[j] = vv * kp2[j] + (nsa * bb2[j] + s2[j] * ww2[j]);
        o2 = s2[j] * rr2[j] + o2;
      }
      float o = o2.x + o2.y;
      o += dpp_x1(o); o += dpp_x2(o); o += dpp_hm(o);
      if (jq == 0) obuf[t * 32 + ii] = o;
      cu = nx;
    }
    __syncthreads();
    {
      const int ot = tid >> 3, oc = (tid & 7) * 4;
      const float4 ov = *(const float4*)(obuf + ot * 32 + oc);
      st_bf4(O2 + (size_t)(row0 + c * 32 + ot) * 1024 + head * 64 + ih * 32 + oc, ov.x, ov.y, ov.z, ov.w);
    }
  }
  {
    float* so = p.out + (seq < 16 ? O_PR : O_SR) + soff;
#pragma unroll
    for (int j = 0; j < 4; ++j) { so[2 * j] = s2[j].x; so[2 * j + 1] = s2[j].y; }
  }
  __syncthreads();
}
DI void phase11(const Params& p, unsigned char* smem) {
  for (int u = blockIdx.x; u < 1024; u += gridDim.x) {
    const int uu = u & 511;
    rwkv_unit(p, (uu & 15) + (u >= 512 ? 16 : 0), (uu >> 4) & 15, uu >> 8, smem);
  }
}

DI void phase12(const Params& p) {
  unsigned char* ws = p.ws;
  const int lane = threadIdx.x & 63, gw = blockIdx.x * 4 + (threadIdx.x >> 6), nw = gridDim.x * 4;
  const bf16_t* O2 = (const bf16_t*)(ws + OFF_ORAW2); const bf16_t* V = (const bf16_t*)(ws + OFF_V); const bf16_t* GG = (const bf16_t*)(ws + OFF_GG);
  const float* BON = (const float*)(ws + OFF_BON);
  bf16_t* A5 = (bf16_t*)(ws + OFF_A5);
  float lg[16], lb[16];
#pragma unroll
  for (int i = 0; i < 16; ++i) { lg[i] = p.in[I_LNG][lane * 16 + i]; lb[i] = p.in[I_LNB][lane * 16 + i]; }
  for (int row = gw; row < NT; row += nw) {
    const size_t o = (size_t)row * 1024 + lane * 16;
    float ov[16], vv[16], gg[16];
    unpack8(*(const u32x4*)(O2 + o), ov); unpack8(*(const u32x4*)(O2 + o + 8), ov + 8);
    unpack8(*(const u32x4*)(V + o), vv); unpack8(*(const u32x4*)(V + o + 8), vv + 8);
    unpack8(*(const u32x4*)(GG + o), gg); unpack8(*(const u32x4*)(GG + o + 8), gg + 8);
    const float bon = BON[(size_t)row * 16 + (lane >> 2)];
    float sm = 0.f;
#pragma unroll
    for (int i = 0; i < 16; ++i) sm += ov[i];
    sm += __shfl_xor(sm, 1); sm += __shfl_xor(sm, 2);
    const float mean = sm * (1.f / 64.f);
    float sq = 0.f;
#pragma unroll
    for (int i = 0; i < 16; ++i) { const float d = ov[i] - mean; sq += d * d; }
    sq += __shfl_xor(sq, 1); sq += __shfl_xor(sq, 2);
    const float rs = rsqrtf(sq * (1.f / 64.f) + 64e-5f);
    float r[16];
#pragma unroll
    for (int i = 0; i < 16; ++i) r[i] = ((ov[i] - mean) * rs * lg[i] + lb[i] + bon * vv[i]) * gg[i];
    *(u32x4*)(A5 + o) = pack8(r); *(u32x4*)(A5 + o + 8) = pack8(r + 8);
  }
}

DI void phase13(const Params& p, unsigned char* smem) {
  cvt_fp8_rows(p.in[I_PU] + (size_t)16384 * 1024, p.ws + OFF_U8, (float*)(p.ws + OFF_USC));
  cvt_fp8_rows(p.in[I_PV] + (size_t)16384 * 1024, p.ws + OFF_V8, (float*)(p.ws + OFF_VSC));
  phase_outproj(p, smem, OFF_A5, OFF_WT_OUTC, false);
}

template <int PH>
DI void run_phase(const Params& p, unsigned char* smem) {
  if (PH == 0) phase0(p, smem);
  else if (PH == 1) phase1(p, smem);
  else if (PH == 2) phase2(p, smem);
  else if (PH == 3) phase3(p, smem);
  else if (PH == 4) phase_outproj(p, smem, OFF_HA, OFF_WT_OUTAB, true);
  else if (PH == 5) phase_norm2(p, 0);
  else if (PH == 6) phase_qp(p, smem, 0);
  else if (PH == 7) phase_route(p, smem, 0);
  else if (PH == 8) phase_peer_u(p);
  else if (PH == 9) phase_peer_act(p);
  else if (PH == 10) phase_peer_v(p);
  else if (PH == 11) phase_peer_norm(p, 0);
  else if (PH == 12) phase9(p, smem);
  else if (PH == 13) phase10(p, smem);
  else if (PH == 14) phase11(p, smem);
  else if (PH == 15) phase12(p);
  else if (PH == 16) phase13(p, smem);
  else if (PH == 17) phase_norm2(p, 1);
  else if (PH == 18) phase_qp(p, smem, 1);
  else if (PH == 19) phase_route(p, smem, 1);
  else if (PH == 20) phase_peer_u(p);
  else if (PH == 21) phase_peer_act(p);
  else if (PH == 22) phase_peer_v(p);
  else if (PH == 23) phase_peer_norm(p, 1);
  else if (PH == 24) phase_pre(p, smem);
}

template <int PH>
__global__ void __launch_bounds__(256, 2) k_phase(Params p) {
  extern __shared__ __attribute__((aligned(16))) unsigned char smem[];
  run_phase<PH>(p, smem);
}

#ifndef PROBE_MASK
#define PROBE_MASK 0u
#endif
DI void grid_barrier(unsigned* cnt, unsigned target) {
  asm volatile("s_waitcnt vmcnt(0) lgkmcnt(0)" ::: "memory");
  __syncthreads();
  if (threadIdx.x == 0) {
    __builtin_amdgcn_fence(__ATOMIC_RELEASE, "agent");
    asm volatile("s_waitcnt vmcnt(0)" ::: "memory");
    __hip_atomic_fetch_add(cnt, 1u, __ATOMIC_RELAXED, __HIP_MEMORY_SCOPE_AGENT);
    while (__hip_atomic_load(cnt, __ATOMIC_RELAXED, __HIP_MEMORY_SCOPE_AGENT) < target) __builtin_amdgcn_s_sleep(1);
    __builtin_amdgcn_fence(__ATOMIC_ACQUIRE, "agent");
    asm volatile("s_waitcnt vmcnt(0)" ::: "memory");
  }
  __syncthreads();
}
template <int PH>
DI void mega_step(const Params& p, unsigned char* smem, cg::grid_group& grid, unsigned& nb, bool last) {
  run_phase<PH>(p, smem);
  if ((PROBE_MASK >> PH) & 1u) { grid.sync(); run_phase<PH>(p, smem); }
  if (!last) {
    if (PH == 0) grid.sync();
    else { ++nb; grid_barrier((unsigned*)(p.ws + OFF_GBAR), nb * gridDim.x); }
  }
}
__global__ void __launch_bounds__(256, 2) k_mega(Params p) {
  extern __shared__ __attribute__((aligned(16))) unsigned char smem[];
  cg::grid_group grid = cg::this_grid();
  unsigned nb = 0;
  mega_step<0>(p, smem, grid, nb, false); mega_step<1>(p, smem, grid, nb, false); mega_step<24>(p, smem, grid, nb, false); mega_step<2>(p, smem, grid, nb, false); mega_step<3>(p, smem, grid, nb, false);
  mega_step<4>(p, smem, grid, nb, false); mega_step<5>(p, smem, grid, nb, false); mega_step<6>(p, smem, grid, nb, false); mega_step<7>(p, smem, grid, nb, false);
  mega_step<8>(p, smem, grid, nb, false); mega_step<9>(p, smem, grid, nb, false); mega_step<10>(p, smem, grid, nb, false); mega_step<11>(p, smem, grid, nb, false);
  mega_step<12>(p, smem, grid, nb, false); mega_step<13>(p, smem, grid, nb, false); mega_step<14>(p, smem, grid, nb, false); mega_step<15>(p, smem, grid, nb, false);
  mega_step<16>(p, smem, grid, nb, false); mega_step<17>(p, smem, grid, nb, false); mega_step<18>(p, smem, grid, nb, false); mega_step<19>(p, smem, grid, nb, false);
  mega_step<20>(p, smem, grid, nb, false); mega_step<21>(p, smem, grid, nb, false); mega_step<22>(p, smem, grid, nb, false); mega_step<23>(p, smem, grid, nb, true);
}

template <int PH>
static void launch_phase(const Params& p, int grid, hipStream_t stream) {
  static bool attr = false;
  if (!attr) { hipFuncSetAttribute((const void*)k_phase<PH>, hipFuncAttributeMaxDynamicSharedMemorySize, LDS_BYTES); attr = true; }
  hipLaunchKernelGGL(k_phase<PH>, dim3(grid), dim3(256), LDS_BYTES, stream, p);
}

extern "C" void kernel_launch(void* const* d_in, const int* in_sizes, int n_in, void* d_out, int out_size, void* d_ws, size_t ws_size, hipStream_t stream) {
  Params p{};
  for (int i = 0; i < 36; ++i) p.in[i] = (const float*)d_in[i];
  p.out = (float*)d_out; p.ws = (unsigned char*)d_ws;
  if (ws_size < WS_END) { fprintf(stderr, "workspace too small: %zu < %zu\n", ws_size, (size_t)WS_END); return; }
#if MEGA
  static int grid_blocks = 0;
  if (!grid_blocks) {
    hipFuncSetAttribute((const void*)k_mega, hipFuncAttributeMaxDynamicSharedMemorySize, LDS_BYTES);
    int dev = 0, cus = 0, per_cu = 0;
    hipGetDevice(&dev);
    hipDeviceGetAttribute(&cus, hipDeviceAttributeMultiprocessorCount, dev);
    hipOccupancyMaxActiveBlocksPerMultiprocessor(&per_cu, k_mega, 256, LDS_BYTES);
    if (per_cu > 2) per_cu = 2;
    if (per_cu < 1) per_cu = 1;
    grid_blocks = cus * per_cu;
  }
  hipMemsetAsync((unsigned char*)d_ws + OFF_GBAR, 0, 256, stream);
  void* args[] = {&p};
  hipError_t e = hipLaunchCooperativeKernel((void*)k_mega, dim3(grid_blocks), dim3(256), args, LDS_BYTES, stream);
  if (e != hipSuccess) fprintf(stderr, "cooperative launch failed: %s (grid %d)\n", hipGetErrorString(e), grid_blocks);
#else
  const int grid = 512;
  launch_phase<0>(p, grid, stream); launch_phase<1>(p, grid, stream); launch_phase<24>(p, grid, stream); launch_phase<2>(p, grid, stream); launch_phase<3>(p, grid, stream);
  launch_phase<4>(p, grid, stream); launch_phase<5>(p, grid, stream); launch_phase<6>(p, grid, stream); launch_phase<7>(p, grid, stream);
  launch_phase<8>(p, grid, stream); launch_phase<9>(p, grid, stream); launch_phase<10>(p, grid, stream); launch_phase<11>(p, grid, stream);
  launch_phase<12>(p, grid, stream); launch_phase<13>(p, grid, stream); launch_phase<14>(p, grid, stream); launch_phase<15>(p, grid, stream);
  launch_phase<16>(p, grid, stream); launch_phase<17>(p, grid, stream); launch_phase<18>(p, grid, stream); launch_phase<19>(p, grid, stream);
  launch_phase<20>(p, grid, stream); launch_phase<21>(p, grid, stream); launch_phase<22>(p, grid, stream); launch_phase<23>(p, grid, stream);
#endif
}
```

```cpp
#include <hip/hip_runtime.h>
#include <hip/hip_cooperative_groups.h>
#include <cstdio>
namespace cg = cooperative_groups;

#ifndef MEGA
#define MEGA 1
#endif

#define DI __device__ __forceinline__
typedef unsigned short bf16_t;
typedef short bf16x8 __attribute__((ext_vector_type(8)));
typedef float f32x16 __attribute__((ext_vector_type(16)));
typedef _Float16 half8 __attribute__((ext_vector_type(8)));
typedef unsigned u32x4 __attribute__((ext_vector_type(4)));
typedef unsigned u32x2 __attribute__((ext_vector_type(2)));
typedef float f32x2 __attribute__((ext_vector_type(2)));

constexpr int NT = 66048;
constexpr int NPR = 65536;
constexpr size_t U = (size_t)NT * 1024 * 2;
constexpr int LDS_BYTES = 77824;

constexpr size_t S0 = 0, S1 = U, S2 = 2 * U, S3 = 3 * U, S4 = 4 * U, S5 = 5 * U, S6 = 6 * U;
constexpr size_t OFF_HA = S0;
constexpr size_t OFF_QA = S1, OFF_F = S1 + U / 2, OFF_VA = S1 + U / 2 + U, OFF_GA = S1 + 2 * U, OFF_QB = S1 + 2 * U + U / 2,
                 OFF_KB = OFF_QB + U / 4, OFF_VB = S1 + 3 * U, OFF_GB = OFF_VB + U / 2, OFF_LR = S1 + 4 * U;
constexpr size_t OFF_ORAW = S6;
constexpr size_t OFF_EBL = S5 + (size_t)8 * 1024 * 1024, OFF_KTA = S5 + U / 4, OFF_KTB = OFF_KTA + U / 2;
constexpr size_t OFF_QP = S1;
constexpr size_t OFF_EIDX = S3, OFF_GATE = S3 + U / 4;
constexpr size_t OFF_HP = S1, OFF_SSP = S4;
constexpr size_t OFF_R = S1, OFF_K = S2, OFF_V = S3, OFF_DEC = S4, OFF_AA = S5, OFF_GG = S6, OFF_ORAW2 = S0, OFF_A5 = S4;
constexpr size_t OFF_TAB = 7 * U;
constexpr size_t TAB_BYTES = (size_t)16384 * 1024 * 2;
constexpr size_t OFF_U8 = OFF_TAB, OFF_V8 = OFF_TAB + (size_t)16384 * 1024, OFF_USC = OFF_V8 + (size_t)16384 * 1024, OFF_VSC = OFF_USC + 65536;
constexpr size_t OFF_W1 = OFF_TAB, OFF_A1 = OFF_W1 + (size_t)NT * 64 * 2, OFF_G1 = OFF_A1 + (size_t)NT * 64 * 2,
                 OFF_BON = OFF_G1 + (size_t)NT * 128 * 2;
constexpr size_t OFF_W = OFF_TAB + 2 * TAB_BYTES;
constexpr size_t OFF_WT_IN = OFF_W;
constexpr size_t OFF_WT_OUTAB = OFF_WT_IN + (size_t)3712 * 1024 * 2;
constexpr size_t OFF_WT_RK = OFF_WT_OUTAB + (size_t)1024 * 1024 * 2;
constexpr size_t OFF_WT_W2 = OFF_WT_RK + (size_t)3456 * 1024 * 2;
constexpr size_t OFF_WT_A2 = OFF_WT_W2 + (size_t)1024 * 64 * 2;
constexpr size_t OFF_WT_G2 = OFF_WT_A2 + (size_t)1024 * 64 * 2;
constexpr size_t OFF_WT_OUTC = OFF_WT_G2 + (size_t)1024 * 128 * 2;
constexpr size_t OFF_WT_Q = OFF_WT_OUTC + (size_t)1024 * 1024 * 2;
constexpr size_t OFF_SK = OFF_WT_Q + (size_t)2 * 2048 * 1024 * 2;
constexpr size_t OFF_LBS = OFF_SK + (size_t)2 * 16 * 128 * 128 * 2;
constexpr size_t OFF_GBAR = OFF_LBS + 2048;
constexpr size_t WS_END = OFF_GBAR + 256;

constexpr size_t O_PH = 67633152, O_PG = 68681728, O_PR = 69206016, O_PS = 70254592,
                 O_SH = 70270976, O_SG = 71319552, O_SR = 71843840, O_SS = 72892416;

struct Params { const float* in[36]; float* out; unsigned char* ws; };

enum { I_XP = 0, I_XS, I_SH, I_SG, I_SR, I_SS, I_WIN, I_LB, I_HNG, I_GW2, I_GB, I_GNG, I_WOUTAB, I_MU, I_WRKV, I_WW1, I_WW2, I_W0,
       I_AW1, I_AW2, I_A0, I_GW1, I_GWW2, I_KK, I_KA, I_RK, I_LNG, I_LNB, I_WOUTC, I_N1, I_N2, I_FG, I_PWQ, I_PSK, I_PU, I_PV };

DI float bf2f(bf16_t u) { return __uint_as_float(((unsigned)u) << 16); }
DI unsigned pack2(float lo, float hi) { unsigned r; asm("v_cvt_pk_bf16_f32 %0, %1, %2" : "=v"(r) : "v"(lo), "v"(hi)); return r; }
DI bf16_t f2bf(float x) { return (bf16_t)(pack2(x, 0.f) & 0xffffu); }
DI float lo2f(unsigned p) { return __uint_as_float(p << 16); }
DI float hi2f(unsigned p) { return __uint_as_float(p & 0xffff0000u); }
DI void unpack8(const u32x4& q, float* f) { f[0] = lo2f(q.x); f[1] = hi2f(q.x); f[2] = lo2f(q.y); f[3] = hi2f(q.y); f[4] = lo2f(q.z); f[5] = hi2f(q.z); f[6] = lo2f(q.w); f[7] = hi2f(q.w); }
DI u32x4 pack8(const float* f) { u32x4 q; q.x = pack2(f[0], f[1]); q.y = pack2(f[2], f[3]); q.z = pack2(f[4], f[5]); q.w = pack2(f[6], f[7]); return q; }
DI float sigmoidf_(float x) { return 1.f / (1.f + __expf(-x)); }
DI float siluf_(float x) { return x / (1.f + __expf(-x)); }
DI float wave_sum(float v) {
  v += __uint_as_float(__builtin_amdgcn_update_dpp(0, __float_as_uint(v), 0xB1, 0xF, 0xF, true));
  v += __uint_as_float(__builtin_amdgcn_update_dpp(0, __float_as_uint(v), 0x4E, 0xF, 0xF, true));
  v += __uint_as_float(__builtin_amdgcn_update_dpp(0, __float_as_uint(v), 0x141, 0xF, 0xF, true));
  v += __uint_as_float(__builtin_amdgcn_update_dpp(0, __float_as_uint(v), 0x140, 0xF, 0xF, true));
  v += __uint_as_float(__builtin_amdgcn_update_dpp(0, __float_as_uint(v), 0x142, 0xA, 0xF, false));
  v += __uint_as_float(__builtin_amdgcn_update_dpp(0, __float_as_uint(v), 0x143, 0xC, 0xF, false));
  return __uint_as_float(__builtin_amdgcn_readlane(__float_as_uint(v), 63));
}
DI int crow(int reg, int h) { return (reg & 3) + 8 * (reg >> 2) + 4 * h; }
#define MFMA(a, b, c) __builtin_amdgcn_mfma_f32_32x32x16_bf16((a), (b), (c), 0, 0, 0)

DI int seq_row0(int s) { return s < 16 ? s * 4096 : NPR + (s - 16) * 32; }
DI int seq_len(int s) { return s < 16 ? 4096 : 32; }

struct LoadBf16 {
  const bf16_t* A; int lda;
  DI void stage(int row, int k, u32x4& a, u32x4& b) const { a = *(const u32x4*)(A + (size_t)row * lda + k); (void)b; }
  DI u32x4 finish(const u32x4& a, const u32x4& b, int k) const { return a; }
};
struct LoadShiftMix {
  const bf16_t* H; const float* mu; const float* xlast;
  DI void stage(int row, int k, u32x4& a, u32x4& b) const {
    a = *(const u32x4*)(H + (size_t)row * 1024 + k);
    const bool first = row < NPR ? ((row & 4095) == 0) : (((row - NPR) & 31) == 0);
    if (!first) b = *(const u32x4*)(H + (size_t)(row - 1) * 1024 + k);
    else if (row >= NPR) {
      const float* xl = xlast + (size_t)((row - NPR) >> 5) * 1024 + k;
      const float4 x0 = *(const float4*)xl, x1 = *(const float4*)(xl + 4);
      const float pv[8] = {x0.x, x0.y, x0.z, x0.w, x1.x, x1.y, x1.z, x1.w};
      b = pack8(pv);
    } else b = (u32x4){0u, 0u, 0u, 0u};
  }
  DI u32x4 finish(const u32x4& a, const u32x4& b, int k) const {
    float hv[8], pv[8], o[8];
    unpack8(a, hv); unpack8(b, pv);
    const float4 m0 = *(const float4*)(mu + k), m1 = *(const float4*)(mu + k + 4);
    const float mv[8] = {m0.x, m0.y, m0.z, m0.w, m1.x, m1.y, m1.z, m1.w};
#pragma unroll
    for (int i = 0; i < 8; ++i) o[i] = hv[i] + (pv[i] - hv[i]) * mv[i];
    return pack8(o);
  }
};

template <int BK, class AL>
DI void gemm_tile(const AL& al, const bf16_t* __restrict__ Bt, int ldb, int K, int m0, int n0, f32x16 (&acc)[2][2], bf16_t* As) {
  constexpr int LDK = BK + 8, CPR = BK / 8, NL = BK / 16, RSTEP = 256 / CPR;
  bf16_t* Bs = As + 128 * LDK;
  const int tid = threadIdx.x, lane = tid & 63, w = tid >> 6, wm = w >> 1, wn = w & 1;
#pragma unroll
  for (int mi = 0; mi < 2; ++mi)
#pragma unroll
    for (int ni = 0; ni < 2; ++ni)
#pragma unroll
      for (int r = 0; r < 16; ++r) acc[mi][ni][r] = 0.f;
  u32x4 ra[NL], ra2[NL], rb[NL];
  const int lr = tid / CPR, lk = (tid % CPR) * 8;
#pragma unroll
  for (int j = 0; j < NL; ++j) { al.stage(m0 + lr + RSTEP * j, lk, ra[j], ra2[j]); rb[j] = *(const u32x4*)(Bt + (size_t)(n0 + lr + RSTEP * j) * ldb + lk); }
  const int nk = K / BK;
  const int frow = lane & 31, fk = (lane >> 5) * 8;
  for (int kt = 0; kt < nk; ++kt) {
    __syncthreads();
#pragma unroll
    for (int j = 0; j < NL; ++j) { *(u32x4*)(As + (lr + RSTEP * j) * LDK + lk) = al.finish(ra[j], ra2[j], kt * BK + lk); *(u32x4*)(Bs + (lr + RSTEP * j) * LDK + lk) = rb[j]; }
    __syncthreads();
    if (kt + 1 < nk) {
      const int k0 = (kt + 1) * BK;
#pragma unroll
      for (int j = 0; j < NL; ++j) { al.stage(m0 + lr + RSTEP * j, k0 + lk, ra[j], ra2[j]); rb[j] = *(const u32x4*)(Bt + (size_t)(n0 + lr + RSTEP * j) * ldb + k0 + lk); }
    }
    __builtin_amdgcn_sched_barrier(0);
#pragma unroll
    for (int kk = 0; kk < BK / 16; ++kk) {
      bf16x8 af[2], bfr[2];
#pragma unroll
      for (int mi = 0; mi < 2; ++mi) af[mi] = *(const bf16x8*)(As + (wm * 64 + mi * 32 + frow) * LDK + kk * 16 + fk);
#pragma unroll
      for (int ni = 0; ni < 2; ++ni) bfr[ni] = *(const bf16x8*)(Bs + (wn * 64 + ni * 32 + frow) * LDK + kk * 16 + fk);
#pragma unroll
      for (int mi = 0; mi < 2; ++mi)
#pragma unroll
        for (int ni = 0; ni < 2; ++ni) acc[mi][ni] = MFMA(bfr[ni], af[mi], acc[mi][ni]);
    }
  }
}

template <class AL>
DI void gemm_tile_db(const AL& al, const bf16_t* __restrict__ Bt, int ldb, int K, int m0, int n0, f32x16 (&acc)[2][2], bf16_t* smem) {
  constexpr int LDK = 72, TB = 128 * LDK;
  const int tid = threadIdx.x, lane = tid & 63, w = tid >> 6, wm = w >> 1, wn = w & 1;
#pragma unroll
  for (int mi = 0; mi < 2; ++mi)
#pragma unroll
    for (int ni = 0; ni < 2; ++ni)
#pragma unroll
      for (int r = 0; r < 16; ++r) acc[mi][ni][r] = 0.f;
  u32x4 ra0[4], rc0[4], rb0[4], ra1[4], rc1[4], rb1[4];
  const int lr = tid >> 3, lk = (tid & 7) * 8;
  const int nk = K >> 6;
  const int frow = lane & 31, fk = (lane >> 5) * 8;
  const bf16_t* Bp = Bt + (size_t)(n0 + lr) * ldb + lk;
#define GDB_STAGE(RA, RC, RB, kt_)                                                                                     \
  {                                                                                                                    \
    _Pragma("unroll") for (int j = 0; j < 4; ++j) {                                                                    \
      al.stage(m0 + lr + 32 * j, (kt_) * 64 + lk, RA[j], RC[j]);                                                       \
      RB[j] = *(const u32x4*)(Bp + (size_t)(32 * j) * ldb + (kt_) * 64);                                               \
    }                                                                                                                  \
  }
#define GDB_WRITE(RA, RC, RB, kt_, buf_)                                                                               \
  {                                                                                                                    \
    bf16_t* Aw = smem + (buf_) * 2 * TB; bf16_t* Bw = Aw + TB;                                                         \
    _Pragma("unroll") for (int j = 0; j < 4; ++j) {                                                                    \
      *(u32x4*)(Aw + (lr + 32 * j) * LDK + lk) = al.finish(RA[j], RC[j], (kt_) * 64 + lk);                            \
      *(u32x4*)(Bw + (lr + 32 * j) * LDK + lk) = RB[j];                                                                \
    }                                                                                                                  \
  }
#define GDB_KK(buf_, kk_)                                                                                              \
  {                                                                                                                    \
    const bf16_t* Ar = smem + (buf_) * 2 * TB; const bf16_t* Br = Ar + TB;                                             \
    bf16x8 af[2], bfr[2];                                                                                              \
    _Pragma("unroll") for (int mi = 0; mi < 2; ++mi) af[mi] = *(const bf16x8*)(Ar + (wm * 64 + mi * 32 + frow) * LDK + (kk_) * 16 + fk);  \
    _Pragma("unroll") for (int ni = 0; ni < 2; ++ni) bfr[ni] = *(const bf16x8*)(Br + (wn * 64 + ni * 32 + frow) * LDK + (kk_) * 16 + fk); \
    _Pragma("unroll") for (int mi = 0; mi < 2; ++mi)                                                                   \
      _Pragma("unroll") for (int ni = 0; ni < 2; ++ni) acc[mi][ni] = MFMA(bfr[ni], af[mi], acc[mi][ni]);               \
  }
#define GDB_LD(AF, BF, buf_, kk_)                                                                                      \
  {                                                                                                                    \
    const bf16_t* Ar = smem + (buf_) * 2 * TB; const bf16_t* Br = Ar + TB;                                             \
    _Pragma("unroll") for (int mi = 0; mi < 2; ++mi) AF[mi] = *(const bf16x8*)(Ar + (wm * 64 + mi * 32 + frow) * LDK + (kk_) * 16 + fk);  \
    _Pragma("unroll") for (int ni = 0; ni < 2; ++ni) BF[ni] = *(const bf16x8*)(Br + (wn * 64 + ni * 32 + frow) * LDK + (kk_) * 16 + fk);  \
  }
#define GDB_MM(AF, BF)                                                                                                 \
  {                                                                                                                    \
    _Pragma("unroll") for (int mi = 0; mi < 2; ++mi)                                                                   \
      _Pragma("unroll") for (int ni = 0; ni < 2; ++ni) acc[mi][ni] = MFMA(BF[ni], AF[mi], acc[mi][ni]);                \
  }
#define GDB_ITER(kt_, cur_, RAn, RCn, RBn)                                                                             \
  {                                                                                                                    \
    bf16x8 fa0[2], fb0[2], fa1[2], fb1[2];                                                                             \
    GDB_LD(fa0, fb0, cur_, 0)                                                                                          \
    GDB_LD(fa1, fb1, cur_, 1)                                                                                          \
    __builtin_amdgcn_sched_barrier(0);                                                                                 \
    GDB_MM(fa0, fb0)                                                                                                   \
    if ((kt_) + 1 < nk) GDB_WRITE(RAn, RCn, RBn, (kt_) + 1, (cur_) ^ 1)                                                \
    if ((kt_) + 3 < nk) GDB_STAGE(RAn, RCn, RBn, (kt_) + 3)                                                            \
    GDB_LD(fa0, fb0, cur_, 2)                                                                                          \
    GDB_MM(fa1, fb1)                                                                                                   \
    GDB_LD(fa1, fb1, cur_, 3)                                                                                          \
    GDB_MM(fa0, fb0)                                                                                                   \
    GDB_MM(fa1, fb1)                                                                                                   \
    __syncthreads();                                                                                                   \
  }
  GDB_STAGE(ra0, rc0, rb0, 0)
  if (nk > 1) GDB_STAGE(ra1, rc1, rb1, 1)
  __syncthreads();
  GDB_WRITE(ra0, rc0, rb0, 0, 0)
  if (nk > 2) GDB_STAGE(ra0, rc0, rb0, 2)
  __syncthreads();
  for (int kt = 0; kt < nk; kt += 2) {
    GDB_ITER(kt, 0, ra1, rc1, rb1)
    if (kt + 1 < nk) GDB_ITER(kt + 1, 1, ra0, rc0, rb0)
  }
#undef GDB_STAGE
#undef GDB_WRITE
#undef GDB_KK
#undef GDB_ITER
#undef GDB_LD
#undef GDB_MM
}

template <class E>
DI void epilogue(const f32x16 (&acc)[2][2], int m0, int n0, E&& e, float* Cs) {
  const int tid = threadIdx.x, lane = tid & 63, w = tid >> 6, wm = w >> 1, wn = w & 1;
  __syncthreads();
#pragma unroll
  for (int mi = 0; mi < 2; ++mi)
#pragma unroll
    for (int ni = 0; ni < 2; ++ni)
#pragma unroll
      for (int g = 0; g < 4; ++g) {
        const int row = wm * 64 + mi * 32 + (lane & 31);
        const int col = wn * 64 + ni * 32 + 8 * g + 4 * (lane >> 5);
        *(float4*)(Cs + row * 132 + col) = make_float4(acc[mi][ni][4 * g], acc[mi][ni][4 * g + 1], acc[mi][ni][4 * g + 2], acc[mi][ni][4 * g + 3]);
      }
  __syncthreads();
#pragma unroll 4
  for (int it = 0; it < 16; ++it) {
    const int idx = tid + 256 * it, row = idx >> 5, col = (idx & 31) * 4;
    const float4 v = *(const float4*)(Cs + row * 132 + col);
    e(m0 + row, n0 + col, v.x, v.y, v.z, v.w);
  }
}

template <class F>
DI void for_tiles(int nM, int nN, F&& f) {
  const int x = blockIdx.x & 7, s = blockIdx.x >> 3, slots = gridDim.x >> 3;
  const int nFull = nN >> 3, wd = nN & 7, nRG8 = (nM + 7) >> 3, hr = wd ? 64 / wd : 1, cntP = wd ? (nM + hr - 1) / hr : 0;
  const int nSTf = nFull * nRG8, nST = nSTf + cntP;
  for (int e = s;; e += slots) {
    const int st = (e >> 6) * 8 + x;
    if (st >= nST) break;
    const int wi = e & 63;
    int tm, tn; bool ok;
    if (st < nSTf) { const int rg = st / nFull, cgi = st - rg * nFull; tm = rg * 8 + (wi & 7); tn = cgi * 8 + (wi >> 3); ok = tm < nM; }
    else { const int idx = st - nSTf, q = wi / hr; tm = idx * hr + (wi - q * hr); tn = nFull * 8 + q; ok = (q < wd) && (tm < nM); }
    if (ok) f(tm, tn);
  }
}

DI void st_bf4(bf16_t* p, float a, float b, float c, float d) { u32x2 q; q.x = pack2(a, b); q.y = pack2(c, d); *(u32x2*)p = q; }

DI void transpose_cvt(const float* __restrict__ W, int K, int N, bf16_t* __restrict__ Wt, int Npad, float* tile) {
  const int tK = K >> 5, tN = Npad >> 5;
  const int tx = threadIdx.x & 31, ty = threadIdx.x >> 5;
  for (int t = blockIdx.x; t < tK * tN; t += gridDim.x) {
    const int tk = t % tK, tn = t / tK;
    __syncthreads();
#pragma unroll
    for (int i = 0; i < 4; ++i) { const int k = tk * 32 + ty + 8 * i, n = tn * 32 + tx; tile[(ty + 8 * i) * 33 + tx] = (n < N) ? W[(size_t)k * N + n] : 0.f; }
    __syncthreads();
#pragma unroll
    for (int i = 0; i < 4; ++i) { const int n = tn * 32 + ty + 8 * i, k = tk * 32 + tx; Wt[(size_t)n * K + k] = f2bf(tile[tx * 33 + ty + 8 * i]); }
  }
}
DI void cvt_bf16(const float* __restrict__ src, bf16_t* __restrict__ dst, size_t n) {
  const size_t stride = (size_t)gridDim.x * 256 * 8;
  for (size_t i = ((size_t)blockIdx.x * 256 + threadIdx.x) * 8; i < n; i += stride) {
    float4 a = *(const float4*)(src + i), b = *(const float4*)(src + i + 4);
    float f[8] = {a.x, a.y, a.z, a.w, b.x, b.y, b.z, b.w};
    *(u32x4*)(dst + i) = pack8(f);
  }
}

DI void cvt_fp8_rows(const float* __restrict__ src, unsigned char* __restrict__ dst, float* __restrict__ scale) {
  const int lane = threadIdx.x & 63, gw = blockIdx.x * 4 + (threadIdx.x >> 6), nw = gridDim.x * 4;
  for (int row = gw; row < 16384; row += nw) {
    float4 v[4]; float m = 0.f;
#pragma unroll
    for (int j = 0; j < 4; ++j) { v[j] = *(const float4*)(src + (size_t)row * 1024 + lane * 4 + 256 * j); m = fmaxf(m, fmaxf(fmaxf(fabsf(v[j].x), fabsf(v[j].y)), fmaxf(fabsf(v[j].z), fabsf(v[j].w)))); }
    for (int o = 32; o > 0; o >>= 1) m = fmaxf(m, __shfl_xor(m, o));
    const float sc = m > 0.f ? m * (1.f / 224.f) : 1.f, inv = 1.f / sc;
#pragma unroll
    for (int j = 0; j < 4; ++j) {
      int q = 0;
      q = __builtin_amdgcn_cvt_pk_fp8_f32(v[j].x * inv, v[j].y * inv, q, false);
      q = __builtin_amdgcn_cvt_pk_fp8_f32(v[j].z * inv, v[j].w * inv, q, true);
      *(int*)(dst + ((size_t)(2 * j + (lane >> 5)) * 16384 + row) * 128 + ((lane * 4) & 127)) = q;
    }
    if (lane == 0) scale[row] = sc;
  }
}
DI void rmsnorm_rows(const Params& p, const float* __restrict__ X, bool from_input, const float* __restrict__ g, bf16_t* __restrict__ out) {
  const int lane = threadIdx.x & 63, gw = blockIdx.x * 4 + (threadIdx.x >> 6), nw = gridDim.x * 4;
  float4 gv[4];
#pragma unroll
  for (int j = 0; j < 4; ++j) gv[j] = *(const float4*)(g + lane * 4 + 256 * j);
  for (int row = gw; row < NT; row += nw) {
    const float* xr;
    if (from_input) xr = row < NPR ? p.in[I_XP] + (size_t)row * 1024 : p.in[I_XS] + (size_t)(row - NPR) * 1024;
    else xr = X + (size_t)row * 1024;
    float4 v[4]; float ss = 0.f;
#pragma unroll
    for (int j = 0; j < 4; ++j) { v[j] = *(const float4*)(xr + lane * 4 + 256 * j); ss += v[j].x * v[j].x + v[j].y * v[j].y + v[j].z * v[j].z + v[j].w * v[j].w; }
    ss = wave_sum(ss);
    const float rs = rsqrtf(ss * (1.f / 1024.f) + 1e-6f);
#pragma unroll
    for (int j = 0; j < 4; ++j) st_bf4(out + (size_t)row * 1024 + lane * 4 + 256 * j, v[j].x * rs * gv[j].x, v[j].y * rs * gv[j].y, v[j].z * rs * gv[j].z, v[j].w * rs * gv[j].w);
  }
}

DI void phase0(const Params& p, unsigned char* smem) {
  float* tile = (float*)smem;
  unsigned char* ws = p.ws;
  transpose_cvt(p.in[I_WIN], 1024, 3600, (bf16_t*)(ws + OFF_WT_IN), 3712, tile);
  transpose_cvt(p.in[I_WOUTAB], 1024, 1024, (bf16_t*)(ws + OFF_WT_OUTAB), 1024, tile);
  bf16_t* wrk = (bf16_t*)(ws + OFF_WT_RK);
  for (int i = 0; i < 3; ++i) transpose_cvt(p.in[I_WRKV] + (size_t)i * 1024 * 1024, 1024, 1024, wrk + (size_t)i * 1024 * 1024, 1024, tile);
  transpose_cvt(p.in[I_WW1], 1024, 64, wrk + (size_t)3072 * 1024, 128, tile);
  transpose_cvt(p.in[I_AW1], 1024, 64, wrk + (size_t)3200 * 1024, 128, tile);
  transpose_cvt(p.in[I_GW1], 1024, 128, wrk + (size_t)3328 * 1024, 128, tile);
  transpose_cvt(p.in[I_WW2], 64, 1024, (bf16_t*)(ws + OFF_WT_W2), 1024, tile);
  transpose_cvt(p.in[I_AW2], 64, 1024, (bf16_t*)(ws + OFF_WT_A2), 1024, tile);
  transpose_cvt(p.in[I_GWW2], 128, 1024, (bf16_t*)(ws + OFF_WT_G2), 1024, tile);
  transpose_cvt(p.in[I_WOUTC], 1024, 1024, (bf16_t*)(ws + OFF_WT_OUTC), 1024, tile);
  for (int l = 0; l < 2; ++l) transpose_cvt(p.in[I_PWQ] + (size_t)l * 1024 * 2048, 1024, 2048, (bf16_t*)(ws + OFF_WT_Q) + (size_t)l * 2048 * 1024, 2048, tile);
  cvt_bf16(p.in[I_PSK], (bf16_t*)(ws + OFF_SK), (size_t)2 * 16 * 128 * 128);
  cvt_fp8_rows(p.in[I_PU], ws + OFF_U8, (float*)(ws + OFF_USC));
  cvt_fp8_rows(p.in[I_PV], ws + OFF_V8, (float*)(ws + OFF_VSC));
  if (blockIdx.x == 0) {
    float* lbs = (float*)(ws + OFF_LBS);
    for (int c = threadIdx.x; c < 512; c += 256) {
      const float a0 = p.in[I_LB][c], a1 = p.in[I_LB][512 + c], a2 = p.in[I_LB][1024 + c];
      const float m = fmaxf(a0, fmaxf(a1, a2));
      const float e0 = expf(a0 - m), e1 = expf(a1 - m), e2 = expf(a2 - m);
      lbs[c] = e0 / (e0 + e1 + e2);
    }
  }
  rmsnorm_rows(p, nullptr, true, p.in[I_N1], (bf16_t*)(ws + OFF_HA));
}

DI void phase1(const Params& p, unsigned char* smem) {
  unsigned char* ws = p.ws;
  bf16_t* As = (bf16_t*)smem;
  const float* lbs = (const float*)(ws + OFF_LBS);
  bf16_t* QA = (bf16_t*)(ws + OFF_QA); float* F = (float*)(ws + OFF_F); bf16_t* VA = (bf16_t*)(ws + OFF_VA); bf16_t* GA = (bf16_t*)(ws + OFF_GA);
  bf16_t* QB = (bf16_t*)(ws + OFF_QB); bf16_t* KB = (bf16_t*)(ws + OFF_KB); bf16_t* VB = (bf16_t*)(ws + OFF_VB); bf16_t* GB = (bf16_t*)(ws + OFF_GB);
  float* LR = (float*)(ws + OFF_LR);
  for_tiles(NT / 128, 29, [&](int tm, int tn) {
    f32x16 acc[2][2];
    gemm_tile_db(LoadBf16{(const bf16_t*)(ws + OFF_HA), 1024}, (const bf16_t*)(ws + OFF_WT_IN), 1024, 1024, tm * 128, tn * 128, acc, As);
    epilogue(acc, tm * 128, tn * 128, [&](int row, int col, float a, float b, float c, float d) {
      if (col < 512) st_bf4(QA + (size_t)row * 512 + col, siluf_(a), siluf_(b), siluf_(c), siluf_(d));
      else if (col < 1024) {
        const int cc = col - 512; const float4 lb = *(const float4*)(lbs + cc);
        float4 o; o.x = lb.x + (1.f - lb.x) * sigmoidf_(a); o.y = lb.y + (1.f - lb.y) * sigmoidf_(b); o.z = lb.z + (1.f - lb.z) * sigmoidf_(c); o.w = lb.w + (1.f - lb.w) * sigmoidf_(d);
        *(float4*)(F + (size_t)row * 512 + cc) = o;
      } else if (col < 1536) st_bf4(VA + (size_t)row * 512 + col - 1024, a, b, c, d);
      else if (col < 2048) st_bf4(GA + (size_t)row * 512 + col - 1536, siluf_(a), siluf_(b), siluf_(c), siluf_(d));
      else if (col < 2304) st_bf4(QB + (size_t)row * 256 + col - 2048, a * 0.125f, b * 0.125f, c * 0.125f, d * 0.125f);
      else if (col < 2560) st_bf4(KB + (size_t)row * 256 + col - 2304, a, b, c, d);
      else if (col < 3072) st_bf4(VB + (size_t)row * 512 + col - 2560, a, b, c, d);
      else if (col < 3088) { float4 o = {a, b, c, d}; *(float4*)(LR + (size_t)row * 16 + col - 3072) = o; }
      else if (col < 3600) st_bf4(GB + (size_t)row * 512 + col - 3088, siluf_(a), siluf_(b), siluf_(c), siluf_(d));
    }, (float*)smem);
  });
}

DI int chunk_index(int seq, int c) { return seq < 16 ? seq * 64 + c : 1024 + (seq - 16); }
template <int K, bool GLA>
DI void pre_unit(const Params& p, int seq, int c, int head, unsigned char* smem) {
  constexpr int NPART = 256 / K, TPER = 64 / NPART;
  unsigned char* ws = p.ws;
  float* part = (float*)smem;
  const int tid = threadIdx.x, k = tid % K, tp = tid / K;
  const int row0 = seq_row0(seq), T = seq_len(seq);
  bf16_t* qsrc; const float* fsrc = nullptr; const bf16_t* ksrc = nullptr; bf16_t* kdst; int ldq;
  float w2c[16]; float gbias = 0.f;
  if (!GLA) {
    qsrc = (bf16_t*)(ws + OFF_QA) + head * 128 + k; fsrc = (const float*)(ws + OFF_F) + head * 128 + k; ldq = 512;
    kdst = (bf16_t*)(ws + OFF_KTA) + head * 128 + k;
#pragma unroll
    for (int r = 0; r < 16; ++r) w2c[r] = 0.f;
  } else {
    qsrc = (bf16_t*)(ws + OFF_QB) + head * 64 + k; ksrc = (const bf16_t*)(ws + OFF_KB) + head * 64 + k; ldq = 256;
    kdst = (bf16_t*)(ws + OFF_KTB) + head * 64 + k;
#pragma unroll
    for (int r = 0; r < 16; ++r) w2c[r] = p.in[I_GW2][r * 256 + head * 64 + k];
    gbias = p.in[I_GB][head * 64 + k];
  }
  const float* LR = (const float*)(ws + OFF_LR);
  struct LD { float4 l0, l1, l2, l3; float f; unsigned short kraw, qraw; };
  auto ld_issue = [&](size_t row, LD& d, bool withq) {
    if (!GLA) d.f = fsrc[row * 512];
    else { const float4* lp = (const float4*)(LR + row * 16); d.l0 = lp[0]; d.l1 = lp[1]; d.l2 = lp[2]; d.l3 = lp[3]; d.kraw = ksrc[row * ldq]; }
    if (withq) d.qraw = qsrc[row * ldq];
  };
  auto ld_eval = [&](const LD& d, float& kval) -> float {
    if (!GLA) { kval = 1.f - d.f; return __logf(d.f); }
    const float x = gbias + d.l0.x * w2c[0] + d.l0.y * w2c[1] + d.l0.z * w2c[2] + d.l0.w * w2c[3] + d.l1.x * w2c[4] + d.l1.y * w2c[5] + d.l1.z * w2c[6] + d.l1.w * w2c[7]
                    + d.l2.x * w2c[8] + d.l2.y * w2c[9] + d.l2.z * w2c[10] + d.l2.w * w2c[11] + d.l3.x * w2c[12] + d.l3.y * w2c[13] + d.l3.z * w2c[14] + d.l3.w * w2c[15];
    kval = bf2f(d.kraw);
    return (fminf(x, 0.f) - log1pf(__expf(-fabsf(x)))) * (1.f / 16.f);
  };
  constexpr int BT = GLA ? 4 : 16;
  float run = 0.f;
#pragma unroll
  for (int t0 = 0; t0 < TPER; t0 += BT) {
    LD ld[BT];
#pragma unroll
    for (int u = 0; u < BT; ++u) { const int ta = c * 64 + tp * TPER + t0 + u; ld_issue((size_t)(row0 + (ta < T ? ta : 0)), ld[u], false); }
    __builtin_amdgcn_sched_barrier(0);
#pragma unroll
    for (int u = 0; u < BT; ++u) { const int ta = c * 64 + tp * TPER + t0 + u; float kd; const float g = ld_eval(ld[u], kd); run += (ta < T) ? g : 0.f; }
  }
  __syncthreads();
  part[tp * K + k] = run;
  __syncthreads();
  float off = 0.f, tot = 0.f;
#pragma unroll
  for (int pp = 0; pp < NPART; ++pp) { const float v = part[pp * K + k]; tot += v; if (pp < tp) off += v; }
  if (tp == 0) ((float*)(ws + OFF_EBL))[(size_t)chunk_index(seq, c) * 768 + (GLA ? 512 : 0) + head * K + k] = __expf(tot);
  run = off;
#pragma unroll
  for (int t0 = 0; t0 < TPER; t0 += BT) {
    LD ld[BT];
#pragma unroll
    for (int u = 0; u < BT; ++u) { const int ta = c * 64 + tp * TPER + t0 + u; ld_issue((size_t)(row0 + (ta < T ? ta : 0)), ld[u], true); }
    __builtin_amdgcn_sched_barrier(0);
#pragma unroll
    for (int u = 0; u < BT; ++u) {
      const int ta = c * 64 + tp * TPER + t0 + u; const bool valid = ta < T;
      const size_t row = (size_t)(row0 + (valid ? ta : 0));
      float kd; const float g = ld_eval(ld[u], kd);
      run += valid ? g : 0.f;
      if (valid) {
        qsrc[row * ldq] = f2bf(bf2f(ld[u].qraw) * __expf(run));
        kdst[row * ldq] = f2bf(kd * __expf(-run));
      }
    }
  }
}
DI void phase_pre(const Params& p, unsigned char* smem) {
  for (int it = blockIdx.x; it < 1040 * 8; it += gridDim.x) {
    const int kind = it & 1, head = (it >> 1) & 3, ci = it >> 3;
    const int seq = ci < 1024 ? (ci >> 6) : 16 + (ci - 1024), c = ci < 1024 ? (ci & 63) : 0;
    if (kind == 0) pre_unit<128, false>(p, seq, c, head, smem);
    else pre_unit<64, true>(p, seq, c, head, smem);
  }
}

template <int K, bool GLA>
DI void chunk_unit(const Params& p, int seq, int head, int vs, unsigned char* smem) {
  constexpr int KP = K + 8, KT = K / 32, NQ = K / 32, CPR = K / 8;
  unsigned char* ws = p.ws;
  bf16_t* Qs = (bf16_t*)smem;
  bf16_t* Ks = Qs + 64 * KP;
  bf16_t* KsT = Ks + 64 * KP;
  bf16_t* VT = KsT + K * 72;
  bf16_t* Am = VT + 32 * 72;
  bf16_t* ST = Am + 64 * 72;
  float* bl = (float*)(ST + 32 * KP);
  const int tid = threadIdx.x, lane = tid & 63, w = tid >> 6, hh = lane >> 5, l31 = lane & 31;
  const int row0 = seq_row0(seq), T = seq_len(seq), nch = (T + 63) >> 6;
  const bf16_t* qsrc = GLA ? (const bf16_t*)(ws + OFF_QB) + head * 64 : (const bf16_t*)(ws + OFF_QA) + head * 128;
  const bf16_t* ksrc = GLA ? (const bf16_t*)(ws + OFF_KTB) + head * 64 : (const bf16_t*)(ws + OFF_KTA) + head * 128;
  const int ldq = GLA ? 256 : 512;
  const bf16_t* vsrc = (const bf16_t*)(ws + (GLA ? OFF_VB : OFF_VA)) + head * 128 + vs * 32;
  const float* ebl = (const float*)(ws + OFF_EBL) + (GLA ? 512 : 0) + head * K;
  bf16_t* odst = (bf16_t*)(ws + OFF_ORAW) + (GLA ? 512 : 0) + head * 128 + vs * 32;
  f32x16 S;
#pragma unroll
  for (int r = 0; r < 16; ++r) S[r] = 0.f;
  float* sout; const float* sin = nullptr;
  {
    const int b = seq & 15;
    const size_t hoff = GLA ? ((size_t)(b * 4 + head) * 64) * 128 : ((size_t)(b * 4 + head) * 128) * 128;
    sout = p.out + (seq < 16 ? (GLA ? O_PG : O_PH) : (GLA ? O_SG : O_SH)) + hoff + vs * 32;
    if (seq >= 16) sin = p.in[GLA ? I_SG : I_SH] + hoff + vs * 32;
  }
  u32x4 rq[NQ], rk[NQ], rv; float rbl = 1.f;
  auto gload = [&](int c) {
#pragma unroll
    for (int j = 0; j < NQ; ++j) {
      const int cj = tid + 256 * j, t = cj / CPR, k8 = (cj % CPR) * 8, ta = c * 64 + t;
      if (ta < T) { rq[j] = *(const u32x4*)(qsrc + (size_t)(row0 + ta) * ldq + k8); rk[j] = *(const u32x4*)(ksrc + (size_t)(row0 + ta) * ldq + k8); }
      else { rq[j] = (u32x4){0u, 0u, 0u, 0u}; rk[j] = (u32x4){0u, 0u, 0u, 0u}; }
    }
    const int s = tid >> 2, vq = tid & 3, ta = c * 64 + s;
    rv = (u32x4){0u, 0u, 0u, 0u};
    if (ta < T) rv = *(const u32x4*)(vsrc + (size_t)(row0 + ta) * 512 + vq * 8);
    if (tid < K) rbl = ebl[(size_t)chunk_index(seq, c) * 768 + tid];
  };
  gload(0);
  __syncthreads();
  if (w < KT) {
    if (sin) {
#pragma unroll
      for (int r = 0; r < 16; ++r) S[r] = sin[(size_t)(w * 32 + crow(r, hh)) * 128 + l31];
    }
#pragma unroll
    for (int g = 0; g < 4; ++g) st_bf4(ST + l31 * KP + w * 32 + 8 * g + 4 * hh, S[4 * g], S[4 * g + 1], S[4 * g + 2], S[4 * g + 3]);
  }
  for (int c = 0; c < nch; ++c) {
#pragma unroll
    for (int j = 0; j < NQ; ++j) {
      const int cj = tid + 256 * j, t = cj / CPR, k8 = (cj % CPR) * 8;
      *(u32x4*)(Qs + t * KP + k8) = rq[j];
      *(u32x4*)(Ks + t * KP + k8) = rk[j];
      const unsigned kk4[4] = {rk[j].x, rk[j].y, rk[j].z, rk[j].w};
      const int tsw = ((((t >> 3) ^ ((k8 >> 3) & 7)) << 3) | (t & 7));
#pragma unroll
      for (int e = 0; e < 4; ++e) { KsT[(k8 + 2 * e) * 72 + tsw] = (bf16_t)(kk4[e] & 0xffffu); KsT[(k8 + 2 * e + 1) * 72 + tsw] = (bf16_t)(kk4[e] >> 16); }
    }
    {
      const int s = tid >> 2, vq = tid & 3;
      const unsigned qq[4] = {rv.x, rv.y, rv.z, rv.w};
#pragma unroll
      for (int j = 0; j < 4; ++j) { VT[(vq * 8 + 2 * j) * 72 + s] = (bf16_t)(qq[j] & 0xffffu); VT[(vq * 8 + 2 * j + 1) * 72 + s] = (bf16_t)(qq[j] >> 16); }
    }
    if (tid < K) bl[tid] = rbl;
    __syncthreads();
    if (c + 1 < nch) gload(c + 1);
    {
      const int tm = w >> 1, tn = w & 1;
      f32x16 a;
#pragma unroll
      for (int r = 0; r < 16; ++r) a[r] = 0.f;
      if (tn <= tm) {
#pragma unroll
        for (int ks = 0; ks < K / 16; ++ks) {
          const bf16x8 qf = *(const bf16x8*)(Qs + (tm * 32 + l31) * KP + ks * 16 + hh * 8);
          const bf16x8 kf = *(const bf16x8*)(Ks + (tn * 32 + l31) * KP + ks * 16 + hh * 8);
          a = MFMA(kf, qf, a);
        }
      }
      const int t = tm * 32 + l31;
#pragma unroll
      for (int g = 0; g < 4; ++g) {
        const int s0 = tn * 32 + 8 * g + 4 * hh;
        float v0 = (s0 <= t) ? a[4 * g] : 0.f, v1 = (s0 + 1 <= t) ? a[4 * g + 1] : 0.f, v2 = (s0 + 2 <= t) ? a[4 * g + 2] : 0.f, v3 = (s0 + 3 <= t) ? a[4 * g + 3] : 0.f;
        if (tn > tm) { v0 = v1 = v2 = v3 = 0.f; }
        st_bf4(Am + t * 72 + s0, v0, v1, v2, v3);
      }
    }
    if (w < KT) {
#pragma unroll
      for (int ks = 0; ks < 4; ++ks) {
        const bf16x8 af = *(const bf16x8*)(KsT + (w * 32 + l31) * 72 + 8 * ((ks * 2 + hh) ^ (((w * 32 + l31) >> 3) & 7)));
        const bf16x8 bf = *(const bf16x8*)(VT + l31 * 72 + ks * 16 + hh * 8);
        S = MFMA(af, bf, S);
      }
    }
    __syncthreads();
    if (w < 2) {
      f32x16 o;
#pragma unroll
      for (int r = 0; r < 16; ++r) o[r] = 0.f;
#pragma unroll
      for (int ks = 0; ks < 4; ++ks) {
        const bf16x8 af = *(const bf16x8*)(Am + (w * 32 + l31) * 72 + ks * 16 + hh * 8);
        const bf16x8 bf = *(const bf16x8*)(VT + l31 * 72 + ks * 16 + hh * 8);
        o = MFMA(af, bf, o);
      }
#pragma unroll
      for (int ks = 0; ks < K / 16; ++ks) {
        const bf16x8 af = *(const bf16x8*)(Qs + (w * 32 + l31) * KP + ks * 16 + hh * 8);
        const bf16x8 bf = *(const bf16x8*)(ST + l31 * KP + ks * 16 + hh * 8);
        o = MFMA(af, bf, o);
      }
#pragma unroll
      for (int r = 0; r < 16; ++r) {
        const int ta = c * 64 + w * 32 + crow(r, hh);
        if (ta < T) odst[(size_t)(row0 + ta) * 1024 + l31] = f2bf(o[r]);
      }
    }
    __syncthreads();
    if (w < KT) {
#pragma unroll
      for (int r = 0; r < 16; ++r) S[r] *= bl[w * 32 + crow(r, hh)];
#pragma unroll
      for (int g = 0; g < 4; ++g) st_bf4(ST + l31 * KP + w * 32 + 8 * g + 4 * hh, S[4 * g], S[4 * g + 1], S[4 * g + 2], S[4 * g + 3]);
    }
    __syncthreads();
  }
  if (w < KT) {
#pragma unroll
    for (int r = 0; r < 16; ++r) sout[(size_t)(w * 32 + crow(r, hh)) * 128 + l31] = S[r];
  }
  __syncthreads();
}

DI void phase2(const Params& p, unsigned char* smem) {
  for (int u = blockIdx.x; u < 1024; u += gridDim.x) {
    const int kind = (u >> 8) & 1, idx = u & 255, seq = (idx >> 4) + (u >= 512 ? 16 : 0), head = (idx >> 2) & 3, vs = idx & 3;
    if (kind == 0) chunk_unit<128, false>(p, seq, head, vs, smem);
    else chunk_unit<64, true>(p, seq, head, vs, smem);
  }
}

DI void phase3(const Params& p, unsigned char*) {
  unsigned char* ws = p.ws;
  const int lane = threadIdx.x & 63, gw = blockIdx.x * 4 + (threadIdx.x >> 6), nw = gridDim.x * 4;
  const bf16_t* O = (const bf16_t*)(ws + OFF_ORAW);
  const bf16_t* G = (const bf16_t*)(ws + (lane < 32 ? OFF_GA : OFF_GB)) + (lane & 31) * 16;
  const float* ng = p.in[lane < 32 ? I_HNG : I_GNG] + (lane & 7) * 16;
  float gv[16];
#pragma unroll
  for (int i = 0; i < 16; ++i) gv[i] = ng[i];
  bf16_t* out = (bf16_t*)(ws + OFF_HA);
  for (int row = gw; row < NT; row += nw) {
    const u32x4 o0 = *(const u32x4*)(O + (size_t)row * 1024 + lane * 16), o1 = *(const u32x4*)(O + (size_t)row * 1024 + lane * 16 + 8);
    const u32x4 g0 = *(const u32x4*)(G + (size_t)row * 512), g1 = *(const u32x4*)(G + (size_t)row * 512 + 8);
    float ov[16], gt[16];
    unpack8(o0, ov); unpack8(o1, ov + 8); unpack8(g0, gt); unpack8(g1, gt + 8);
    float ss = 0.f;
#pragma unroll
    for (int i = 0; i < 16; ++i) ss += ov[i] * ov[i];
    ss += __shfl_xor(ss, 1); ss += __shfl_xor(ss, 2); ss += __shfl_xor(ss, 4);
    const float rs = rsqrtf(ss * (1.f / 128.f) + 1e-6f);
    float r[16];
#pragma unroll
    for (int i = 0; i < 16; ++i) r[i] = ov[i] * rs * gv[i] * gt[i];
    *(u32x4*)(out + (size_t)row * 1024 + lane * 16) = pack8(r);
    *(u32x4*)(out + (size_t)row * 1024 + lane * 16 + 8) = pack8(r + 8);
  }
}

DI void phase_outproj(const Params& p, unsigned char* smem, size_t offA, size_t offW, bool first) {
  unsigned char* ws = p.ws;
  bf16_t* As = (bf16_t*)smem;
  float* X = p.out;
  for_tiles(NT / 128, 8, [&](int tm, int tn) {
    f32x16 acc[2][2];
    gemm_tile_db(LoadBf16{(const bf16_t*)(ws + offA), 1024}, (const bf16_t*)(ws + offW), 1024, 1024, tm * 128, tn * 128, acc, As);
    epilogue(acc, tm * 128, tn * 128, [&](int row, int col, float a, float b, float c, float d) {
      const float* src = first ? (row < NPR ? p.in[I_XP] + (size_t)row * 1024 + col : p.in[I_XS] + (size_t)(row - NPR) * 1024 + col) : X + (size_t)row * 1024 + col;
      float4 x = *(const float4*)src;
      x.x += a; x.y += b; x.z += c; x.w += d;
      *(float4*)(X + (size_t)row * 1024 + col) = x;
    }, (float*)smem);
  });
}

DI void phase_norm2(const Params& p, int layer) { rmsnorm_rows(p, p.out, false, p.in[I_N2] + layer * 1024, (bf16_t*)(p.ws + OFF_HA)); }

DI void phase_qp(const Params& p, unsigned char* smem, int layer) {
  unsigned char* ws = p.ws;
  bf16_t* As = (bf16_t*)smem;
  bf16_t* QP = (bf16_t*)(ws + OFF_QP);
  for_tiles(NT / 128, 16, [&](int tm, int tn) {
    f32x16 acc[2][2];
    gemm_tile_db(LoadBf16{(const bf16_t*)(ws + OFF_HA), 1024}, (const bf16_t*)(ws + OFF_WT_Q) + (size_t)layer * 2048 * 1024, 1024, 1024, tm * 128, tn * 128, acc, As);
    epilogue(acc, tm * 128, tn * 128, [&](int row, int col, float a, float b, float c, float d) { st_bf4(QP + (size_t)row * 2048 + col, a, b, c, d); }, (float*)smem);
  });
}

DI unsigned f2key(float f, int idx) { unsigned u = __float_as_uint(f); u = (u & 0x80000000u) ? ~u : (u | 0x80000000u); return (u & ~127u) | (unsigned)(127 - idx); }
DI float key2f(unsigned k) { k &= ~127u; const unsigned u = (k & 0x80000000u) ? (k & 0x7fffffffu) : ~k; return __uint_as_float(u); }
DI void phase_route(const Params& p, unsigned char* smem, int layer) {
  unsigned char* ws = p.ws;
  bf16_t* As = (bf16_t*)smem;
  unsigned* sk = (unsigned*)smem;
  float* lv = (float*)smem;
  int* li = (int*)(smem + 16384);
  float* sv1 = (float*)(smem + 32768);
  unsigned char* si1 = smem + 32768 + 8192;
  float* sv0 = (float*)(smem + 65536);
  unsigned char* si0 = smem + 65536 + 8192;
  const bf16_t* QP = (const bf16_t*)(ws + OFF_QP);
  const bf16_t* SK = (const bf16_t*)(ws + OFF_SK);
  int* EIDX = (int*)(ws + OFF_EIDX); float* GATE = (float*)(ws + OFF_GATE);
  const int tid = threadIdx.x, lane = tid & 63, w = tid >> 6, wm = w >> 1, wn = w & 1;
  const int ntile = (NT / 128) * 8;
  for (int t = blockIdx.x; t < ntile; t += gridDim.x) {
    const int tm = t >> 3, h = t & 7;
    for (int p2 = 0; p2 < 2; ++p2) {
      f32x16 acc[2][2];
      gemm_tile<64>(LoadBf16{QP + (h * 2 + p2) * 128, 2048}, SK + (size_t)((layer * 8 + h) * 2 + p2) * 128 * 128, 128, 128, tm * 128, 0, acc, As);
      __syncthreads();
#pragma unroll
      for (int mi = 0; mi < 2; ++mi)
#pragma unroll
        for (int ni = 0; ni < 2; ++ni)
#pragma unroll
          for (int g4 = 0; g4 < 4; ++g4) {
            const int m = wm * 64 + mi * 32 + (lane & 31), n = wn * 64 + ni * 32 + 8 * g4 + 4 * (lane >> 5);
            *(u32x4*)(sk + m * 128 + 4 * ((n >> 2) ^ (m & 31))) = (u32x4){f2key(acc[mi][ni][4 * g4], n), f2key(acc[mi][ni][4 * g4 + 1], n + 1), f2key(acc[mi][ni][4 * g4 + 2], n + 2), f2key(acc[mi][ni][4 * g4 + 3], n + 3)};
          }
      __syncthreads();
      const int row = tid & 127, half = tid >> 7, sw = row & 31;
      unsigned keys[16];
#pragma unroll
      for (int r = 0; r < 16; ++r) {
        unsigned best = 0u;
#pragma unroll
        for (int q = 0; q < 16; ++q) {
          const u32x4 v = *(const u32x4*)(sk + row * 128 + 4 * ((half * 16 + q) ^ sw));
          best = max(max(best, v.x), v.y); best = max(max(best, v.z), v.w);
        }
        const int bidx = 127 - (int)(best & 127u);
        sk[row * 128 + 4 * ((bidx >> 2) ^ sw) + (bidx & 3)] = 0u;
        keys[r] = best;
      }
      __syncthreads();
#pragma unroll
      for (int r = 0; r < 16; ++r) { lv[r * 256 + tid] = key2f(keys[r]); li[r * 256 + tid] = 127 - (int)(keys[r] & 127u); }
      __syncthreads();
      if (tid < 128) {
        float* dv = p2 ? sv1 : sv0; unsigned char* di = p2 ? si1 : si0;
        int a = 0, b = 0;
#pragma unroll 1
        for (int r = 0; r < 16; ++r) {
          const float va = lv[a * 256 + row], vb = lv[b * 256 + 128 + row];
          const bool ta = va >= vb;
          dv[r * 128 + row] = ta ? va : vb;
          di[r * 128 + row] = (unsigned char)(ta ? li[a * 256 + row] : li[b * 256 + 128 + row]);
          a += ta ? 1 : 0; b += ta ? 0 : 1;
        }
      }
      __syncthreads();
    }
    if (tid < 128) {
      const int row = tid;
      unsigned long long jp = 0ull;
      float cs[16]; int ce[16];
#pragma unroll
      for (int r = 0; r < 16; ++r) {
        float best = -INFINITY; int bi_ = 0;
#pragma unroll
        for (int i = 0; i < 16; ++i) {
          const int j = (int)((jp >> (4 * i)) & 15ull);
          const float v = sv0[i * 128 + row] + sv1[j * 128 + row];
          if (v > best) { best = v; bi_ = i; }
        }
        const int j = (int)((jp >> (4 * bi_)) & 15ull);
        ce[r] = (int)si0[bi_ * 128 + row] * 128 + (int)si1[j * 128 + row];
        cs[r] = best;
        jp += 1ull << (4 * bi_);
      }
      float e[16], sum = 0.f;
#pragma unroll
      for (int r = 0; r < 16; ++r) { e[r] = __expf(cs[r] - cs[0]); sum += e[r]; }
      const float inv = 1.f / sum;
      const size_t base = ((size_t)(tm * 128 + row) * 8 + h) * 16;
#pragma unroll
      for (int r = 0; r < 16; ++r) { EIDX[base + r] = ce[r]; GATE[base + r] = e[r] * inv; }
    }
    __syncthreads();
  }
}

DI float dot2bf(unsigned a, unsigned b, float c) {
  typedef __bf16 bf2 __attribute__((ext_vector_type(2)));
  return __builtin_amdgcn_fdot2_f32_bf16(__builtin_bit_cast(bf2, a), __builtin_bit_cast(bf2, b), c, false);
}

#define CVT8(q, hi) __builtin_amdgcn_cvt_pk_f32_fp8((int)(q), hi)
DI float dpp_x1(float v) { return __uint_as_float(__builtin_amdgcn_update_dpp(0, __float_as_uint(v), 0xB1, 0xF, 0xF, true)); }
DI float dpp_x2(float v) { return __uint_as_float(__builtin_amdgcn_update_dpp(0, __float_as_uint(v), 0x4E, 0xF, 0xF, true)); }
DI float dpp_hm(float v) { return __uint_as_float(__builtin_amdgcn_update_dpp(0, __float_as_uint(v), 0x141, 0xF, 0xF, true)); }
DI f32x2 shx2(const f32x2& v, int m) { f32x2 r; r.x = __shfl_xor(v.x, m); r.y = __shfl_xor(v.y, m); return r; }

struct TokU { u32x4 xa, xb; int ev0, ev1; };
DI void phase_peer_u(const Params& p) {
  unsigned char* ws = p.ws;
  const int lane = threadIdx.x & 63, r = lane >> 3, s = lane & 7;
  const int x = blockIdx.x & 7, lw = (blockIdx.x >> 3) * 4 + (threadIdx.x >> 6), nlw = (gridDim.x >> 3) * 4;
  const unsigned char* U8s = ws + OFF_U8 + (size_t)x * 16384 * 128 + 16 * s;
  const int* EIDX = (const int*)(ws + OFF_EIDX);
  const bf16_t* HA = (const bf16_t*)(ws + OFF_HA);
  float* HP = (float*)(ws + OFF_HP) + (size_t)x * NT * 128;
  auto load_tok = [&](int t, TokU& k) {
    const bf16_t* hp = HA + (size_t)t * 1024 + 128 * x + 16 * s;
    k.xa = *(const u32x4*)hp; k.xb = *(const u32x4*)(hp + 8);
    k.ev0 = EIDX[(size_t)t * 128 + lane]; k.ev1 = EIDX[(size_t)t * 128 + 64 + lane];
  };
  auto gather = [&](const TokU& k, u32x4 (&g)[16]) {
#pragma unroll
    for (int i = 0; i < 16; ++i) { const int e = __shfl(i < 8 ? k.ev0 : k.ev1, (8 * i + r) & 63); g[i] = *(const u32x4*)(U8s + (size_t)e * 128); }
  };
  auto compute = [&](int t, const f32x2 (&xs)[8], const u32x4 (&g)[16]) {
    float keep0 = 0.f, keep1 = 0.f;
#pragma unroll
    for (int i = 0; i < 16; ++i) {
      const u32x4 u = g[i];
      f32x2 d = CVT8(u.x, false) * xs[0];
      d = CVT8(u.x, true) * xs[1] + d; d = CVT8(u.y, false) * xs[2] + d; d = CVT8(u.y, true) * xs[3] + d;
      d = CVT8(u.z, false) * xs[4] + d; d = CVT8(u.z, true) * xs[5] + d; d = CVT8(u.w, false) * xs[6] + d; d = CVT8(u.w, true) * xs[7] + d;
      float ds = d.x + d.y;
      ds += dpp_x1(ds); ds += dpp_x2(ds); ds += dpp_hm(ds);
      if (s == (i & 7)) { if (i < 8) keep0 = ds; else keep1 = ds; }
    }
    HP[(size_t)t * 128 + 8 * s + r] = keep0; HP[(size_t)t * 128 + 64 + 8 * s + r] = keep1;
  };
#define PU_STEP(kc, gc, kn, gn)                                                                                        \
  {                                                                                                                    \
    const int tn = t + nlw; const bool has_next = tn < NT;                                                             \
    if (has_next) gather(kn, gn);                                                                                      \
    const f32x2 xs[8] = {{lo2f(kc.xa.x), hi2f(kc.xa.x)}, {lo2f(kc.xa.y), hi2f(kc.xa.y)}, {lo2f(kc.xa.z), hi2f(kc.xa.z)}, {lo2f(kc.xa.w), hi2f(kc.xa.w)}, \
                         {lo2f(kc.xb.x), hi2f(kc.xb.x)}, {lo2f(kc.xb.y), hi2f(kc.xb.y)}, {lo2f(kc.xb.z), hi2f(kc.xb.z)}, {lo2f(kc.xb.w), hi2f(kc.xb.w)}}; \
    if (tn + nlw < NT) load_tok(tn + nlw, kc);                                                                         \
    __builtin_amdgcn_sched_barrier(0);                                                                                 \
    compute(t, xs, gc);                                                                                                \
    t = tn; if (!has_next) break;                                                                                      \
  }
  int t = lw;
  if (t < NT) {
    TokU ka, kb; u32x4 ga[16], gb[16];
    load_tok(t, ka); gather(ka, ga);
    if (t + nlw < NT) load_tok(t + nlw, kb);
    while (true) {
      PU_STEP(ka, ga, kb, gb)
      PU_STEP(kb, gb, ka, ga)
    }
  }
#undef PU_STEP
}

DI void phase_peer_act(const Params& p) {
  unsigned char* ws = p.ws;
  const float* HP = (const float*)(ws + OFF_HP);
  const float* USC = (const float*)(ws + OFF_USC); const float* VSC = (const float*)(ws + OFF_VSC);
  const int* EIDX = (const int*)(ws + OFF_EIDX); float* GATE = (float*)(ws + OFF_GATE);
  const size_t n = (size_t)NT * 128, stride = (size_t)gridDim.x * 256 * 4;
  for (size_t idx = ((size_t)blockIdx.x * 256 + threadIdx.x) * 4; idx < n; idx += stride) {
    float4 hp[8];
#pragma unroll
    for (int x = 0; x < 8; ++x) hp[x] = *(const float4*)(HP + (size_t)x * n + idx);
    const int4 e4 = *(const int4*)(EIDX + idx);
    const float4 g4 = *(const float4*)(GATE + idx);
    __builtin_amdgcn_sched_barrier(0);
    const float us[4] = {USC[e4.x], USC[e4.y], USC[e4.z], USC[e4.w]};
    const float vs[4] = {VSC[e4.x], VSC[e4.y], VSC[e4.z], VSC[e4.w]};
    float h[4] = {0.f, 0.f, 0.f, 0.f};
#pragma unroll
    for (int x = 0; x < 8; ++x) { h[0] += hp[x].x; h[1] += hp[x].y; h[2] += hp[x].z; h[3] += hp[x].w; }
    const float gg[4] = {g4.x, g4.y, g4.z, g4.w};
    float o[4];
#pragma unroll
    for (int j = 0; j < 4; ++j) { const float hh = h[j] * us[j]; o[j] = 0.5f * hh * (1.f + erff(hh * 0.70710678118f)) * gg[j] * vs[j]; }
    *(float4*)(GATE + idx) = make_float4(o[0], o[1], o[2], o[3]);
  }
}

struct TokV { int ev0, ev1; float ac0, ac1; float2 xv; };
DI void phase_peer_v(const Params& p) {
  unsigned char* ws = p.ws;
  const int lane = threadIdx.x & 63, r = lane >> 3, s = lane & 7;
  const int x = blockIdx.x & 7, lw = (blockIdx.x >> 3) * 4 + (threadIdx.x >> 6), nlw = (gridDim.x >> 3) * 4;
  const unsigned char* V8s = ws + OFF_V8 + (size_t)x * 16384 * 128 + 16 * s;
  const int* EIDX = (const int*)(ws + OFF_EIDX); const float* ACT = (const float*)(ws + OFF_GATE);
  float* X = p.out; float* SSP = (float*)(ws + OFF_SSP) + (size_t)x * NT;
  const int xoff = 128 * x + 16 * s + 2 * r;
  auto load_tok = [&](int t, TokV& k) {
    k.ev0 = EIDX[(size_t)t * 128 + lane]; k.ev1 = EIDX[(size_t)t * 128 + 64 + lane];
    k.ac0 = ACT[(size_t)t * 128 + lane]; k.ac1 = ACT[(size_t)t * 128 + 64 + lane];
    k.xv = *(const float2*)(X + (size_t)t * 1024 + xoff);
  };
  auto gather = [&](const TokV& k, u32x4 (&g)[16], unsigned (&pk)[16]) {
    const unsigned w0 = (pack2(0.f, k.ac0) & 0xffff0000u) | (unsigned)k.ev0, w1 = (pack2(0.f, k.ac1) & 0xffff0000u) | (unsigned)k.ev1;
#pragma unroll
    for (int i = 0; i < 16; ++i) { pk[i] = (unsigned)__shfl((int)(i < 8 ? w0 : w1), (8 * i + r) & 63); g[i] = *(const u32x4*)(V8s + (size_t)(pk[i] & 0xffffu) * 128); }
  };
  auto compute = [&](int t, float2 xv, const u32x4 (&g)[16], const unsigned (&pk)[16]) {
    f32x2 acc[8];
#pragma unroll
    for (int i = 0; i < 8; ++i) acc[i] = (f32x2){0.f, 0.f};
#pragma unroll
    for (int i = 0; i < 16; ++i) {
      const float a = __uint_as_float(pk[i] & 0xffff0000u);
      const u32x4 v = g[i];
      const f32x2 aa = {a, a};
      acc[0] = CVT8(v.x, false) * aa + acc[0]; acc[1] = CVT8(v.x, true) * aa + acc[1];
      acc[2] = CVT8(v.y, false) * aa + acc[2]; acc[3] = CVT8(v.y, true) * aa + acc[3];
      acc[4] = CVT8(v.z, false) * aa + acc[4]; acc[5] = CVT8(v.z, true) * aa + acc[5];
      acc[6] = CVT8(v.w, false) * aa + acc[6]; acc[7] = CVT8(v.w, true) * aa + acc[7];
    }
    f32x2 b4[4], b2[2];
#pragma unroll
    for (int m = 0; m < 4; ++m) { const f32x2 keep = (r & 4) ? acc[4 + m] : acc[m], send = (r & 4) ? acc[m] : acc[4 + m]; b4[m] = keep + shx2(send, 32); }
#pragma unroll
    for (int m = 0; m < 2; ++m) { const f32x2 keep = (r & 2) ? b4[2 + m] : b4[m], send = (r & 2) ? b4[m] : b4[2 + m]; b2[m] = keep + shx2(send, 16); }
    const f32x2 keep = (r & 1) ? b2[1] : b2[0], send = (r & 1) ? b2[0] : b2[1];
    const f32x2 o = keep + shx2(send, 8);
    xv.x += o.x; xv.y += o.y;
    *(float2*)(X + (size_t)t * 1024 + xoff) = xv;
    const float ss = wave_sum(xv.x * xv.x + xv.y * xv.y);
    if (lane == 0) SSP[t] = ss;
  };
#define PV_STEP(kc, gc, pc, kn, gn, pn)                                                                                       \
  {                                                                                                                    \
    const int tn = t + nlw; const bool has_next = tn < NT;                                                             \
    if (has_next) gather(kn, gn, pn);                                                                                  \
    const float2 cx = kc.xv;                                                     \
    if (tn + nlw < NT) load_tok(tn + nlw, kc);                                                                         \
    __builtin_amdgcn_sched_barrier(0);                                                                                 \
    compute(t, cx, gc, pc);                                                                                        \
    t = tn; if (!has_next) break;                                                                                      \
  }
  int t = lw;
  if (t < NT) {
    TokV ka, kb; u32x4 ga[16], gb[16]; unsigned pa[16], pb[16];
    load_tok(t, ka); gather(ka, ga, pa);
    if (t + nlw < NT) load_tok(t + nlw, kb);
    while (true) {
      PV_STEP(ka, ga, pa, kb, gb, pb)
      PV_STEP(kb, gb, pb, ka, ga, pa)
    }
  }
#undef PV_STEP
}

DI void phase_peer_norm(const Params& p, int layer) {
  unsigned char* ws = p.ws;
  const int lane = threadIdx.x & 63, gw = blockIdx.x * 4 + (threadIdx.x >> 6), nw = gridDim.x * 4;
  const float* SSP = (const float*)(ws + OFF_SSP);
  bf16_t* HA = (bf16_t*)(ws + OFF_HA);
  float* X = p.out;
  const float* gn = layer == 0 ? p.in[I_N1] + 1024 : p.in[I_FG];
  float4 gv[4];
#pragma unroll
  for (int j = 0; j < 4; ++j) gv[j] = *(const float4*)(gn + lane * 4 + 256 * j);
  for (int row = gw; row < NT; row += nw) {
    float sp[8];
#pragma unroll
    for (int x = 0; x < 8; ++x) sp[x] = SSP[(size_t)x * NT + row];
    float* xr = X + (size_t)row * 1024;
    float4 xin[4];
#pragma unroll
    for (int j = 0; j < 4; ++j) xin[j] = *(const float4*)(xr + lane * 4 + 256 * j);
    __builtin_amdgcn_sched_barrier(0);
    const float ss = ((sp[0] + sp[1]) + (sp[2] + sp[3])) + ((sp[4] + sp[5]) + (sp[6] + sp[7]));
    const float rs = rsqrtf(ss * (1.f / 1024.f) + 1e-6f);
    float* so = nullptr;
    if (layer == 0) {
      if (row < NPR) { if ((row & 4095) == 4095) so = p.out + O_PS + (size_t)(row >> 12) * 1024; }
      else { if (((row - NPR) & 31) == 31) so = p.out + O_SS + (size_t)((row - NPR) >> 5) * 1024; }
    }
#pragma unroll
    for (int j = 0; j < 4; ++j) {
      const float4 v = xin[j];
      const float4 y = make_float4(v.x * rs * gv[j].x, v.y * rs * gv[j].y, v.z * rs * gv[j].z, v.w * rs * gv[j].w);
      if (layer == 0) {
        st_bf4(HA + (size_t)row * 1024 + lane * 4 + 256 * j, y.x, y.y, y.z, y.w);
        if (so) *(float4*)(so + lane * 4 + 256 * j) = y;
      } else *(float4*)(xr + lane * 4 + 256 * j) = y;
    }
  }
}

DI void phase9(const Params& p, unsigned char* smem) {
  unsigned char* ws = p.ws;
  bf16_t* As = (bf16_t*)smem;
  bf16_t* R = (bf16_t*)(ws + OFF_R); bf16_t* Kb = (bf16_t*)(ws + OFF_K); bf16_t* V = (bf16_t*)(ws + OFF_V);
  bf16_t* W1 = (bf16_t*)(ws + OFF_W1); bf16_t* A1 = (bf16_t*)(ws + OFF_A1); bf16_t* G1 = (bf16_t*)(ws + OFF_G1);
  for_tiles(NT / 128, 27, [&](int tm, int tn) {
    const int mi_ = tn < 24 ? (tn >> 3) : tn - 21;
    f32x16 acc[2][2];
    gemm_tile<64>(LoadShiftMix{(const bf16_t*)(ws + OFF_HA), p.in[I_MU] + mi_ * 1024, p.in[I_SS]}, (const bf16_t*)(ws + OFF_WT_RK), 1024, 1024, tm * 128, tn * 128, acc, As);
    epilogue(acc, tm * 128, tn * 128, [&](int row, int col, float a, float b, float c, float d) {
      if (col < 1024) st_bf4(R + (size_t)row * 1024 + col, a, b, c, d);
      else if (col < 2048) st_bf4(Kb + (size_t)row * 1024 + col - 1024, a, b, c, d);
      else if (col < 3072) st_bf4(V + (size_t)row * 1024 + col - 2048, a, b, c, d);
      else if (col < 3136) st_bf4(W1 + (size_t)row * 64 + col - 3072, tanhf(a), tanhf(b), tanhf(c), tanhf(d));
      else if (col < 3200) {}
      else if (col < 3264) st_bf4(A1 + (size_t)row * 64 + col - 3200, a, b, c, d);
      else if (col < 3328) {}
      else st_bf4(G1 + (size_t)row * 128 + col - 3328, sigmoidf_(a), sigmoidf_(b), sigmoidf_(c), sigmoidf_(d));
    }, (float*)smem);
  });
}

DI float decay_of(float w) {
  const float nw = -w;
  const float sp = nw > 20.f ? nw : log1pf(__expf(nw));
  return __expf(-__expf(-sp - 0.5f));
}
DI unsigned short f2h(float x) { return __builtin_bit_cast(unsigned short, (_Float16)x); }

DI void phase10(const Params& p, unsigned char* smem) {
  unsigned char* ws = p.ws;
  bf16_t* As = (bf16_t*)smem;
  unsigned short* DEC = (unsigned short*)(ws + OFF_DEC); bf16_t* AA = (bf16_t*)(ws + OFF_AA); bf16_t* GG = (bf16_t*)(ws + OFF_GG);
  for_tiles(NT / 128, 24, [&](int tm, int tn) {
    const int grp = tn >> 3, n0 = (tn & 7) * 128;
    f32x16 acc[2][2];
    if (grp == 0) {
      gemm_tile<64>(LoadBf16{(const bf16_t*)(ws + OFF_W1), 64}, (const bf16_t*)(ws + OFF_WT_W2), 64, 64, tm * 128, n0, acc, As);
      epilogue(acc, tm * 128, n0, [&](int row, int col, float a, float b, float c, float d) {
        const float4 w0 = *(const float4*)(p.in[I_W0] + col);
        u32x2 q; q.x = (unsigned)f2h(decay_of(w0.x + a)) | ((unsigned)f2h(decay_of(w0.y + b)) << 16); q.y = (unsigned)f2h(decay_of(w0.z + c)) | ((unsigned)f2h(decay_of(w0.w + d)) << 16);
        *(u32x2*)(DEC + (size_t)row * 1024 + col) = q;
      }, (float*)smem);
    } else if (grp == 1) {
      gemm_tile<64>(LoadBf16{(const bf16_t*)(ws + OFF_A1), 64}, (const bf16_t*)(ws + OFF_WT_A2), 64, 64, tm * 128, n0, acc, As);
      epilogue(acc, tm * 128, n0, [&](int row, int col, float a, float b, float c, float d) {
        const float4 a0 = *(const float4*)(p.in[I_A0] + col);
        st_bf4(AA + (size_t)row * 1024 + col, sigmoidf_(a0.x + a), sigmoidf_(a0.y + b), sigmoidf_(a0.z + c), sigmoidf_(a0.w + d));
      }, (float*)smem);
    } else {
      gemm_tile<128>(LoadBf16{(const bf16_t*)(ws + OFF_G1), 128}, (const bf16_t*)(ws + OFF_WT_G2), 128, 128, tm * 128, n0, acc, As);
      epilogue(acc, tm * 128, n0, [&](int row, int col, float a, float b, float c, float d) { st_bf4(GG + (size_t)row * 1024 + col, a, b, c, d); }, (float*)smem);
    }
  });
}

DI float dpp_xor1(float v) { return __uint_as_float(__builtin_amdgcn_update_dpp(0, __float_as_uint(v), 0xB1, 0xF, 0xF, true)); }
DI float dpp_xor2(float v) { return __uint_as_float(__builtin_amdgcn_update_dpp(0, __float_as_uint(v), 0x4E, 0xF, 0xF, true)); }

DI void rwkv_unit(const Params& p, int seq, int head, int ih, unsigned char* smem) {
  unsigned char* ws = p.ws;
  float* buf = (float*)smem;
  float* obuf = buf + 32 * 384;
  const int tid = threadIdx.x, lane = tid & 63, w = tid >> 6, il = lane >> 3, jq = lane & 7, ii = w * 8 + il, i = ih * 32 + ii;
  const int row0 = seq_row0(seq), T = seq_len(seq), nch = T >> 5;
  const int b = seq & 15;
  f32x2 s2[4];
  const size_t soff = ((size_t)(b * 16 + head) * 64 + i) * 64 + jq * 8;
  if (seq >= 16) {
    const float* sp = p.in[I_SR] + soff;
#pragma unroll
    for (int j = 0; j < 4; ++j) s2[j] = (f32x2){sp[2 * j], sp[2 * j + 1]};
  } else {
#pragma unroll
    for (int j = 0; j < 4; ++j) s2[j] = (f32x2){0.f, 0.f};
  }
  const int pt = tid >> 3, jg = tid & 7, col = head * 64 + jg * 8;
  float ckk[8], cka[8], crk[8];
#pragma unroll
  for (int j = 0; j < 8; ++j) { ckk[j] = p.in[I_KK][col + j]; cka[j] = p.in[I_KA][col + j]; crk[j] = p.in[I_RK][col + j]; }
  const bf16_t* R = (const bf16_t*)(ws + OFF_R); const bf16_t* Kb = (const bf16_t*)(ws + OFF_K); const bf16_t* V = (const bf16_t*)(ws + OFF_V);
  const unsigned short* DEC = (const unsigned short*)(ws + OFF_DEC); const bf16_t* AA = (const bf16_t*)(ws + OFF_AA);
  float* BON = (float*)(ws + OFF_BON);
  bf16_t* O2 = (bf16_t*)(ws + OFF_ORAW2);
  u32x4 qr, qk, qv, qd, qa;
  {
    const size_t o = (size_t)(row0 + pt) * 1024 + col;
    qr = *(const u32x4*)(R + o); qk = *(const u32x4*)(Kb + o); qv = *(const u32x4*)(V + o); qd = *(const u32x4*)(DEC + o); qa = *(const u32x4*)(AA + o);
  }
  __syncthreads();
  for (int c = 0; c < nch; ++c) {
    {
      float r8[8], k8[8], v8[8], a8[8], d8[8];
      unpack8(qr, r8); unpack8(qk, k8); unpack8(qv, v8); unpack8(qa, a8);
      const half8 dh = __builtin_bit_cast(half8, qd);
#pragma unroll
      for (int j = 0; j < 8; ++j) d8[j] = (float)dh[j];
      float kkr[8], ss = 0.f, bon = 0.f, kp[8];
#pragma unroll
      for (int j = 0; j < 8; ++j) { kkr[j] = k8[j] * ckk[j]; ss += kkr[j] * kkr[j]; kp[j] = k8[j] * (1.f + (a8[j] - 1.f) * cka[j]); bon += r8[j] * kp[j] * crk[j]; }
      ss += dpp_x1(ss); ss += dpp_x2(ss); ss += dpp_hm(ss);
      bon += dpp_x1(bon); bon += dpp_x2(bon); bon += dpp_hm(bon);
      const float inv = rsqrtf(ss + 1e-12f);
      float* bb = buf + pt * 384 + jg * 8;
      float kkn[8], bbv[8];
#pragma unroll
      for (int j = 0; j < 8; ++j) { kkn[j] = kkr[j] * inv; bbv[j] = kkn[j] * a8[j]; }
      *(float4*)(bb) = make_float4(r8[0], r8[1], r8[2], r8[3]); *(float4*)(bb + 4) = make_float4(r8[4], r8[5], r8[6], r8[7]);
      *(float4*)(bb + 64) = make_float4(d8[0], d8[1], d8[2], d8[3]); *(float4*)(bb + 68) = make_float4(d8[4], d8[5], d8[6], d8[7]);
      *(float4*)(bb + 128) = make_float4(kp[0], kp[1], kp[2], kp[3]); *(float4*)(bb + 132) = make_float4(kp[4], kp[5], kp[6], kp[7]);
      *(float4*)(bb + 192) = make_float4(kkn[0], kkn[1], kkn[2], kkn[3]); *(float4*)(bb + 196) = make_float4(kkn[4], kkn[5], kkn[6], kkn[7]);
      *(float4*)(bb + 256) = make_float4(bbv[0], bbv[1], bbv[2], bbv[3]); *(float4*)(bb + 260) = make_float4(bbv[4], bbv[5], bbv[6], bbv[7]);
      *(float4*)(bb + 320) = make_float4(v8[0], v8[1], v8[2], v8[3]); *(float4*)(bb + 324) = make_float4(v8[4], v8[5], v8[6], v8[7]);
      if (jg == 0 && ih == 0) BON[(size_t)(row0 + c * 32 + pt) * 16 + head] = bon;
    }
    __syncthreads();
    if (c + 1 < nch) {
      const size_t o = (size_t)(row0 + (c + 1) * 32 + pt) * 1024 + col;
      qr = *(const u32x4*)(R + o); qk = *(const u32x4*)(Kb + o); qv = *(const u32x4*)(V + o); qd = *(const u32x4*)(DEC + o); qa = *(const u32x4*)(AA + o);
    }
    struct StepOps { float4 r0, r1, w0, w1, k0, k1, n0, n1, b0, b1; float vi; };
    auto ldops = [&](int t, StepOps& q) {
      const float* sb = buf + t * 384 + jq * 8;
      q.n0 = *(const float4*)(sb + 192); q.n1 = *(const float4*)(sb + 196);
      q.w0 = *(const float4*)(sb + 64); q.w1 = *(const float4*)(sb + 68);
      q.b0 = *(const float4*)(sb + 256); q.b1 = *(const float4*)(sb + 260);
      q.k0 = *(const float4*)(sb + 128); q.k1 = *(const float4*)(sb + 132);
      q.r0 = *(const float4*)(sb); q.r1 = *(const float4*)(sb + 4);
      q.vi = buf[t * 384 + 320 + i];
    };
    StepOps cu; ldops(0, cu);
#pragma unroll 4
    for (int t = 0; t < 32; ++t) {
      StepOps nx = cu;
      if (t + 1 < 32) ldops(t + 1, nx);
      __builtin_amdgcn_sched_barrier(0);
      const f32x2 rr2[4] = {{cu.r0.x, cu.r0.y}, {cu.r0.z, cu.r0.w}, {cu.r1.x, cu.r1.y}, {cu.r1.z, cu.r1.w}};
      const f32x2 ww2[4] = {{cu.w0.x, cu.w0.y}, {cu.w0.z, cu.w0.w}, {cu.w1.x, cu.w1.y}, {cu.w1.z, cu.w1.w}};
      const f32x2 kp2[4] = {{cu.k0.x, cu.k0.y}, {cu.k0.z, cu.k0.w}, {cu.k1.x, cu.k1.y}, {cu.k1.z, cu.k1.w}};
      const f32x2 kn2[4] = {{cu.n0.x, cu.n0.y}, {cu.n0.z, cu.n0.w}, {cu.n1.x, cu.n1.y}, {cu.n1.z, cu.n1.w}};
      const f32x2 bb2[4] = {{cu.b0.x, cu.b0.y}, {cu.b0.z, cu.b0.w}, {cu.b1.x, cu.b1.y}, {cu.b1.z, cu.b1.w}};
      const float vi = cu.vi;
      f32x2 sa2 = s2[0] * kn2[0];
      sa2 = s2[1] * kn2[1] + sa2; sa2 = s2[2] * kn2[2] + sa2; sa2 = s2[3] * kn2[3] + sa2;
      float sa = sa2.x + sa2.y;
      sa += dpp_x1(sa); sa += dpp_x2(sa); sa += dpp_hm(sa);
      const f32x2 nsa = {-sa, -sa}, vv = {vi, vi};
      f32x2 o2 = {0.f, 0.f};
#pragma unroll
      for (int j = 0; j < 4; ++j) {
        s2[j] = vv * kp2[j] + (nsa * bb2[j] + s2[j] * ww2[j]);
        o2 = s2[j] * rr2[j] + o2;
      }
      float o = o2.x + o2.y;
      o += dpp_x1(o); o += dpp_x2(o); o += dpp_hm(o);
      if (jq == 0) obuf[t * 32 + ii] = o;
      cu = nx;
    }
    __syncthreads();
    {
      const int ot = tid >> 3, oc = (tid & 7) * 4;
      const float4 ov = *(const float4*)(obuf + ot * 32 + oc);
      st_bf4(O2 + (size_t)(row0 + c * 32 + ot) * 1024 + head * 64 + ih * 32 + oc, ov.x, ov.y, ov.z, ov.w);
    }
  }
  {
    float* so = p.out + (seq < 16 ? O_PR : O_SR) + soff;
#pragma unroll
    for (int j = 0; j < 4; ++j) { so[2 * j] = s2[j].x; so[2 * j + 1] = s2[j].y; }
  }
  __syncthreads();
}
DI void phase11(const Params& p, unsigned char* smem) {
  for (int u = blockIdx.x; u < 1024; u += gridDim.x) {
    const int uu = u & 511;
    rwkv_unit(p, (uu & 15) + (u >= 512 ? 16 : 0), (uu >> 4) & 15, uu >> 8, smem);
  }
}

DI void phase12(const Params& p) {
  unsigned char* ws = p.ws;
  const int lane = threadIdx.x & 63, gw = blockIdx.x * 4 + (threadIdx.x >> 6), nw = gridDim.x * 4;
  const bf16_t* O2 = (const bf16_t*)(ws + OFF_ORAW2); const bf16_t* V = (const bf16_t*)(ws + OFF_V); const bf16_t* GG = (const bf16_t*)(ws + OFF_GG);
  const float* BON = (const float*)(ws + OFF_BON);
  bf16_t* A5 = (bf16_t*)(ws + OFF_A5);
  float lg[16], lb[16];
#pragma unroll
  for (int i = 0; i < 16; ++i) { lg[i] = p.in[I_LNG][lane * 16 + i]; lb[i] = p.in[I_LNB][lane * 16 + i]; }
  for (int row = gw; row < NT; row += nw) {
    const size_t o = (size_t)row * 1024 + lane * 16;
    float ov[16], vv[16], gg[16];
    unpack8(*(const u32x4*)(O2 + o), ov); unpack8(*(const u32x4*)(O2 + o + 8), ov + 8);
    unpack8(*(const u32x4*)(V + o), vv); unpack8(*(const u32x4*)(V + o + 8), vv + 8);
    unpack8(*(const u32x4*)(GG + o), gg); unpack8(*(const u32x4*)(GG + o + 8), gg + 8);
    const float bon = BON[(size_t)row * 16 + (lane >> 2)];
    float sm = 0.f;
#pragma unroll
    for (int i = 0; i < 16; ++i) sm += ov[i];
    sm += __shfl_xor(sm, 1); sm += __shfl_xor(sm, 2);
    const float mean = sm * (1.f / 64.f);
    float sq = 0.f;
#pragma unroll
    for (int i = 0; i < 16; ++i) { const float d = ov[i] - mean; sq += d * d; }
    sq += __shfl_xor(sq, 1); sq += __shfl_xor(sq, 2);
    const float rs = rsqrtf(sq * (1.f / 64.f) + 64e-5f);
    float r[16];
#pragma unroll
    for (int i = 0; i < 16; ++i) r[i] = ((ov[i] - mean) * rs * lg[i] + lb[i] + bon * vv[i]) * gg[i];
    *(u32x4*)(A5 + o) = pack8(r); *(u32x4*)(A5 + o + 8) = pack8(r + 8);
  }
}

DI void phase13(const Params& p, unsigned char* smem) {
  cvt_fp8_rows(p.in[I_PU] + (size_t)16384 * 1024, p.ws + OFF_U8, (float*)(p.ws + OFF_USC));
  cvt_fp8_rows(p.in[I_PV] + (size_t)16384 * 1024, p.ws + OFF_V8, (float*)(p.ws + OFF_VSC));
  phase_outproj(p, smem, OFF_A5, OFF_WT_OUTC, false);
}

template <int PH>
DI void run_phase(const Params& p, unsigned char* smem) {
  if (PH == 0) phase0(p, smem);
  else if (PH == 1) phase1(p, smem);
  else if (PH == 2) phase2(p, smem);
  else if (PH == 3) phase3(p, smem);
  else if (PH == 4) phase_outproj(p, smem, OFF_HA, OFF_WT_OUTAB, true);
  else if (PH == 5) phase_norm2(p, 0);
  else if (PH == 6) phase_qp(p, smem, 0);
  else if (PH == 7) phase_route(p, smem, 0);
  else if (PH == 8) phase_peer_u(p);
  else if (PH == 9) phase_peer_act(p);
  else if (PH == 10) phase_peer_v(p);
  else if (PH == 11) phase_peer_norm(p, 0);
  else if (PH == 12) phase9(p, smem);
  else if (PH == 13) phase10(p, smem);
  else if (PH == 14) phase11(p, smem);
  else if (PH == 15) phase12(p);
  else if (PH == 16) phase13(p, smem);
  else if (PH == 17) phase_norm2(p, 1);
  else if (PH == 18) phase_qp(p, smem, 1);
  else if (PH == 19) phase_route(p, smem, 1);
  else if (PH == 20) phase_peer_u(p);
  else if (PH == 21) phase_peer_act(p);
  else if (PH == 22) phase_peer_v(p);
  else if (PH == 23) phase_peer_norm(p, 1);
  else if (PH == 24) phase_pre(p, smem);
}

template <int PH>
__global__ void __launch_bounds__(256, 2) k_phase(Params p) {
  extern __shared__ __attribute__((aligned(16))) unsigned char smem[];
  run_phase<PH>(p, smem);
}

#ifndef PROBE_MASK
#define PROBE_MASK 0u
#endif
DI void grid_barrier(unsigned* cnt, unsigned target) {
  asm volatile("s_waitcnt vmcnt(0) lgkmcnt(0)" ::: "memory");
  __syncthreads();
  if (threadIdx.x == 0) {
    __builtin_amdgcn_fence(__ATOMIC_RELEASE, "agent");
    asm volatile("s_waitcnt vmcnt(0)" ::: "memory");
    __hip_atomic_fetch_add(cnt, 1u, __ATOMIC_RELAXED, __HIP_MEMORY_SCOPE_AGENT);
    while (__hip_atomic_load(cnt, __ATOMIC_RELAXED, __HIP_MEMORY_SCOPE_AGENT) < target) __builtin_amdgcn_s_sleep(1);
    __builtin_amdgcn_fence(__ATOMIC_ACQUIRE, "agent");
    asm volatile("s_waitcnt vmcnt(0)" ::: "memory");
  }
  __syncthreads();
}
template <int PH>
DI void mega_step(const Params& p, unsigned char* smem, cg::grid_group& grid, unsigned& nb, bool last) {
  run_phase<PH>(p, smem);
  if ((PROBE_MASK >> PH) & 1u) { grid.sync(); run_phase<PH>(p, smem); }
  if (!last) {
    if (PH == 0) grid.sync();
    else { ++nb; grid_barrier((unsigned*)(p.ws + OFF_GBAR), nb * gridDim.x); }
  }
}
__global__ void __launch_bounds__(256, 2) k_mega(Params p) {
  extern __shared__ __attribute__((aligned(16))) unsigned char smem[];
  cg::grid_group grid = cg::this_grid();
  unsigned nb = 0;
  mega_step<0>(p, smem, grid, nb, false); mega_step<1>(p, smem, grid, nb, false); mega_step<24>(p, smem, grid, nb, false); mega_step<2>(p, smem, grid, nb, false); mega_step<3>(p, smem, grid, nb, false);
  mega_step<4>(p, smem, grid, nb, false); mega_step<5>(p, smem, grid, nb, false); mega_step<6>(p, smem, grid, nb, false); mega_step<7>(p, smem, grid, nb, false);
  mega_step<8>(p, smem, grid, nb, false); mega_step<9>(p, smem, grid, nb, false); mega_step<10>(p, smem, grid, nb, false); mega_step<11>(p, smem, grid, nb, false);
  mega_step<12>(p, smem, grid, nb, false); mega_step<13>(p, smem, grid, nb, false); mega_step<14>(p, smem, grid, nb, false); mega_step<15>(p, smem, grid, nb, false);
  mega_step<16>(p, smem, grid, nb, false); mega_step<17>(p, smem, grid, nb, false); mega_step<18>(p, smem, grid, nb, false); mega_step<19>(p, smem, grid, nb, false);
  mega_step<20>(p, smem, grid, nb, false); mega_step<21>(p, smem, grid, nb, false); mega_step<22>(p, smem, grid, nb, false); mega_step<23>(p, smem, grid, nb, true);
}

template <int PH>
static void launch_phase(const Params& p, int grid, hipStream_t stream) {
  static bool attr = false;
  if (!attr) { hipFuncSetAttribute((const void*)k_phase<PH>, hipFuncAttributeMaxDynamicSharedMemorySize, LDS_BYTES); attr = true; }
  hipLaunchKernelGGL(k_phase<PH>, dim3(grid), dim3(256), LDS_BYTES, stream, p);
}

extern "C" void kernel_launch(void* const* d_in, const int* in_sizes, int n_in, void* d_out, int out_size, void* d_ws, size_t ws_size, hipStream_t stream) {
  Params p{};
  for (int i = 0; i < 36; ++i) p.in[i] = (const float*)d_in[i];
  p.out = (float*)d_out; p.ws = (unsigned char*)d_ws;
  if (ws_size < WS_END) { fprintf(stderr, "workspace too small: %zu < %zu\n", ws_size, (size_t)WS_END); return; }
#if MEGA
  static int grid_blocks = 0;
  if (!grid_blocks) {
    hipFuncSetAttribute((const void*)k_mega, hipFuncAttributeMaxDynamicSharedMemorySize, LDS_BYTES);
    int dev = 0, cus = 0, per_cu = 0;
    hipGetDevice(&dev);
    hipDeviceGetAttribute(&cus, hipDeviceAttributeMultiprocessorCount, dev);
    hipOccupancyMaxActiveBlocksPerMultiprocessor(&per_cu, k_mega, 256, LDS_BYTES);
    if (per_cu > 2) per_cu = 2;
    if (per_cu < 1) per_cu = 1;
    grid_blocks = cus * per_cu;
  }
  hipMemsetAsync((unsigned char*)d_ws + OFF_GBAR, 0, 256, stream);
  void* args[] = {&p};
  hipError_t e = hipLaunchCooperativeKernel((void*)k_mega, dim3(grid_blocks), dim3(256), args, LDS_BYTES, stream);
  if (e != hipSuccess) fprintf(stderr, "cooperative launch failed: %s (grid %d)\n", hipGetErrorString(e), grid_blocks);
#else
  const int grid = 512;
  launch_phase<0>(p, grid, stream); launch_phase<1>(p, grid, stream); launch_phase<24>(p, grid, stream); launch_phase<2>(p, grid, stream); launch_phase<3>(p, grid, stream);
  launch_phase<4>(p, grid, stream); launch_phase<5>(p, grid, stream); launch_phase<6>(p, grid, stream); launch_phase<7>(p, grid, stream);
  launch_phase<8>(p, grid, stream); launch_phase<9>(p, grid, stream); launch_phase<10>(p, grid, stream); launch_phase<11>(p, grid, stream);
  launch_phase<12>(p, grid, stream); launch_phase<13>(p, grid, stream); launch_phase<14>(p, grid, stream); launch_phase<15>(p, grid, stream);
  launch_phase<16>(p, grid, stream); launch_phase<17>(p, grid, stream); launch_phase<18>(p, grid, stream); launch_phase<19>(p, grid, stream);
  launch_phase<20>(p, grid, stream); launch_phase<21>(p, grid, stream); launch_phase<22>(p, grid, stream); launch_phase<23>(p, grid, stream);
#endif
}
```
